# Optimizing an MI355X kernel written in HIP

```python
import math
import jax, jax.numpy as jnp
from jax import lax
import numpy as np

D_MODEL = 2048
BATCH = 4
SEQ = 2048
DEPTH = 1

MIX_WIDTH = D_MODEL
RWKV_HEAD_DIM = 64
RWKV_WIDTH = MIX_WIDTH // 2
RWKV_HEADS = RWKV_WIDTH // RWKV_HEAD_DIM
DECAY_LORA = 64
AAA_LORA = 64
GATE_LORA = 160
DIFF_HEAD_DIM = 64
DIFF_V_DIM = 2 * DIFF_HEAD_DIM
DIFF_WIDTH = MIX_WIDTH // 2
DIFF_HEADS = DIFF_WIDTH // DIFF_V_DIM
DIFF_QK_WIDTH = 2 * DIFF_HEADS * DIFF_HEAD_DIM
Q_BLOCK = 128
ROPE_THETA = 10000.0
D_FF = ((8 * D_MODEL // 3 + 255) // 256) * 256
N_BRANCHES = 2
NORM_EPS = 1e-6
RWKV_GN_EPS = 64e-5
SUBLN_EPS = 1e-5

RWKV_SEG_SIZES = (RWKV_WIDTH, RWKV_WIDTH, RWKV_WIDTH, DECAY_LORA, DECAY_LORA, AAA_LORA, AAA_LORA, GATE_LORA)
RWKV_COLS = sum(RWKV_SEG_SIZES)
DIFF_COLS = 2 * DIFF_QK_WIDTH + DIFF_WIDTH
GATE_COLS = N_BRANCHES * D_MODEL
IN_COLS = RWKV_COLS + DIFF_COLS + GATE_COLS

kernel_name = 'hybrid_rwkv7_diffattn_macaron_encoder'


def rms_norm(x, g, eps=NORM_EPS):
    xf = x.astype(jnp.float32)
    y = xf * lax.rsqrt(jnp.mean(xf * xf, axis=-1, keepdims=True) + eps)
    return (y * g.astype(jnp.float32)).astype(x.dtype)


def swiglu_ffn(x, w_gu, w_down):
    gate, up = jnp.split(x @ w_gu, 2, axis=-1)
    return (jax.nn.silu(gate) * up) @ w_down


def centred_token_shift(y, mu_prev, mu_next):
    zero = jnp.zeros_like(y[:, :1])
    y_prev = jnp.concatenate([zero, y[:, :-1]], axis=1)
    y_next = jnp.concatenate([y[:, 1:], zero], axis=1)
    return y + mu_prev * (y_prev - y) + mu_next * (y_next - y)


def rope(x):
    T, dh = x.shape[1], x.shape[-1]
    half = dh // 2
    inv_freq = ROPE_THETA ** (-jnp.arange(half, dtype=jnp.float32) / half)
    ang = jnp.arange(T, dtype=jnp.float32)[:, None] * inv_freq[None, :]
    cos = jnp.cos(ang)[None, :, None, :]
    sin = jnp.sin(ang)[None, :, None, :]
    xf = x.astype(jnp.float32)
    x1, x2 = xf[..., :half], xf[..., half:]
    return jnp.concatenate([x1 * cos - x2 * sin, x2 * cos + x1 * sin], axis=-1).astype(x.dtype)


def heads(z):
    return z.reshape(z.shape[:-1] + (RWKV_HEADS, RWKV_HEAD_DIM))


def wkv7_bidirectional(r, w, k, v, kk, a):
    _, B, T, H, N = r.shape

    def to_scan(z):
        z = jnp.stack([z[0], jnp.flip(z[1], axis=1)]).astype(jnp.float32)
        return jnp.moveaxis(z, 2, 0)

    def step(S, inp):
        r_t, w_t, k_t, v_t, kk_t, a_t = inp
        sa = -jnp.einsum('dbhij,dbhj->dbhi', S, kk_t)
        S = (S * w_t[..., None, :]
             + sa[..., :, None] * (kk_t * a_t)[..., None, :]
             + v_t[..., :, None] * k_t[..., None, :])
        return S, jnp.einsum('dbhij,dbhj->dbhi', S, r_t)

    xs = tuple(to_scan(z) for z in (r, w, k, v, kk, a))
    S0 = jnp.zeros((2, B, H, N, N), jnp.float32)
    _, out = lax.scan(step, S0, xs)
    out = jnp.moveaxis(out, 0, 2)
    return out[0] + jnp.flip(out[1], axis=1)


def rwkv7_branch(rw_seg, w0, w_up, a0, a_up, g_up, k_k, k_a, r_k, gn_w, gn_b):
    split_at = np.cumsum(RWKV_SEG_SIZES)[:-1].tolist()
    r, k, v, wd_f, wd_b, ad_f, ad_b, gd = jnp.split(rw_seg, split_at, axis=-1)
    B, T, _ = r.shape
    wd = jnp.stack([wd_f, wd_b])
    ad = jnp.stack([ad_f, ad_b])
    w_log = -jax.nn.softplus(-(w0[:, None, None, :] + jnp.einsum('dbtr,drc->dbtc', jnp.tanh(wd), w_up))) - 0.5
    decay = jnp.exp(-jnp.exp(w_log.astype(jnp.float32)))
    a = jax.nn.sigmoid(a0[:, None, None, :] + jnp.einsum('dbtr,drc->dbtc', ad, a_up))
    g = jax.nn.sigmoid(gd) @ g_up
    kk = heads((k * k_k).astype(jnp.float32))
    kk = kk * lax.rsqrt(jnp.maximum(jnp.sum(kk * kk, axis=-1, keepdims=True), 1e-24))
    k_dir = heads(k[None] * (1.0 + (a - 1.0) * k_a))
    r_h, v_h = heads(r), heads(v)

    def both(z):
        return jnp.broadcast_to(z[None], (2,) + z.shape)

    o = wkv7_bidirectional(both(r_h), heads(decay), k_dir, both(v_h), both(kk), heads(a))
    mean = jnp.mean(o, axis=-1, keepdims=True)
    var = jnp.mean(jnp.square(o - mean), axis=-1, keepdims=True)
    o = ((o - mean) * lax.rsqrt(var + RWKV_GN_EPS)).reshape(B, T, RWKV_WIDTH)
    o = (o * gn_w.astype(jnp.float32) + gn_b.astype(jnp.float32)).astype(r.dtype)
    bonus = jnp.sum(r_h[None] * k_dir * r_k, axis=-1, keepdims=True) * v_h[None]
    bonus = jnp.sum(bonus, axis=0).reshape(B, T, RWKV_WIDTH)
    return (o + bonus) * g


def diff_attention_branch(q, k, v, lambda_q1, lambda_k1, lambda_q2, lambda_k2, subln_g, lam_init):
    B, T, _ = q.shape
    q = rope(q.reshape(B, T, 2 * DIFF_HEADS, DIFF_HEAD_DIM)) * (DIFF_HEAD_DIM ** -0.5)
    k = rope(k.reshape(B, T, 2 * DIFF_HEADS, DIFF_HEAD_DIM))
    v = v.reshape(B, T, DIFF_HEADS, DIFF_V_DIM)
    lam = (jnp.exp(jnp.sum(lambda_q1.astype(jnp.float32) * lambda_k1.astype(jnp.float32)))
           - jnp.exp(jnp.sum(lambda_q2.astype(jnp.float32) * lambda_k2.astype(jnp.float32)))
           + lam_init)
    n_blk = T // Q_BLOCK
    q_blocks = jnp.moveaxis(q.reshape(B, n_blk, Q_BLOCK, 2 * DIFF_HEADS, DIFF_HEAD_DIM), 1, 0)

    def attend(qb):
        s = jnp.einsum('bqhd,bkhd->bhqk', qb, k).astype(jnp.float32)
        p = jax.nn.softmax(s, axis=-1).reshape(B, DIFF_HEADS, 2, Q_BLOCK, T)
        amap = p[:, :, 0] - lam * p[:, :, 1]
        return jnp.einsum('bhqk,bkhd->bqhd', amap.astype(v.dtype), v)

    o = lax.map(attend, q_blocks)
    o = jnp.moveaxis(o, 0, 1).reshape(B, T, DIFF_HEADS, DIFF_V_DIM)
    o = rms_norm(o, subln_g, SUBLN_EPS) * (1.0 - lam_init)
    return o.reshape(B, T, DIFF_WIDTH)


def setup_inputs(seed: int = 0) -> dict:
    key = jax.random.key(seed)
    ks = iter(jax.random.split(key, 40))
    L = DEPTH
    f32 = jnp.float32

    def nrm(shape, scale):
        return scale * jax.random.normal(next(ks), shape, f32)

    def gain(shape):
        return 1.0 + 0.05 * jax.random.normal(next(ks), shape, f32)

    def unif(shape, lo, hi):
        return jax.random.uniform(next(ks), shape, f32, lo, hi)

    return {
        'x': nrm((BATCH, SEQ, D_MODEL), 1.0),
        'ffn1_pre_g': gain((L, D_MODEL)),
        'ffn1_w_gu': nrm((L, D_MODEL, 2 * D_FF), D_MODEL ** -0.5),
        'ffn1_w_down': nrm((L, D_FF, D_MODEL), D_FF ** -0.5),
        'ffn1_post_g': gain((L, D_MODEL)),
        'mix_pre_g': gain((L, D_MODEL)),
        'w_in': nrm((L, D_MODEL, IN_COLS), D_MODEL ** -0.5),
        'mu_prev': unif((L, RWKV_COLS), 0.0, 0.5),
        'mu_next': unif((L, RWKV_COLS), 0.0, 0.5),
        'w0': unif((L, 2, RWKV_WIDTH), -6.0, 0.0),
        'w_up': nrm((L, 2, DECAY_LORA, RWKV_WIDTH), 0.5 * DECAY_LORA ** -0.5),
        'a0': nrm((L, 2, RWKV_WIDTH), 0.1),
        'a_up': nrm((L, 2, AAA_LORA, RWKV_WIDTH), 0.5 * AAA_LORA ** -0.5),
        'g_up': nrm((L, GATE_LORA, RWKV_WIDTH), GATE_LORA ** -0.5),
        'k_k': 0.85 + nrm((L, RWKV_WIDTH), 0.05),
        'k_a': gain((L, RWKV_WIDTH)),
        'r_k': nrm((L, RWKV_HEADS, RWKV_HEAD_DIM), 0.1),
        'gn_w': gain((L, RWKV_WIDTH)),
        'gn_b': nrm((L, RWKV_WIDTH), 0.01),
        'lambda_q1': nrm((L, DIFF_HEAD_DIM), 0.1),
        'lambda_k1': nrm((L, DIFF_HEAD_DIM), 0.1),
        'lambda_q2': nrm((L, DIFF_HEAD_DIM), 0.1),
        'lambda_k2': nrm((L, DIFF_HEAD_DIM), 0.1),
        'subln_g': gain((L, DIFF_V_DIM)),
        'w_branch_a': nrm((L, RWKV_WIDTH, D_MODEL), RWKV_WIDTH ** -0.5),
        'w_branch_b': nrm((L, DIFF_WIDTH, D_MODEL), DIFF_WIDTH ** -0.5),
        'w_out': nrm((L, D_MODEL, D_MODEL), D_MODEL ** -0.5),
        'mix_post_g': gain((L, D_MODEL)),
        'ffn2_pre_g': gain((L, D_MODEL)),
        'ffn2_w_gu': nrm((L, D_MODEL, 2 * D_FF), D_MODEL ** -0.5),
        'ffn2_w_down': nrm((L, D_FF, D_MODEL), D_FF ** -0.5),
        'ffn2_post_g': gain((L, D_MODEL)),
    }


def reference(x, ffn1_pre_g, ffn1_w_gu, ffn1_w_down, ffn1_post_g, mix_pre_g, w_in, mu_prev, mu_next,
              w0, w_up, a0, a_up, g_up, k_k, k_a, r_k, gn_w, gn_b,
              lambda_q1, lambda_k1, lambda_q2, lambda_k2, subln_g,
              w_branch_a, w_branch_b, w_out, mix_post_g,
              ffn2_pre_g, ffn2_w_gu, ffn2_w_down, ffn2_post_g):
    h = x
    col_split = [RWKV_COLS, RWKV_COLS + DIFF_QK_WIDTH, RWKV_COLS + 2 * DIFF_QK_WIDTH,
                 RWKV_COLS + DIFF_COLS, RWKV_COLS + DIFF_COLS + D_MODEL]
    for i in range(DEPTH):
        lam_init = 0.8 - 0.6 * math.exp(-0.3 * i)
        f = swiglu_ffn(rms_norm(h, ffn1_pre_g[i]), ffn1_w_gu[i], ffn1_w_down[i])
        h = h + 0.5 * rms_norm(f, ffn1_post_g[i])
        u = rms_norm(h, mix_pre_g[i])
        proj = u @ w_in[i]
        rw_seg, q, k, v, gate_a, gate_b = jnp.split(proj, col_split, axis=-1)
        rw_seg = centred_token_shift(rw_seg, mu_prev[i], mu_next[i])
        y_a = rwkv7_branch(rw_seg, w0[i], w_up[i], a0[i], a_up[i], g_up[i], k_k[i], k_a[i], r_k[i],
                           gn_w[i], gn_b[i])
        y_b = diff_attention_branch(q, k, v, lambda_q1[i], lambda_k1[i], lambda_q2[i], lambda_k2[i],
                                    subln_g[i], lam_init)
        merged = jax.nn.sigmoid(gate_a) * (y_a @ w_branch_a[i]) + jax.nn.sigmoid(gate_b) * (y_b @ w_branch_b[i])
        h = h + rms_norm(merged @ w_out[i], mix_post_g[i])
        f = swiglu_ffn(rms_norm(h, ffn2_pre_g[i]), ffn2_w_gu[i], ffn2_w_down[i])
        h = h + 0.5 * rms_norm(f, ffn2_post_g[i])
    return h
```

```cpp
#include <hip/hip_runtime.h>
#include <hip/hip_cooperative_groups.h>
#include <cstdio>
#include <cstdint>
namespace pg8 {
#define PG8_LAS __attribute__((address_space(3)))
typedef unsigned short bf16_t;
typedef short bf16x8 __attribute__((ext_vector_type(8)));
typedef float f32x4 __attribute__((ext_vector_type(4)));
typedef unsigned u32x4 __attribute__((ext_vector_type(4)));
constexpr int BM = 256, BK = 64, HALF = 128, HTB = HALF * BK * 2  , STAGE_BYTES = 8 * HTB, NXCD = 8, WGM = 8;

__host__ __device__ __forceinline__ int lds_byte(int r, int c) { const int st = (r >> 4) * 2 + (c >> 5), rr = r & 15, cc = c & 31, ob = rr * 64 + cc * 2; return st * 1024 + (ob ^ (((ob >> 9) & 1) << 5)); }
__host__ __device__ __forceinline__ void stage_rc(int b, int& R, int& C) { const int st = b / 1024, sb = b % 1024, swz = sb ^ (((sb >> 9) & 1) << 5); R = (st >> 1) * 16 + swz / 64; C = (st & 1) * 32 + (swz % 64) / 2; }
__host__ __device__ __forceinline__ int perm32(int rho) { const int n = rho >> 4, i = rho & 15; return 8 * (i >> 2) + 4 * n + (i & 3); }

struct Unit { int pm, pn, sel; };
struct Gemm { const bf16_t* A; const bf16_t* Bt; int M, N, K; const bf16_t* A2; const bf16_t* Bt2; };

struct StaticOrder {
    int nM, nN, nwg, G, c;
    __host__ __device__ void init(int M, int N, int G_, int c_) { nM = M / BM; nN = N / BM; nwg = nM * nN; G = G_; c = c_; }
    __host__ __device__ bool next(int i, Unit& u) const {
        const long L = (long)i * G + c; if (L >= nwg) return false;
        int wgid = (int)L; { const int q = nwg / NXCD, r = nwg % NXCD, xcd = wgid % NXCD, off = wgid / NXCD; wgid = (xcd < r ? xcd * (q + 1) : r * (q + 1) + (xcd - r) * q) + off; }
        const int nig = WGM * nN, gid = wgid / nig, fm = gid * WGM, gsz = (nM - fm) < WGM ? (nM - fm) : WGM;
        u.pm = fm + ((wgid % nig) % gsz); u.pn = (wgid % nig) / gsz; u.sel = 0; return true;
    }
    __device__ __forceinline__ void a_ready(const Unit&) const {}
    __device__ __forceinline__ void done(const Unit&) const {}
};


typedef float f32x2c_t __attribute__((ext_vector_type(2))); typedef __bf16 bf16x2c_t __attribute__((ext_vector_type(2)));
__device__ __forceinline__ unsigned cvt_pk_bf16(float lo, float hi) { f32x2c_t v = {lo, hi}; bf16x2c_t b = __builtin_convertvector(v, bf16x2c_t); return __builtin_bit_cast(unsigned, b); }
__device__ __forceinline__ float sigm(float x) { return __builtin_amdgcn_rcpf(1.0f + __builtin_amdgcn_exp2f(-1.4426950408889634f * x)); }
__device__ __forceinline__ u32x4 pack8(const f32x4 a, const f32x4 b) { u32x4 w; w.x = cvt_pk_bf16(a[0], a[1]); w.y = cvt_pk_bf16(a[2], a[3]); w.z = cvt_pk_bf16(b[0], b[1]); w.w = cvt_pk_bf16(b[2], b[3]); return w; }
__device__ __forceinline__ f32x4 unpk_lo(const u32x4 w) { return (f32x4){__uint_as_float(w.x << 16), __uint_as_float(w.x & 0xffff0000u), __uint_as_float(w.y << 16), __uint_as_float(w.y & 0xffff0000u)}; }
__device__ __forceinline__ f32x4 unpk_hi(const u32x4 w) { return (f32x4){__uint_as_float(w.z << 16), __uint_as_float(w.z & 0xffff0000u), __uint_as_float(w.w << 16), __uint_as_float(w.w & 0xffff0000u)}; }

template <int ACT>
__device__ __forceinline__ void store_nat_bf16(const f32x4 (&acc)[2][2][4][2], bf16_t* O, int ldc, int row0, int colt, int wc, int fq, const float* bias) {
    const int col0 = colt + wc * 32 + 8 * fq;
    f32x4 bv[2][2];
#pragma unroll
    for (int bj = 0; bj < 2; ++bj)
#pragma unroll
        for (int n = 0; n < 2; ++n) bv[bj][n] = bias ? *(const f32x4*)(bias + col0 + bj * HALF + 4 * n) : (f32x4){0.f, 0.f, 0.f, 0.f};
#pragma unroll
    for (int ai = 0; ai < 2; ++ai)
#pragma unroll
        for (int m = 0; m < 4; ++m) { bf16_t* rowp = O + (size_t)(row0 + ai * HALF + m * 16) * ldc + col0;
#pragma unroll
            for (int bj = 0; bj < 2; ++bj) { f32x4 v0 = acc[ai][bj][m][0] + bv[bj][0], v1 = acc[ai][bj][m][1] + bv[bj][1];
                if (ACT >= 1) {
#pragma unroll
                    for (int e = 0; e < 4; ++e) { v0[e] = sigm(v0[e]); v1[e] = sigm(v1[e]); }
                    if (ACT == 2) { v0 = v0 * 0.6065306597f; v1 = v1 * 0.6065306597f; } }
                *(u32x4*)(rowp + bj * HALF) = pack8(v0, v1); } }
}

struct EpiSwiglu {
    static constexpr bool PERM = true, AFTER_DRAIN = false;
    bf16_t* O; int ldc;
    __device__ __forceinline__ void operator()(const f32x4 (&acc)[2][2][4][2], const Unit& u, int wr, int wc, int fr, int fq) const {
        const int row0 = u.pm * BM + wr * 64 + fr, col0 = u.pn * HALF + wc * 32 + 8 * fq;
#pragma unroll
        for (int ai = 0; ai < 2; ++ai)
#pragma unroll
            for (int m = 0; m < 4; ++m) { bf16_t* rowp = O + (size_t)(row0 + ai * HALF + m * 16) * ldc + col0;
                f32x4 v0, v1;
#pragma unroll
                for (int e = 0; e < 4; ++e) { const float g0 = acc[ai][0][m][0][e], g1 = acc[ai][0][m][1][e];
                    v0[e] = g0 * sigm(g0) * acc[ai][1][m][0][e]; v1[e] = g1 * sigm(g1) * acc[ai][1][m][1][e]; }
                *(u32x4*)rowp = pack8(v0, v1); }
    }
};

struct EpiF32 {
    static constexpr bool PERM = true, AFTER_DRAIN = false;
    float* O; int ldc;
    __device__ __forceinline__ void operator()(const f32x4 (&acc)[2][2][4][2], const Unit& u, int wr, int wc, int fr, int fq) const {
        const int row0 = u.pm * BM + wr * 64 + fr, col0 = u.pn * BM + wc * 32 + 8 * fq;
#pragma unroll
        for (int ai = 0; ai < 2; ++ai)
#pragma unroll
            for (int m = 0; m < 4; ++m) { float* rowp = O + (size_t)(row0 + ai * HALF + m * 16) * ldc + col0;
#pragma unroll
                for (int bj = 0; bj < 2; ++bj) { *(f32x4*)(rowp + bj * HALF) = acc[ai][bj][m][0]; *(f32x4*)(rowp + bj * HALF + 4) = acc[ai][bj][m][1]; } }
    }
};

struct EpiIn {
    static constexpr bool PERM = true, AFTER_DRAIN = false;
    bf16_t *RW, *Q, *K, *V, *GATES; float* LR; const float* rope; float qscale;
    __device__ __forceinline__ void operator()(const f32x4 (&acc)[2][2][4][2], const Unit& u, int wr, int wc, int fr, int fq) const {
        const int pn = u.pn, row0 = u.pm * BM + wr * 64 + fr;
        if (pn < 12) store_nat_bf16<0>(acc, RW, 3072, row0, pn * 256, wc, fq, nullptr);
        else if (pn < 14) {
            const int col0 = (pn - 12) * 256 + wc * 32 + 8 * fq;
#pragma unroll
            for (int ai = 0; ai < 2; ++ai)
#pragma unroll
                for (int m = 0; m < 4; ++m) { float* rowp = LR + (size_t)(row0 + ai * HALF + m * 16) * 512 + col0;
#pragma unroll
                    for (int bj = 0; bj < 2; ++bj) { *(f32x4*)(rowp + bj * HALF) = acc[ai][bj][m][0]; *(f32x4*)(rowp + bj * HALF + 4) = acc[ai][bj][m][1]; } }
        } else if (pn < 22) {
            const bool isk = pn >= 18; bf16_t* base = isk ? K : Q; const float sc = isk ? 1.0f : qscale;
            const int head = 4 * ((pn - 14) & 3) + wc;
#pragma unroll
            for (int ai = 0; ai < 2; ++ai)
#pragma unroll
                for (int m = 0; m < 4; ++m) { const int row = row0 + ai * HALF + m * 16; const float* cp = rope + (size_t)(row & 2047) * 64 + 8 * fq;
                    const f32x4 c0 = *(const f32x4*)cp, c1 = *(const f32x4*)(cp + 4), s0 = *(const f32x4*)(cp + 32), s1 = *(const f32x4*)(cp + 36);
                    const f32x4 x1a = acc[ai][0][m][0], x1b = acc[ai][0][m][1], x2a = acc[ai][1][m][0], x2b = acc[ai][1][m][1];
                    const f32x4 o1a = (x1a * c0 - x2a * s0) * sc, o1b = (x1b * c1 - x2b * s1) * sc, o2a = (x2a * c0 + x1a * s0) * sc, o2b = (x2b * c1 + x1b * s1) * sc;
                    bf16_t* rowp = base + (size_t)row * 1024 + head * 64 + 8 * fq;
                    *(u32x4*)rowp = pack8(o1a, o1b); *(u32x4*)(rowp + 32) = pack8(o2a, o2b); }
        } else if (pn < 26) store_nat_bf16<0>(acc, V, 1024, row0, (pn - 22) * 256, wc, fq, nullptr);
        else store_nat_bf16<1>(acc, GATES, 4096, row0, (pn - 26) * 256, wc, fq, nullptr);
    }
};

struct EpiLora {
    static constexpr bool PERM = true, AFTER_DRAIN = false;
    bf16_t* EAG; bf16_t* GG; const float* w0; const float* a0;
    __device__ __forceinline__ void operator()(const f32x4 (&acc)[2][2][4][2], const Unit& u, int wr, int wc, int fr, int fq) const {
        const int ob = u.pn >> 2, colt = (u.pn & 3) * 256, row0 = u.pm * BM + wr * 64 + fr;
        bf16_t* O = EAG + (size_t)ob * 8192 * 1024;
        if (ob < 2) store_nat_bf16<2>(acc, O, 1024, row0, colt, wc, fq, w0 + ob * 1024);
        else if (ob < 4) store_nat_bf16<1>(acc, O, 1024, row0, colt, wc, fq, a0 + (ob - 2) * 1024);
        else store_nat_bf16<0>(acc, GG, 1024, row0, colt, wc, fq, nullptr);
    }
};

struct EpiBranch {
    static constexpr bool PERM = true, AFTER_DRAIN = false;
    float* P; bf16_t* MERGED; const bf16_t* GATES;
    __device__ __forceinline__ void operator()(const f32x4 (&acc)[2][2][4][2], const Unit& u, int wr, int wc, int fr, int fq) const {
        const int row0 = u.pm * BM + wr * 64 + fr, col0 = u.pn * BM + wc * 32 + 8 * fq;
#pragma unroll
        for (int ai = 0; ai < 2; ++ai)
#pragma unroll
            for (int m = 0; m < 4; ++m) { const size_t row = (size_t)(row0 + ai * HALF + m * 16);
#pragma unroll
                for (int bj = 0; bj < 2; ++bj) { const int col = col0 + bj * HALF;
                    const u32x4 gw = *(const u32x4*)(GATES + row * 4096 + u.sel * 2048 + col);
                    const f32x4 v0 = acc[ai][bj][m][0] * unpk_lo(gw), v1 = acc[ai][bj][m][1] * unpk_hi(gw);
                    float* pp = P + row * 2048 + col;
                    if (u.sel == 0) { *(f32x4*)pp = v0; *(f32x4*)(pp + 4) = v1; }
                    else { const f32x4 p0 = *(const f32x4*)pp, p1 = *(const f32x4*)(pp + 4); *(u32x4*)(MERGED + row * 2048 + col) = pack8(p0 + v0, p1 + v1); } } }
    }
};
struct BranchOrder {
    StaticOrder so;
    __host__ __device__ bool next(int i, Unit& u) const { if (!so.next(i >> 1, u)) return false; u.sel = i & 1; return true; }
    __device__ __forceinline__ void a_ready(const Unit&) const {}
    __device__ __forceinline__ void done(const Unit&) const {}
};
template <class Epi, class Sched, bool ALIGN_EPI = false, bool SP2 = false>
__device__ __forceinline__ void gemm_phase(PG8_LAS unsigned char* lds, const Gemm g, const Sched& S, const Epi& E) {
    int tid = threadIdx.x; asm volatile("" : "+v"(tid));
    const int wid = __builtin_amdgcn_readfirstlane(tid >> 6), lane = tid & 63, wr = wid >> 2, wc = wid & 3, fr = lane & 15, fq = lane >> 4;
    const int K = g.K, nt = K / BK;
    unsigned voffA[2], voffB[2];
#pragma unroll
    for (int i = 0; i < 2; ++i) { int R, C; stage_rc(tid * 16 + i * 8192, R, C); const int Rb = Epi::PERM ? ((R & ~31) + perm32(R & 31)) : R;
        voffA[i] = (unsigned)(R * K + C) * 2u; voffB[i] = (unsigned)(Rb * K + C) * 2u; }
    const size_t kstep = (size_t)(BK * 2);
    const size_t hstep = (size_t)HALF * K * 2;
    const size_t tstep = 2 * hstep;
    const unsigned ldsw = (unsigned)wid * 1024u;
    const int aoff = lds_byte(wr * 64 + fr, fq * 8), boff = lds_byte(wc * 32 + fr, fq * 8);
#define PG8_SA(b, h) (((b) * 2 + (h)) * HTB)
#define PG8_SB(b, h) ((4 + (b) * 2 + (h)) * HTB)
#define PG8_STAGE(bufoff, gbase, voff) do { _Pragma("unroll") for (int _i = 0; _i < 2; ++_i) \
        __builtin_amdgcn_global_load_lds((const unsigned*)((const char*)(gbase) + (voff)[_i]), (PG8_LAS unsigned*)(lds + (bufoff) + ldsw + _i * 8192), 16, 0, 0); } while (0)
#define PG8_LDA(dst, b, h) do { _Pragma("unroll") for (int m = 0; m < 4; ++m) _Pragma("unroll") for (int k = 0; k < 2; ++k) dst[m][k] = *(const PG8_LAS bf16x8*)(lds + PG8_SA(b, h) + aoff + m * 2048 + k * 1024); } while (0)
#define PG8_LDB(dst, b, h) do { _Pragma("unroll") for (int n = 0; n < 2; ++n) _Pragma("unroll") for (int k = 0; k < 2; ++k) dst[n][k] = *(const PG8_LAS bf16x8*)(lds + PG8_SB(b, h) + boff + n * 2048 + k * 1024); } while (0)
#define PG8_MMA(ai, bj, At, Bt) do { __builtin_amdgcn_s_setprio(1); _Pragma("unroll") for (int m = 0; m < 4; ++m) _Pragma("unroll") for (int n = 0; n < 2; ++n) _Pragma("unroll") for (int k = 0; k < 2; ++k) \
        acc[ai][bj][m][n] = __builtin_amdgcn_mfma_f32_16x16x32_bf16(Bt[n][k], At[m][k], acc[ai][bj][m][n], 0, 0, 0); __builtin_amdgcn_s_setprio(0); } while (0)
#define PG8_WAIT_V(n) asm volatile("s_waitcnt vmcnt(" #n ")" ::: "memory")
#define PG8_WAIT_L(n) asm volatile("s_waitcnt lgkmcnt(" #n ")" ::: "memory")
#define PG8_BAR __builtin_amdgcn_s_barrier()
#define PG8_SCHED __builtin_amdgcn_sched_barrier(0)
    Unit cur, nxt; int ui = 0;
    if (!S.next(0, cur)) return;
    f32x4 acc[2][2][4][2];
#pragma unroll
    for (int a = 0; a < 2; ++a)
#pragma unroll
        for (int b = 0; b < 2; ++b)
#pragma unroll
            for (int m = 0; m < 4; ++m)
#pragma unroll
                for (int n = 0; n < 2; ++n) acc[a][b][m][n] = (f32x4){0.f, 0.f, 0.f, 0.f};
    bf16x8 At[4][2], B0[2][2], B1[2][2];
    const char* cA = (const char*)(cur.sel ? g.A2 : g.A) + (size_t)cur.pm * tstep; const char* cB = (const char*)(cur.sel ? g.Bt2 : g.Bt) + (size_t)cur.pn * tstep;
    S.a_ready(cur);
    if constexpr (SP2) {
        PG8_STAGE(PG8_SB(0, 0), cB, voffB); PG8_STAGE(PG8_SB(0, 1), cB + hstep, voffB); PG8_STAGE(PG8_SA(0, 0), cA, voffA); PG8_STAGE(PG8_SA(0, 1), cA + hstep, voffA);
        if (wr == 1) PG8_BAR;
        PG8_WAIT_V(2); PG8_BAR;
        PG8_STAGE(PG8_SB(1, 0), cB + kstep, voffB); PG8_STAGE(PG8_SA(1, 0), cA + kstep, voffA); PG8_STAGE(PG8_SB(1, 1), cB + hstep + kstep, voffB);
        PG8_WAIT_V(6); PG8_BAR;
    } else {
        PG8_STAGE(PG8_SB(0, 0), cB, voffB); PG8_STAGE(PG8_SA(0, 0), cA, voffA); PG8_STAGE(PG8_SB(0, 1), cB + hstep, voffB); PG8_STAGE(PG8_SA(0, 1), cA + hstep, voffA);
        if (wr == 1) PG8_BAR;
        PG8_WAIT_V(4); PG8_BAR;
        PG8_STAGE(PG8_SB(1, 0), cB + kstep, voffB); PG8_STAGE(PG8_SA(1, 0), cA + kstep, voffA); PG8_STAGE(PG8_SB(1, 1), cB + hstep + kstep, voffB);
        PG8_WAIT_V(6); PG8_BAR;
    }
    for (;;) {
        const bool has_next = S.next(ui + 1, nxt);
        const char* nA = has_next ? (const char*)(nxt.sel ? g.A2 : g.A) + (size_t)nxt.pm * tstep : cA; const char* nB = has_next ? (const char*)(nxt.sel ? g.Bt2 : g.Bt) + (size_t)nxt.pn * tstep : cB;
        for (int t = 0; t < nt; t += 2) {
            const bool last = (t == nt - 2);
            const char* a1 = cA + (size_t)(t + 1) * kstep;
            const char* a2 = last ? nA : cA + (size_t)(t + 2) * kstep; const char* b2 = last ? nB : cB + (size_t)(t + 2) * kstep;
            const char* a3 = a2 + kstep; const char* b3 = b2 + kstep;
            if (last && has_next) S.a_ready(nxt);
            if constexpr (SP2) {
            PG8_LDB(B0, 0, 0); PG8_LDB(B1, 0, 1); PG8_SCHED; PG8_LDA(At, 0, 0); PG8_STAGE(PG8_SA(1, 1), a1 + hstep, voffA);
            PG8_WAIT_V(8); PG8_WAIT_L(0); PG8_BAR; PG8_MMA(0, 0, At, B0); PG8_MMA(0, 1, At, B1); PG8_BAR; PG8_SCHED;
            PG8_LDA(At, 0, 1); PG8_STAGE(PG8_SB(0, 0), b2, voffB); PG8_STAGE(PG8_SB(0, 1), b2 + hstep, voffB); PG8_STAGE(PG8_SA(0, 0), a2, voffA);
            PG8_WAIT_V(8); PG8_WAIT_L(0); PG8_BAR; PG8_MMA(1, 0, At, B0); PG8_MMA(1, 1, At, B1); PG8_BAR; PG8_SCHED;
            PG8_LDB(B0, 1, 0); PG8_LDB(B1, 1, 1); PG8_SCHED; PG8_LDA(At, 1, 0); PG8_STAGE(PG8_SA(0, 1), a2 + hstep, voffA);
            PG8_WAIT_V(8); PG8_WAIT_L(0); PG8_BAR; PG8_MMA(0, 0, At, B0); PG8_MMA(0, 1, At, B1); PG8_BAR; PG8_SCHED;
            PG8_LDA(At, 1, 1); PG8_STAGE(PG8_SB(1, 0), b3, voffB); PG8_STAGE(PG8_SB(1, 1), b3 + hstep, voffB); PG8_STAGE(PG8_SA(1, 0), a3, voffA);
            PG8_WAIT_V(8); PG8_WAIT_L(0); PG8_BAR; PG8_MMA(1, 0, At, B0); PG8_MMA(1, 1, At, B1); PG8_BAR; PG8_SCHED;
            } else {
            PG8_LDB(B0, 0, 0); PG8_SCHED; PG8_LDA(At, 0, 0); PG8_STAGE(PG8_SA(1, 1), a1 + hstep, voffA);
            PG8_WAIT_L(8); PG8_BAR; PG8_WAIT_L(0); PG8_MMA(0, 0, At, B0); PG8_BAR; PG8_SCHED;
            PG8_LDB(B1, 0, 1); PG8_STAGE(PG8_SB(0, 0), b2, voffB);
            PG8_BAR; PG8_WAIT_L(0); PG8_MMA(0, 1, At, B1); PG8_BAR;
            PG8_LDA(At, 0, 1); PG8_STAGE(PG8_SA(0, 0), a2, voffA);
            PG8_BAR; PG8_WAIT_L(0); PG8_MMA(1, 0, At, B0); PG8_BAR; PG8_SCHED;
            PG8_STAGE(PG8_SB(0, 1), b2 + hstep, voffB);
            PG8_WAIT_V(6); PG8_BAR; PG8_MMA(1, 1, At, B1); PG8_BAR;
            PG8_LDB(B0, 1, 0); PG8_SCHED; PG8_LDA(At, 1, 0); PG8_STAGE(PG8_SA(0, 1), a2 + hstep, voffA);
            PG8_WAIT_L(8); PG8_BAR; PG8_WAIT_L(0); PG8_MMA(0, 0, At, B0); PG8_BAR; PG8_SCHED;
            PG8_LDB(B1, 1, 1); PG8_STAGE(PG8_SB(1, 0), b3, voffB);
            PG8_BAR; PG8_WAIT_L(0); PG8_MMA(0, 1, At, B1); PG8_BAR;
            PG8_LDA(At, 1, 1); PG8_STAGE(PG8_SA(1, 0), a3, voffA);
            PG8_BAR; PG8_WAIT_L(0); PG8_MMA(1, 0, At, B0); PG8_BAR; PG8_SCHED;
            PG8_STAGE(PG8_SB(1, 1), b3 + hstep, voffB);
            PG8_WAIT_V(6); PG8_BAR; PG8_MMA(1, 1, At, B1); PG8_BAR;
            }
        }
        if constexpr (ALIGN_EPI) { if (wr == 0) PG8_BAR; }
        if constexpr (!Epi::AFTER_DRAIN) { E(acc, cur, wr, wc, fr, fq); S.done(cur); }
        if (!has_next) break;
#pragma unroll
        for (int a = 0; a < 2; ++a)
#pragma unroll
            for (int b = 0; b < 2; ++b)
#pragma unroll
                for (int m = 0; m < 4; ++m)
#pragma unroll
                    for (int n = 0; n < 2; ++n) acc[a][b][m][n] = (f32x4){0.f, 0.f, 0.f, 0.f};
        cur = nxt; cA = nA; cB = nB; ++ui;
        if constexpr (ALIGN_EPI) { if (wr == 1) PG8_BAR; }
    }
    PG8_WAIT_V(0);
    if constexpr (!ALIGN_EPI) { if (wr == 0) PG8_BAR; }
    PG8_BAR;
    if constexpr (Epi::AFTER_DRAIN) { E.fused(acc, cur, wr, wc, fr, fq, lds, wid, lane); S.done(cur); }
#undef PG8_SA
#undef PG8_SB
#undef PG8_STAGE
#undef PG8_LDA
#undef PG8_LDB
#undef PG8_MMA
#undef PG8_WAIT_V
#undef PG8_WAIT_L
#undef PG8_BAR
#undef PG8_SCHED
}
}

#include <hip/hip_bf16.h>
#include <cmath>
namespace attn_body {
using bf16=__hip_bfloat16;
using bf16x8=__attribute__((ext_vector_type(8)))short;
using s16x4=__attribute__((ext_vector_type(4)))short;
using f32x16=__attribute__((ext_vector_type(16)))float;
using u32x4=__attribute__((ext_vector_type(4)))unsigned;
constexpr int BATCH=4,NHEAD=16,SEQ=2048,D=64,DM=NHEAD*D,OPITCH=2048;
constexpr int NW=8,QBLK=32,QB=QBLK*NW,KVBLK=64,NQB=SEQ/QB;
constexpr int ATTN_PITCH=DM, ATTN_UNIT_ROWS=QB;
__device__ __forceinline__ int crow(int r,int hi){return (r&3)+8*(r>>2)+4*hi;}
#define SBAR() __builtin_amdgcn_sched_barrier(0)
__device__ __forceinline__ void cmask(f32x16&p0,f32x16&p1,int jb,int qrel,int hi){
  const float NEG=-INFINITY; int kb=64*jb+4*hi;
  #pragma unroll
  for(int r=0;r<16;++r){int kv=kb+(r&3)+8*(r>>2); if(kv>qrel)p0[r]=NEG; if(kv+32>qrel)p1[r]=NEG;}
}

constexpr int NSLOT=3, SLOTB=8192;
constexpr int LDS_K=0, LDS_V=NSLOT*SLOTB, LDS_WS=2*NSLOT*SLOTB, LDS_OST=LDS_WS+NW*64*4, LDS_BYTES=LDS_OST+NW*4096;
constexpr float C2=0.125f*1.4426950408889634f;
__device__ __forceinline__ void glds16(const void*gsrc,unsigned lds_dst){unsigned keep;
  asm volatile("s_mov_b32 %0, m0\n\ts_mov_b32 m0, %2\n\ts_nop 0\n\tglobal_load_lds_dwordx4 %1, off\n\ts_mov_b32 m0, %0":"=&s"(keep):"v"(gsrc),"s"(lds_dst):"memory");}
__device__ __forceinline__ float max3f(float a,float b,float c){float r;asm("v_max3_f32 %0, %1, %2, %3":"=v"(r):"v"(a),"v"(b),"v"(c));return r;}
__device__ __forceinline__ float max2f(float a,float b){float r;asm("v_max_f32_e32 %0, %1, %2":"=v"(r):"v"(a),"v"(b));return r;}
__device__ __forceinline__ float fadd_s(float a,float b){float r;asm("v_add_f32_e32 %0, %1, %2":"=v"(r):"v"(a),"v"(b));return r;}
__device__ __forceinline__ float fsub_s(float a,float b){float r;asm("v_sub_f32_e32 %0, %1, %2":"=v"(r):"v"(a),"v"(b));return r;}
typedef float f32x2_t __attribute__((ext_vector_type(2))); typedef __bf16 bf16x2_t __attribute__((ext_vector_type(2)));
__device__ __forceinline__ unsigned cvtpk_s(float lo,float hi){f32x2_t v={lo,hi};bf16x2_t b=__builtin_convertvector(v,bf16x2_t);return __builtin_bit_cast(unsigned,b);}
#define WAIT_BAR(N) asm volatile("s_waitcnt vmcnt(" #N ") lgkmcnt(0)\n\ts_barrier":::"memory")

__device__ __forceinline__ void qkt(f32x16&p0,f32x16&p1,const char*Kslot,const bf16x8*qr,const f32x16&negm,int r32,int hi){
  const char*kb=Kslot+hi*1024+r32*16;
  #pragma unroll
  for(int d0=0;d0<4;++d0){
    const bf16x8 b0=*reinterpret_cast<const bf16x8*>(kb+d0*2048);
    const bf16x8 b1=*reinterpret_cast<const bf16x8*>(kb+d0*2048+512);
    if(d0==0){p0=__builtin_amdgcn_mfma_f32_32x32x16_bf16(b0,qr[0],negm,0,0,0);p1=__builtin_amdgcn_mfma_f32_32x32x16_bf16(b1,qr[0],negm,0,0,0);}
    else{p0=__builtin_amdgcn_mfma_f32_32x32x16_bf16(b0,qr[d0],p0,0,0,0);p1=__builtin_amdgcn_mfma_f32_32x32x16_bf16(b1,qr[d0],p1,0,0,0);}}
}
typedef __attribute__((address_space(3))) const char* lds_cptr;
typedef short v4i16_t __attribute__((ext_vector_type(4)));
__device__ __forceinline__ void kload8(bf16x8*kf,lds_cptr kp){
  kf[0]=*(const __attribute__((address_space(3))) bf16x8*)(kp);      kf[1]=*(const __attribute__((address_space(3))) bf16x8*)(kp+512);
  kf[2]=*(const __attribute__((address_space(3))) bf16x8*)(kp+2048); kf[3]=*(const __attribute__((address_space(3))) bf16x8*)(kp+2560);
  kf[4]=*(const __attribute__((address_space(3))) bf16x8*)(kp+4096); kf[5]=*(const __attribute__((address_space(3))) bf16x8*)(kp+4608);
  kf[6]=*(const __attribute__((address_space(3))) bf16x8*)(kp+6144); kf[7]=*(const __attribute__((address_space(3))) bf16x8*)(kp+6656);
}
__device__ __forceinline__ void kload2(bf16x8*kf,lds_cptr kp,int j){ kf[2*j]=*(const __attribute__((address_space(3))) bf16x8*)(kp+j*2048); kf[2*j+1]=*(const __attribute__((address_space(3))) bf16x8*)(kp+j*2048+512); }
__device__ __forceinline__ s16x4 vtr(lds_cptr p){ return __builtin_bit_cast(s16x4,__builtin_amdgcn_ds_read_tr16_b64_v4i16((__attribute__((address_space(3))) v4i16_t*)p)); }
__device__ __forceinline__ float rowmax(const f32x16&p0,const f32x16&p1){
  float a=max3f(p0[0],p0[1],p1[0]),b=max3f(p0[2],p0[3],p1[1]);a=max3f(a,p1[2],p1[3]);
  #pragma unroll
  for(int r=4;r<16;r+=4){a=max3f(a,p0[r],p0[r+1]);b=max3f(b,p0[r+2],p0[r+3]);a=max3f(a,p1[r],p1[r+1]);b=max3f(b,p1[r+2],p1[r+3]);}
  const float m=max2f(a,b);
  auto rr=__builtin_amdgcn_permlane32_swap(__float_as_uint(m),__float_as_uint(m),false,false);
  return max2f(__uint_as_float(rr[0]),__uint_as_float(rr[1]));
}
__device__ __forceinline__ void pv(f32x16*o,int vb,bf16x8 pa0,bf16x8 pa1,bf16x8 pa2,bf16x8 pa3){
  #pragma unroll
  for(int d0=0;d0<2;++d0){s16x4 lo[4],hi[4];
    #pragma unroll
    for(int ks=0;ks<4;++ks){
      asm volatile("ds_read_b64_tr_b16 %0,%1 offset:%c2":"=&v"(lo[ks]):"v"(vb),"i"(d0*4096+ks*1024):"memory");
      asm volatile("ds_read_b64_tr_b16 %0,%1 offset:%c2":"=&v"(hi[ks]):"v"(vb),"i"(d0*4096+ks*1024+512):"memory");}
    asm volatile("s_waitcnt lgkmcnt(0)":::"memory");SBAR();
    #define PK(k) (bf16x8){lo[k][0],lo[k][1],lo[k][2],lo[k][3],hi[k][0],hi[k][1],hi[k][2],hi[k][3]}
    o[d0]=__builtin_amdgcn_mfma_f32_32x32x16_bf16(pa0,PK(0),o[d0],0,0,0);
    o[d0]=__builtin_amdgcn_mfma_f32_32x32x16_bf16(pa1,PK(1),o[d0],0,0,0);
    o[d0]=__builtin_amdgcn_mfma_f32_32x32x16_bf16(pa2,PK(2),o[d0],0,0,0);
    o[d0]=__builtin_amdgcn_mfma_f32_32x32x16_bf16(pa3,PK(3),o[d0],0,0,0);
    #undef PK
  }
}

#ifndef ATTN_STORE16
#define ATTN_STORE16(p,v) (*(u32x4*)(p)=(v))
#endif
template<int THRL> __device__ __forceinline__ void attn_unit(int b,int h,int vcol,int ocol,int qb,const bf16*Q,const bf16*__restrict__ K,const bf16*__restrict__ V,bf16*O,char*shm){
  int tid=threadIdx.x; asm volatile("":"+v"(tid)); const int lane=tid&63,r32=lane&31,hi=lane>>5; const int wid=__builtin_amdgcn_readfirstlane(tid>>6);
  const long rowbase=(long)b*SEQ; const int q0=qb*QB;
  const bf16*Qw=Q+(rowbase+q0+wid*QBLK)*DM+h*D;
  const bf16*Kh=K+rowbase*DM+h*D,*Vh=V+rowbase*DM+vcol;
  const unsigned lds0=(unsigned)(uintptr_t)shm;
  float*wsf=(float*)(shm+LDS_WS)+wid*64;
  const bf16*ksrc=Kh+(long)lane*DM+wid*8;
  const bf16*vsrc=Vh+(long)(16*(wid&3)+(lane>>2))*DM+(wid>>2)*32+(lane&3)*8;
  const unsigned kdst=lds0+LDS_K+wid*1024, vdst=lds0+LDS_V+wid*1024;
  #define DMA_K(t,slot) glds16(ksrc+(long)(t)*KVBLK*DM,(unsigned)__builtin_amdgcn_readfirstlane(kdst+(slot)))
  #define DMA_V(t,slot) glds16(vsrc+(long)(t)*KVBLK*DM,(unsigned)__builtin_amdgcn_readfirstlane(vdst+(slot)))
  const int vb0=(int)(lds0+LDS_V)+((lane>>4)&1)*32+(lane&3)*8+(4*hi+((lane&15)>>2))*64;
  const char*Kbase=shm+LDS_K; bf16x8 kf[8];
  const lds_cptr shm3=(lds_cptr)shm; const lds_cptr kp0=shm3+LDS_K+hi*1024+r32*16; const lds_cptr vp0=shm3+LDS_V+((lane>>4)&1)*32+(lane&3)*8+(4*hi+((lane&15)>>2))*64;
  const int NT=SEQ/KVBLK;
  DMA_K(0,0);DMA_V(0,0);DMA_K(1,SLOTB);
  bf16x8 qr[4];
  #pragma unroll
  for(int d0=0;d0<4;++d0)qr[d0]=*reinterpret_cast<const bf16x8*>(&Qw[(long)r32*DM+d0*16+hi*8]);
  float mhat=0.f,l_reg=0.f;f32x16 o[2];o[0]=f32x16{};o[1]=f32x16{};f32x16 negm=f32x16{};asm volatile("":"+v"(negm));
  const int qrel=wid*QBLK+r32;
  #define CMASK(P0,P1,t) do{}while(0)
  bool resc=false;
  #define START(P0,P1) do{ const float rm=rowmax(P0,P1); resc=false; \
    { const float dl=rm; mhat=fadd_s(mhat,dl); \
      _Pragma("unroll") for(int r=0;r<16;++r){P0[r]=fsub_s(P0[r],dl);P1[r]=fsub_s(P1[r],dl);} \
      _Pragma("unroll") for(int r=0;r<16;++r)negm[r]=-mhat; asm volatile("":"+v"(negm)); } \
    _Pragma("unroll") for(int r=0;r<16;++r)P0[r]=__builtin_amdgcn_exp2f(P0[r]); }while(0)
  #define RESC() do{ if(resc){ asm volatile("s_waitcnt lgkmcnt(0)":::"memory"); \
      _Pragma("unroll") for(int d_=0;d_<2;++d_) _Pragma("unroll") for(int r=0;r<16;++r)o[d_][r]*=wsf[crow(r,hi)]; } }while(0)
  f32x16 pA0,pA1,pB0,pB1;
  int sl_prev=0,sl_cur=0,sl_next=SLOTB;
  #define ROT() do{sl_prev=sl_cur;sl_cur=sl_next;sl_next=(sl_next==(NSLOT-1)*SLOTB)?0:sl_next+SLOTB;}while(0)
  DMA_K(2,2*SLOTB);
  WAIT_BAR(3);
  qkt(pA0,pA1,Kbase,qr,negm,r32,hi);asm volatile("s_nop 15\n\ts_nop 7":"+v"(pA0),"+v"(pA1));CMASK(pA0,pA1,0);
  START(pA0,pA1);
  _Pragma("unroll") for(int r=0;r<16;++r)pA1[r]=__builtin_amdgcn_exp2f(pA1[r]);
  WAIT_BAR(0);
  DMA_K(3,0);DMA_V(1,SLOTB);
  ROT();
  kload8(kf,kp0+sl_cur);
  WAIT_BAR(2);
  s16x4 vlo[8],vhi[8]; u32x4 pw0,pw1,pw2,pw3;
  #define PKW(P,B) cvtpk_s(P[B],P[B+1])
  #define PAF(k) __builtin_bit_cast(bf16x8,pw##k)
  #define VFR(i) (bf16x8){vlo[i][0],vlo[i][1],vlo[i][2],vlo[i][3],vhi[i][0],vhi[i][1],vhi[i][2],vhi[i][3]}
  #define PIN(x) asm volatile("":"+v"(x))
  #define MX3(a,b,c) __builtin_fmaxf(__builtin_fmaxf((a),(b)),(c))
  #define GAPA(MF,A0,A1,A2,A3,W0,W1,PW) do{ MF; sacc+=A0; sacc+=A1; sacc+=A2; sacc+=A3; PIN(sacc); W0; W1; PIN(PW); SBAR(); }while(0)
  #define EX(v) __builtin_amdgcn_exp2f(v)
  #define GAPB(MF,X,B) do{ MF; X[B]=EX(X[B]); X[B+1]=EX(X[B+1]); X[B+2]=EX(X[B+2]); X[B+3]=EX(X[B+3]); PIN(X); SBAR(); }while(0)
  #define VRD(i) do{ vlo[i]=vtr(vp_+(((i)>>2)*4096+((i)&3)*1024)); vhi[i]=vtr(vp_+(((i)>>2)*4096+((i)&3)*1024+512)); }while(0)
  #define KRD(G,j) do{ if(G){ kload2(kf,kp0+sl_next,j); SBAR(); } }while(0)
  #define STEP(C0,C1,P0,P1,t,GK,GV,GL) do{ SBAR(); \
    const lds_cptr vp_=vp0+sl_prev; \
    VRD(0); SBAR(); float sacc=(P0[0]+P0[1]); \
    GAPA(C0=__builtin_amdgcn_mfma_f32_32x32x16_bf16(kf[0],qr[0],negm,0,0,0), P0[2],P0[3],P0[4],P0[5],     pw0[0]=PKW(P0,0), pw0[1]=PKW(P0,2), pw0); \
    VRD(4); SBAR(); GAPA(C1=__builtin_amdgcn_mfma_f32_32x32x16_bf16(kf[1],qr[0],negm,0,0,0), P0[6],P0[7],P0[8],P0[9],     pw0[2]=PKW(P0,4), pw0[3]=PKW(P0,6), pw0); \
    VRD(1); SBAR(); GAPA(C0=__builtin_amdgcn_mfma_f32_32x32x16_bf16(kf[2],qr[1],C0,0,0,0),   P0[10],P0[11],P0[12],P0[13], pw1[0]=PKW(P0,8), pw1[1]=PKW(P0,10), pw1); \
    VRD(5); SBAR(); GAPA(C1=__builtin_amdgcn_mfma_f32_32x32x16_bf16(kf[3],qr[1],C1,0,0,0),   P0[14],P0[15],P1[0],P1[1],   pw1[2]=PKW(P0,12),pw1[3]=PKW(P0,14), pw1); \
    VRD(2); SBAR(); GAPA(C0=__builtin_amdgcn_mfma_f32_32x32x16_bf16(kf[4],qr[2],C0,0,0,0),   P1[2],P1[3],P1[4],P1[5],     pw2[0]=PKW(P1,0), pw2[1]=PKW(P1,2), pw2); \
    VRD(6); SBAR(); GAPA(C1=__builtin_amdgcn_mfma_f32_32x32x16_bf16(kf[5],qr[2],C1,0,0,0),   P1[6],P1[7],P1[8],P1[9],     pw2[2]=PKW(P1,4), pw2[3]=PKW(P1,6), pw2); \
    VRD(3); SBAR(); GAPA(C0=__builtin_amdgcn_mfma_f32_32x32x16_bf16(kf[6],qr[3],C0,0,0,0),   P1[10],P1[11],P1[12],P1[13], pw3[0]=PKW(P1,8), pw3[1]=PKW(P1,10), pw3); \
    VRD(7); SBAR(); GAPA(C1=__builtin_amdgcn_mfma_f32_32x32x16_bf16(kf[7],qr[3],C1,0,0,0),   P1[14],P1[15],0.f,0.f,       pw3[2]=PKW(P1,12),pw3[3]=PKW(P1,14), pw3); \
    l_reg+=sacc; \
    if(GK){DMA_K((t)+3,sl_cur);} if(GV){DMA_V((t)+1,sl_next);} \
    CMASK(C0,C1,t); \
    { float a=MX3(C0[0],C0[1],C1[0]),b=MX3(C0[2],C0[3],C1[1]); a=MX3(a,C1[2],C1[3]); \
      _Pragma("unroll") for(int r=4;r<16;r+=4){a=MX3(a,C0[r],C0[r+1]);b=MX3(b,C0[r+2],C0[r+3]);a=MX3(a,C1[r],C1[r+1]);b=MX3(b,C1[r+2],C1[r+3]);} \
      float rm=__builtin_fmaxf(a,b); { auto rr=__builtin_amdgcn_permlane32_swap(__float_as_uint(rm),__float_as_uint(rm),false,false); rm=__builtin_fmaxf(__uint_as_float(rr[0]),__uint_as_float(rr[1])); } \
      resc=false; \
      if(__builtin_expect(__any(rm>(float)THRL),0)){ const float dl=__builtin_fmaxf(rm,0.f); mhat+=dl; \
        _Pragma("unroll") for(int r=0;r<16;++r){C0[r]-=dl;C1[r]-=dl;} \
        _Pragma("unroll") for(int r=0;r<16;++r)negm[r]=-mhat; asm volatile("":"+v"(negm)); \
        const float f=__builtin_amdgcn_exp2f(-dl); l_reg*=f; if(hi==0)wsf[r32]=f; resc=true; } } \
    SBAR(); \
    GAPB(o[0]=__builtin_amdgcn_mfma_f32_32x32x16_bf16(PAF(0),VFR(0),o[0],0,0,0), C0,0); \
    GAPB(o[1]=__builtin_amdgcn_mfma_f32_32x32x16_bf16(PAF(0),VFR(4),o[1],0,0,0), C0,4); \
    KRD(GL,0); GAPB(o[0]=__builtin_amdgcn_mfma_f32_32x32x16_bf16(PAF(1),VFR(1),o[0],0,0,0), C0,8); \
    KRD(GL,1); GAPB(o[1]=__builtin_amdgcn_mfma_f32_32x32x16_bf16(PAF(1),VFR(5),o[1],0,0,0), C0,12); \
    KRD(GL,2); GAPB(o[0]=__builtin_amdgcn_mfma_f32_32x32x16_bf16(PAF(2),VFR(2),o[0],0,0,0), C1,0); \
    KRD(GL,3); GAPB(o[1]=__builtin_amdgcn_mfma_f32_32x32x16_bf16(PAF(2),VFR(6),o[1],0,0,0), C1,4); \
    GAPB(o[0]=__builtin_amdgcn_mfma_f32_32x32x16_bf16(PAF(3),VFR(3),o[0],0,0,0), C1,8); \
    GAPB(o[1]=__builtin_amdgcn_mfma_f32_32x32x16_bf16(PAF(3),VFR(7),o[1],0,0,0), C1,12); \
    }while(0)
  int t=1;
  #undef CMASK
  #define CMASK(P0,P1,t) do{}while(0)
  for(;t+5<NT;t+=2){
    STEP(pB0,pB1,pA0,pA1,t,true,true,true);     WAIT_BAR(2); RESC(); ROT();
    STEP(pA0,pA1,pB0,pB1,t+1,true,true,true);   WAIT_BAR(2); RESC(); ROT();
  }
  #undef CMASK
  #define CMASK(P0,P1,t) do{}while(0)
  #define ENDW(tt) do{ if((tt)+3<NT){WAIT_BAR(2);} else if((tt)+2<NT){WAIT_BAR(1);} else {WAIT_BAR(0);} }while(0)
  for(;t+1<NT;t+=2){
    STEP(pB0,pB1,pA0,pA1,t,(t+3<NT),(t+1<NT),(t+1<NT));       ENDW(t);   RESC(); ROT();
    STEP(pA0,pA1,pB0,pB1,t+1,(t+4<NT),(t+2<NT),(t+2<NT));     ENDW(t+1); RESC(); ROT();
  }
  STEP(pB0,pB1,pA0,pA1,NT-1,false,false,false); RESC();
  { float sacc=pB0[0]+pB0[1]; _Pragma("unroll") for(int r=2;r<16;++r)sacc+=pB0[r]; _Pragma("unroll") for(int r=0;r<16;++r)sacc+=pB1[r]; l_reg+=sacc;
    pw0=(u32x4){PKW(pB0,0),PKW(pB0,2),PKW(pB0,4),PKW(pB0,6)};pw1=(u32x4){PKW(pB0,8),PKW(pB0,10),PKW(pB0,12),PKW(pB0,14)};pw2=(u32x4){PKW(pB1,0),PKW(pB1,2),PKW(pB1,4),PKW(pB1,6)};pw3=(u32x4){PKW(pB1,8),PKW(pB1,10),PKW(pB1,12),PKW(pB1,14)};
    SBAR(); pv(o,vb0+sl_cur,PAF(0),PAF(1),PAF(2),PAF(3)); }
  #undef PKW
  #undef PAF
  #undef VFR
  #undef PIN
  #undef MX3
  #undef GAPA
  #undef GAPB
  #undef EX
  #undef VRD
  #undef KRD
  #undef STEP
  #undef ENDW
  {auto rr=__builtin_amdgcn_permlane32_swap(__float_as_uint(l_reg),__float_as_uint(l_reg),false,false);l_reg=__uint_as_float(rr[0])+__uint_as_float(rr[1]);}
  if(hi==0)wsf[32+r32]=l_reg;asm volatile("s_waitcnt lgkmcnt(0)":::"memory");
  float rli[16];
  #pragma unroll
  for(int r=0;r<16;++r)rli[r]=__builtin_amdgcn_rcpf(wsf[32+crow(r,hi)]);
  bf16*Ow=O+(rowbase+q0+wid*QBLK)*OPITCH+ocol;
  { bf16*stg=(bf16*)(shm+LDS_OST)+wid*2048;
    #pragma unroll
    for(int r=0;r<16;++r){const int orow=crow(r,hi);
      #pragma unroll
      for(int d0=0;d0<2;++d0)stg[orow*64+d0*32+r32]=__float2bfloat16(o[d0][r]*rli[r]);}
    asm volatile("s_waitcnt lgkmcnt(0)":::"memory");
    #pragma unroll
    for(int i=0;i<4;++i){const int row=i*8+(lane>>3),ch=lane&7; const u32x4 v=*(const u32x4*)(stg+row*64+ch*8); ATTN_STORE16(Ow+(long)row*OPITCH+ch*8,v);} }
  asm volatile("s_waitcnt lgkmcnt(0)\n\ts_barrier":::"memory");
  #undef DMA_K
  #undef DMA_V
  #undef CMASK
  #undef START
  #undef RESC
  #undef ROT
}
constexpr int ATTN_LDS_BYTES=LDS_BYTES;
#undef SBAR
#undef WAIT_BAR
}

#define GAS __attribute__((address_space(1)))
#define LAS __attribute__((address_space(3)))
typedef unsigned short bf16;
typedef unsigned v4u __attribute__((ext_vector_type(4)));
typedef float f32x4 __attribute__((ext_vector_type(4)));
typedef short bf16x8 __attribute__((ext_vector_type(8)));
typedef GAS unsigned gu32;
typedef GAS unsigned long long gu64;
#define RLX_AGENT __ATOMIC_RELAXED, __HIP_MEMORY_SCOPE_AGENT
#define LDS_WAIT() asm volatile("s_waitcnt lgkmcnt(0)" ::: "memory")
#define VM_WAIT() asm volatile("s_waitcnt vmcnt(0)" ::: "memory")
__device__ __forceinline__ unsigned long long rt() { return __builtin_amdgcn_s_memrealtime(); }
__device__ __forceinline__ unsigned f2bf(float f) { unsigned u = __builtin_bit_cast(unsigned, f); return (u + 0x7fffu + ((u >> 16) & 1u)) >> 16; }
__device__ __forceinline__ unsigned pk2(float lo, float hi) { return f2bf(lo) | (f2bf(hi) << 16); }

#define XB_TMO      128
#define XB_XCNT(j)  (256  + 64 * (j))
#define XB_XSUB(j)  (1280 + 64 * (j))
#define XB_XGEN(j)  (2304 + 64 * (j))
#define XB_TOP      3328
#define XB_TOPGEN   3392
#define XCD_BAR_WORDS 3456
#define XB_SPIN_CAP (1u << 18)

__device__ __forceinline__ unsigned xb_ld(unsigned* p)              { return __hip_atomic_load(p, __ATOMIC_RELAXED, __HIP_MEMORY_SCOPE_AGENT); }
__device__ __forceinline__ unsigned xb_add(unsigned* p, unsigned v) { return __hip_atomic_fetch_add(p, v, __ATOMIC_RELAXED, __HIP_MEMORY_SCOPE_AGENT); }
__device__ __forceinline__ unsigned xb_xcc_id() { return (unsigned)__builtin_amdgcn_s_getreg((3 << 11) | 20) & 0xFu; }
#define XB_SPIN(cond, bar) do { unsigned _sp = 0; while (cond) { __builtin_amdgcn_s_sleep(1); \
    if ((++_sp & 255u) == 0u) { if (xb_ld(&(bar)[XB_TMO])) break; if (_sp > XB_SPIN_CAP) { atomicAdd(&(bar)[XB_TMO], 1u); break; } } } } while (0)

struct XcdBarrier {
    unsigned* bar; unsigned x;
    volatile LAS unsigned* st;
};

__device__ __forceinline__ XcdBarrier xcd_barrier_post(unsigned* bar, volatile LAS unsigned* st) {
    XcdBarrier b; b.bar = bar; b.x = xb_xcc_id(); b.st = st;
    if (threadIdx.x == 0) (void)xb_add(&bar[XB_XCNT(b.x)], 1u);
    return b;
}
__device__ __forceinline__ void xcd_barrier_complete(unsigned* bar, unsigned x, unsigned& nloc, unsigned& nx) {
    const unsigned G = gridDim.x * gridDim.y * gridDim.z;
    unsigned sum, cnt, mine, sp = 0u;
    for (;;) {
        sum = 0u; cnt = 0u; mine = 0u;
#pragma unroll
        for (unsigned j = 0; j < 16; ++j) { const unsigned c = xb_ld(&bar[XB_XCNT(j)]); sum += c; cnt += (c > 0u) ? 1u : 0u; mine = (j == x) ? c : mine; }
        if (sum == G) break;
        __builtin_amdgcn_s_sleep(1);
        if ((++sp & 255u) == 0u) { if (xb_ld(&bar[XB_TMO])) break; if (sp > XB_SPIN_CAP) { atomicAdd(&bar[XB_TMO], 1u); break; } }
    }
    nloc = mine > 0u ? mine : 1u; nx = cnt > 0u ? cnt : 1u;
}

__device__ __forceinline__ void xcd_barrier(const XcdBarrier& b) {
    asm volatile("s_waitcnt vmcnt(0)" ::: "memory");
    __syncthreads();
    if (threadIdx.x == 0) {
        unsigned* bar = b.bar;
        __builtin_amdgcn_s_waitcnt(0);
        unsigned nloc = b.st[0], nx = b.st[1];
        if (nloc == 0u) { xcd_barrier_complete(bar, b.x, nloc, nx); b.st[0] = nloc; b.st[1] = nx; }
        const unsigned old = xb_add(&bar[XB_XSUB(b.x)], 1u);
        const unsigned gen = old / nloc;
        if (old + 1u == (gen + 1u) * nloc) {
            __builtin_amdgcn_fence(__ATOMIC_RELEASE, "agent");
            asm volatile("s_waitcnt vmcnt(0)" ::: "memory");
            const unsigned og = xb_add(&bar[XB_TOP], 1u);
            const unsigned tg = og / nx;
            if (og + 1u == (tg + 1u) * nx) xb_add(&bar[XB_TOPGEN], 1u);
            else XB_SPIN(xb_ld(&bar[XB_TOPGEN]) == tg, bar);
            __builtin_amdgcn_fence(__ATOMIC_ACQUIRE, "agent");
            xb_add(&bar[XB_XGEN(b.x)], 1u);
            asm volatile("s_waitcnt vmcnt(0)" ::: "memory");
        } else {
            XB_SPIN(xb_ld(&bar[XB_XGEN(b.x)]) == gen, bar);
            __builtin_amdgcn_fence(__ATOMIC_ACQUIRE, "agent");
            asm volatile("s_waitcnt vmcnt(0)" ::: "memory");
        }
    }
    __syncthreads();
}


constexpr int NWAVES = 8;
constexpr int BATCH = 4, T = 2048, D = 2048, M = BATCH * T, FF = 5632, NGU = 2 * FF;
constexpr int RWC = 3072, IN_COLS = 10656, IN_PAD = 10752, NLORA = 5120, KLORA = 512;
constexpr float NORM_EPS = 1e-6f, GN_EPS = 64e-5f, SUBLN_EPS = 1e-5f, LAM_INIT = 0.2f;
constexpr float QSCALE = 0.125f * 1.4426950408889634f;

constexpr size_t MiB = 1u << 20;
constexpr size_t WS_CTL = 0, CTL_ZERO_BYTES = 1 * MiB;
constexpr size_t WS_ROPE = 1 * MiB;
constexpr size_t WS_WGU = 2 * MiB;
constexpr size_t WS_WDN = 46 * MiB;
constexpr size_t WS_WIN = 68 * MiB;
constexpr size_t WS_WA = 110 * MiB, WS_WB = 114 * MiB;
constexpr size_t WS_WOUT = 118 * MiB;
constexpr size_t WS_WLORA = 126 * MiB;
constexpr size_t WS_XN = 131 * MiB;
constexpr size_t WS_F = 163 * MiB;
constexpr size_t WS_ACT = 227 * MiB;
constexpr size_t WS_RW = 227 * MiB;
constexpr size_t WS_Q = 275 * MiB, WS_K = 291 * MiB, WS_V = 307 * MiB;
constexpr size_t WS_Y = 275 * MiB;
constexpr size_t WS_GATES = 323 * MiB;
constexpr size_t WS_LR = 387 * MiB;
constexpr size_t WS_G = 387 * MiB;
constexpr size_t WS_LA = 403 * MiB;
constexpr size_t WS_OATT = 411 * MiB;
constexpr size_t WS_END = 443 * MiB;
constexpr int CW_BAR = 4096;

constexpr int RING_OFF = 0, RING_BYTES = 131072;
constexpr int LDSCTL_OFF = RING_BYTES, MISC_OFF = LDSCTL_OFF + 320;
constexpr int LDS_BYTES = 147456;

struct Args { const float* in[32]; float* out; unsigned char* ws; int ph_lo, ph_hi, li, pad; };

__device__ __forceinline__ float wave_sum(float v) {
#pragma unroll
    for (int o = 1; o < 64; o <<= 1) v += __shfl_xor(v, o);
    return v;
}
template <int CTRL> __device__ __forceinline__ float dppf(float x) { return __builtin_bit_cast(float, __builtin_amdgcn_mov_dpp(__builtin_bit_cast(int, x), CTRL, 0xf, 0xf, true)); }
__device__ __forceinline__ float red8(float x) { x += dppf<0xB1>(x); x += dppf<0x4E>(x); x += dppf<0x141>(x); return x; }
__device__ __forceinline__ float red16(float x) { x = red8(x); x += dppf<0x128>(x); return x; }
__device__ __forceinline__ float bf2f(unsigned short h) { return __uint_as_float((unsigned)h << 16); }
__device__ __forceinline__ float bfsel(unsigned w, int lane) { return __uint_as_float((lane & 1) ? (w & 0xffff0000u) : (w << 16)); }
__device__ __forceinline__ float sigm_(float x) { return __builtin_amdgcn_rcpf(1.0f + __builtin_amdgcn_exp2f(-1.4426950408889634f * x)); }
typedef unsigned u32x2 __attribute__((ext_vector_type(2)));
__device__ __forceinline__ f32x4 unpk4(const u32x2 w) { return (f32x4){__uint_as_float(w.x << 16), __uint_as_float(w.x & 0xffff0000u), __uint_as_float(w.y << 16), __uint_as_float(w.y & 0xffff0000u)}; }

__device__ __forceinline__ void transpose_item(const float* W, int K, int N, bf16* WT, int k0, int n0, int drow0, LAS float* scr, int lane) {
#pragma unroll 8
    for (int i = 0; i < 32; ++i) { const int kk = 2 * i + (lane >> 5); scr[kk * 33 + (lane & 31)] = W[(size_t)(k0 + kk) * N + n0 + (lane & 31)]; }
    LDS_WAIT(); asm volatile("" ::: "memory");
    const int c = lane & 7;
#pragma unroll
    for (int j = 0; j < 4; ++j) { const int n = (lane >> 3) + 8 * j; const LAS float* s = scr + (8 * c) * 33 + n;
        v4u o; o.x = pk2(s[0 * 33], s[1 * 33]); o.y = pk2(s[2 * 33], s[3 * 33]); o.z = pk2(s[4 * 33], s[5 * 33]); o.w = pk2(s[6 * 33], s[7 * 33]);
        *(GAS v4u*)(WT + (size_t)(drow0 + n) * K + k0 + 8 * c) = o; }
    LDS_WAIT(); asm volatile("" ::: "memory");
}
__device__ __forceinline__ int map_gu(int n0) { const int which = n0 / FF, cc = n0 % FF; return 256 * (cc / 128) + 128 * which + (cc % 128); }
__device__ __forceinline__ int map_in(int n0) {
    if (n0 < 3488) return n0;
    if (n0 < 5536) { const int seg = n0 - 3488, l = seg & 255, hd = l >> 6, half = (l >> 5) & 1; return 3584 + (seg & ~255) + 128 * half + 32 * hd; }
    if (n0 < 6560) return 5632 + (n0 - 5536);
    return 6656 + (n0 - 6560);
}
__device__ __forceinline__ void conv_ffn_weights(const float* wgu, const float* wdn, unsigned char* ws, LAS float* scr, int gw, int NGW, int lane) {
    constexpr int I_GU = (D / 64) * (NGU / 32), I_DN = (FF / 64) * (D / 32);
    for (int it = gw; it < I_GU + I_DN; it += NGW) {
        if (it < I_GU) { const int nb = it % (NGU / 32), kb = it / (NGU / 32); transpose_item(wgu, D, NGU, (bf16*)(ws + WS_WGU), kb * 64, nb * 32, map_gu(nb * 32), scr, lane); }
        else { const int r = it - I_GU, nb = r % (D / 32), kb = r / (D / 32); transpose_item(wdn, FF, D, (bf16*)(ws + WS_WDN), kb * 64, nb * 32, nb * 32, scr, lane); }
    }
}
__device__ __forceinline__ void rms_row_to_bf16(const float* xrow, const float* g, bf16* orow, int lane) {
    const f32x4* xr = (const f32x4*)xrow + lane; const f32x4* gr = (const f32x4*)g + lane;
    f32x4 v[8]; float s = 0.f;
#pragma unroll
    for (int j = 0; j < 8; ++j) { v[j] = xr[64 * j]; s += (v[j].x * v[j].x + v[j].y * v[j].y) + (v[j].z * v[j].z + v[j].w * v[j].w); }
    const float rs = 1.0f / sqrtf(wave_sum(s) * (1.f / D) + NORM_EPS);
    u32x2* o8 = (u32x2*)orow + lane;
#pragma unroll
    for (int j = 0; j < 8; ++j) { const f32x4 gg = gr[64 * j]; const f32x4 y = v[j] * rs * gg; u32x2 w; w.x = pk2(y.x, y.y); w.y = pk2(y.z, y.w); o8[64 * j] = w; }
}
__device__ __forceinline__ void norm_phase(const float* Fb, const float* Hin, float* Hout, const float* gpost, float coef, const float* gpre, bf16* XN, int gw, int NGW, int lane) {
    for (int m = gw; m < M; m += NGW) {
        const f32x4* fr = (const f32x4*)(Fb + (size_t)m * D) + lane; const f32x4* hr = (const f32x4*)(Hin + (size_t)m * D) + lane; f32x4* ho = (f32x4*)(Hout + (size_t)m * D) + lane;
        f32x4 f[8], h[8]; float s = 0.f;
#pragma unroll
        for (int j = 0; j < 8; ++j) { f[j] = fr[64 * j]; h[j] = hr[64 * j]; }
#pragma unroll
        for (int j = 0; j < 8; ++j) s += (f[j].x * f[j].x + f[j].y * f[j].y) + (f[j].z * f[j].z + f[j].w * f[j].w);
        const float rs = coef / sqrtf(wave_sum(s) * (1.f / D) + NORM_EPS);
        float s2 = 0.f;
#pragma unroll
        for (int j = 0; j < 8; ++j) { const f32x4 gg = ((const f32x4*)gpost)[lane + 64 * j]; h[j] = h[j] + f[j] * rs * gg; ho[64 * j] = h[j];
            s2 += (h[j].x * h[j].x + h[j].y * h[j].y) + (h[j].z * h[j].z + h[j].w * h[j].w); }
        if (XN) {
            const float rs2 = 1.0f / sqrtf(wave_sum(s2) * (1.f / D) + NORM_EPS);
            u32x2* o8 = (u32x2*)(XN + (size_t)m * D) + lane;
#pragma unroll
            for (int j = 0; j < 8; ++j) { const f32x4 gg = ((const f32x4*)gpre)[lane + 64 * j]; const f32x4 y = h[j] * rs2 * gg; u32x2 w; w.x = pk2(y.x, y.y); w.y = pk2(y.z, y.w); o8[64 * j] = w; }
        }
    }
}

constexpr int SC_TC = 8, SC_STEP_F = 384, SC_NG = T / SC_TC;
__device__ __forceinline__ unsigned cld(const unsigned* p) { return __hip_atomic_load(p, __ATOMIC_RELAXED, __HIP_MEMORY_SCOPE_AGENT); }
struct ScanRaw { unsigned rr[10], kr[10], vr[10], ee[8], aa[8]; bool ok[10]; };
template <int DIR>
__device__ __forceinline__ void scan_fetch(ScanRaw& R, const bf16* RWb, const bf16* Eb, const bf16* Ab, int t0) {
    constexpr int ts = DIR ? -1 : 1;
#pragma unroll
    for (int p = 0; p < 10; ++p) { const int t = t0 + (p - 1) * ts; const bool ok = (t >= 0) && (t < T); const unsigned* rp = (const unsigned*)(RWb + (size_t)(ok ? t : 0) * RWC);
        R.rr[p] = cld(rp); R.kr[p] = cld(rp + 512); R.vr[p] = cld(rp + 1024); R.ok[p] = ok; }
#pragma unroll
    for (int q = 0; q < 8; ++q) { const size_t m = (size_t)(t0 + q * ts); R.ee[q] = cld((const unsigned*)(Eb + m * 1024)); R.aa[q] = cld((const unsigned*)(Ab + m * 1024)); }
}
__device__ __forceinline__ float wsum64(float x) {
    x += dppf<0xB1>(x); x += dppf<0x4E>(x); x += dppf<0x141>(x); x += dppf<0x128>(x);
    x += __shfl_xor(x, 16); x += __shfl_xor(x, 32); return x;
}
template <int DIR>
__device__ __forceinline__ void scan_prep(const ScanRaw& R, int lane, float mpr, float mnr, float mpk, float mnk, float mpv, float mnv, float kkc, float kac,
                                          float (&kk_)[8], float (&ww_)[8], float (&bb_)[8], float (&kd_)[8], float (&rq_)[8], float (&vv_)[8]) {
    float rr[10], kr[10], vr[10];
#pragma unroll
    for (int p = 0; p < 10; ++p) { rr[p] = R.ok[p] ? bfsel(R.rr[p], lane) : 0.f; kr[p] = R.ok[p] ? bfsel(R.kr[p], lane) : 0.f; vr[p] = R.ok[p] ? bfsel(R.vr[p], lane) : 0.f; }
#pragma unroll
    for (int q = 0; q < 8; ++q) {
        const int pc = q + 1, pp = DIR ? q + 2 : q, pn = DIR ? q : q + 2;
        const float r = rr[pc] + mpr * (rr[pp] - rr[pc]) + mnr * (rr[pn] - rr[pc]);
        const float k = kr[pc] + mpk * (kr[pp] - kr[pc]) + mnk * (kr[pn] - kr[pc]);
        const float v = vr[pc] + mpv * (vr[pp] - vr[pc]) + mnv * (vr[pn] - vr[pc]);
        const float a = bfsel(R.aa[q], lane), w = __builtin_amdgcn_exp2f(-1.4426950408889634f * bfsel(R.ee[q], lane));
        const float kq = k * kkc; const float n2 = wsum64(kq * kq); const float kk = kq * (1.0f / sqrtf(fmaxf(n2, 1e-24f)));
        kk_[q] = kk; ww_[q] = w; bb_[q] = kk * a; kd_[q] = k * (1.0f + (a - 1.0f) * kac); rq_[q] = r; vv_[q] = v;
    }
}
__device__ __forceinline__ void scan_phase(LAS unsigned char* lds, const bf16* RW, const bf16* EA, bf16* OS, const float* mu_prev, const float* mu_next, const float* k_k, const float* k_a,
                                           int vcu, int G, int wave, int lane) {
    (void)lds;
    for (int wg = vcu; wg < 256; wg += G) {
        const int ch = wg >> 1, rh = wg & 1, d = ch >> 6, b = (ch >> 4) & 3, h = ch & 15;
        const size_t mb = (size_t)b * T;
        const int c_ = h * 64 + lane, ce = c_ & ~1;
        const float mpr = mu_prev[c_], mnr = mu_next[c_], mpk = mu_prev[1024 + c_], mnk = mu_next[1024 + c_], mpv = mu_prev[2048 + c_], mnv = mu_next[2048 + c_];
        const float kkc = k_k[c_], kac = k_a[c_];
        const bf16* RWb = RW + mb * RWC + ce; const bf16* Eb = EA + ((size_t)d * M + mb) * 1024 + ce; const bf16* Ab = EA + ((size_t)(2 + d) * M + mb) * 1024 + ce;
        const int rowbase = rh * 32 + wave * 4;
        float S[4] = {0.f, 0.f, 0.f, 0.f};
        bf16* Od = OS + ((size_t)(((((d * 4 + b) * 16 + h) * 2 + rh) * 8 + wave)) * T) * 4;
        u32x2 keep; keep.x = 0u; keep.y = 0u;
        float chk1 = 0.f, chk2 = 0.f, chk3 = 0.f;
        ScanRaw R;
        if (d == 0) scan_fetch<0>(R, RWb, Eb, Ab, 0); else scan_fetch<1>(R, RWb, Eb, Ab, T - 1);
        for (int g = 0; g < SC_NG; ++g) {
            float kk_[8], ww_[8], bb_[8], kd_[8], rq_[8], vv_[8];
#ifdef SCAN_VM0
            asm volatile("s_waitcnt vmcnt(0)" ::: "memory");
#endif
            if (d == 0) scan_prep<0>(R, lane, mpr, mnr, mpk, mnk, mpv, mnv, kkc, kac, kk_, ww_, bb_, kd_, rq_, vv_);
            else scan_prep<1>(R, lane, mpr, mnr, mpk, mnk, mpv, mnv, kkc, kac, kk_, ww_, bb_, kd_, rq_, vv_);
#ifdef DBG_CHK
#if DBG_RAW
#pragma unroll
            for (int p = 0; p < 10; ++p) if (R.ok[p]) chk1 += (bfsel(R.rr[p], lane) + 2.f * bfsel(R.kr[p], lane) + 3.f * bfsel(R.vr[p], lane)) * (float)(1 + p);
#pragma unroll
            for (int q = 0; q < 8; ++q) chk1 += (bfsel(R.ee[q], lane) + 2.f * bfsel(R.aa[q], lane)) * (float)(1 + q);
#else
#pragma unroll
            for (int q = 0; q < 8; ++q) chk1 += (kk_[q] + ww_[q] + bb_[q] + kd_[q] + rq_[q] + vv_[q]) * (float)(1 + ((g * 8 + q) & 15));
#endif
#endif
#ifdef DBG_PREP
            if (wave == 0 && rh == DBG_PREP - 1) { float* dbgp = (float*)OS + (size_t)(192 * MiB) / 4;
#pragma unroll
                for (int q = 0; q < 8; ++q) dbgp[((size_t)ch * T + g * SC_TC + q) * 64 + lane] = kk_[q] + ww_[q] + bb_[q] + kd_[q] + rq_[q] + vv_[q]; }
#endif
            if (g + 1 < SC_NG) { const int s0 = (g + 1) * SC_TC; if (d == 0) scan_fetch<0>(R, RWb, Eb, Ab, s0); else scan_fetch<1>(R, RWb, Eb, Ab, T - 1 - s0); }
#pragma unroll
            for (int s = 0; s < SC_TC; ++s) {
                float o[4];
#pragma unroll
                for (int r = 0; r < 4; ++r) {
                    const float vi = __uint_as_float((unsigned)__builtin_amdgcn_readlane((int)__float_as_uint(vv_[s]), rowbase + r));
                    const float sa = wsum64(S[r] * kk_[s]);
#ifdef DBG_CHK
                    chk2 += vi * (float)(1 + r); chk3 += sa;
#endif
                    S[r] = S[r] * ww_[s] - sa * bb_[s] + vi * kd_[s];
#if defined(DBG_O_SA)
                    o[r] = sa;
#elif defined(DBG_O_RQ)
                    o[r] = __uint_as_float((unsigned)__builtin_amdgcn_readlane((int)__float_as_uint(rq_[s]), rowbase + r));
#else
                    o[r] = wsum64(S[r] * rq_[s]);
#endif
                }
                const int sg = g * SC_TC + s, t = d ? (T - 1 - sg) : sg;
                (void)t;
#ifdef DBG_CONST_O
                o[0] = (float)(t & 255) + 1.0f; o[1] = (float)wave + 2.0f; o[2] = (float)(wg & 127) + 3.0f; o[3] = 4.0f;
#endif
                { const int slot = sg & 15; u32x2 w2; w2.x = pk2(o[0], o[1]); w2.y = pk2(o[2], o[3]);
                  if ((lane & 15) == slot) keep = w2;
                  if (slot == 15 && lane < 16) { const int sl = sg - 15 + lane, tl = d ? (T - 1 - sl) : sl; *(u32x2*)(Od + (size_t)tl * 4) = keep; } }
            }
        }
#ifdef DBG_CHK
        { float* dbgp = (float*)OS + (size_t)(192 * MiB) / 4; const size_t ix = (((size_t)wg * 8 + wave) * 4) * 64 + lane;
          dbgp[ix] = (DBG_CHK & 1) ? chk1 : 0.f; dbgp[ix + 64] = (DBG_CHK & 2) ? chk2 : 0.f; dbgp[ix + 128] = (DBG_CHK & 4) ? chk3 : 0.f; dbgp[ix + 192] = 0.f; }
#endif
#ifdef DBG_SFINAL
        { float* dbgp = (float*)OS + (size_t)(192 * MiB) / 4;
#pragma unroll
          for (int r = 0; r < 4; ++r) dbgp[(((size_t)wg * 8 + wave) * 4 + r) * 64 + lane] = S[r]; }
#endif
    }
}

__device__ __forceinline__ void post_phase(const bf16* RW, const bf16* EAG, const bf16* GG, const bf16* OS, const bf16* OATT, bf16* Y, const float* mu_prev, const float* mu_next, const float* k_a, const float* r_k,
                                           const float* gn_w, const float* gn_b, const float* lq1, const float* lk1, const float* lq2, const float* lk2, const float* subln_g, int gw, int NGW, int lane) {
    for (int it = gw; it < M * 4; it += NGW) {
        const int m = it >> 2, hq = it & 3, c0 = hq * 256 + 4 * lane, t = m & (T - 1);
        const bool hasp = t > 0, hasn = t < T - 1;
        const int hh = hq * 4 + (lane >> 4), i0 = (lane & 15) * 4, bb = m >> 11;
        const size_t oso = ((size_t)(((((bb * 16 + hh) * 2 + (i0 >> 5)) * 8 + ((i0 >> 2) & 7))) * T) + t) * 4;
        const f32x4 o = unpk4(*(const u32x2*)(OS + oso)) + unpk4(*(const u32x2*)(OS + (size_t)4 * 16 * 2 * 8 * T * 4 + oso));
        const bf16* rp = RW + (size_t)m * RWC + c0;
        f32x4 x[3], xp[3], xn[3];
#pragma unroll
        for (int q = 0; q < 3; ++q) { x[q] = unpk4(*(const u32x2*)(rp + q * 1024));
            xp[q] = unpk4(*(const u32x2*)(rp + q * 1024 - (hasp ? RWC : 0))); xn[q] = unpk4(*(const u32x2*)(rp + q * 1024 + (hasn ? RWC : 0)));
            if (!hasp) xp[q] = (f32x4){0.f, 0.f, 0.f, 0.f}; if (!hasn) xn[q] = (f32x4){0.f, 0.f, 0.f, 0.f};
            const f32x4 mp = *(const f32x4*)(mu_prev + q * 1024 + c0), mn = *(const f32x4*)(mu_next + q * 1024 + c0);
            x[q] = x[q] + mp * (xp[q] - x[q]) + mn * (xn[q] - x[q]); }
        const f32x4 a0 = unpk4(*(const u32x2*)(EAG + (size_t)(2 * M + m) * 1024 + c0)), a1 = unpk4(*(const u32x2*)(EAG + (size_t)(3 * M + m) * 1024 + c0));
        const f32x4 g = unpk4(*(const u32x2*)(GG + (size_t)m * 1024 + c0));
        const f32x4 ka = *(const f32x4*)(k_a + c0), rk = *(const f32x4*)(r_k + c0), gw4 = *(const f32x4*)(gn_w + c0), gb4 = *(const f32x4*)(gn_b + c0);
        const float mean = red16((o.x + o.y) + (o.z + o.w)) * (1.f / 64.f);
        const f32x4 dv = o - mean;
        const float var = red16((dv.x * dv.x + dv.y * dv.y) + (dv.z * dv.z + dv.w * dv.w)) * (1.f / 64.f);
        const float rstd = 1.0f / sqrtf(var + GN_EPS);
        const f32x4 ksum = x[1] * (2.0f + (a0 + a1 - 2.0f) * ka);
        const f32x4 bt = x[0] * ksum * rk;
        const float bs = red16((bt.x + bt.y) + (bt.z + bt.w));
        const f32x4 y = (dv * rstd * gw4 + gb4 + x[2] * bs) * g;
        u32x2 w; w.x = pk2(y.x, y.y); w.y = pk2(y.z, y.w);
        *(u32x2*)(Y + (size_t)m * 1024 + c0) = w;
    }
    const float lam = __expf(wave_sum(lq1[lane] * lk1[lane])) - __expf(wave_sum(lq2[lane] * lk2[lane])) + LAM_INIT;
    for (int m = gw; m < M; m += NGW) {
        const int hv = lane >> 3, d0 = 16 * (lane & 7);
        const bf16* p1 = OATT + (size_t)m * 2048 + (2 * hv) * 128 + d0; const bf16* p2 = p1 + 128;
        const v4u a0 = *(const v4u*)p1, a1 = *(const v4u*)(p1 + 8), b0 = *(const v4u*)p2, b1 = *(const v4u*)(p2 + 8);
        f32x4 df[4];
        df[0] = pg8::unpk_lo(a0) - lam * pg8::unpk_lo(b0); df[1] = pg8::unpk_hi(a0) - lam * pg8::unpk_hi(b0); df[2] = pg8::unpk_lo(a1) - lam * pg8::unpk_lo(b1); df[3] = pg8::unpk_hi(a1) - lam * pg8::unpk_hi(b1);
        float ss = 0.f;
#pragma unroll
        for (int q = 0; q < 4; ++q) ss += (df[q].x * df[q].x + df[q].y * df[q].y) + (df[q].z * df[q].z + df[q].w * df[q].w);
        const float rs = (1.0f - LAM_INIT) / sqrtf(red8(ss) * (1.f / 128.f) + SUBLN_EPS);
#pragma unroll
        for (int q = 0; q < 4; ++q) df[q] = df[q] * rs * *(const f32x4*)(subln_g + d0 + 4 * q);
        bf16* yo = Y + (size_t)(M + m) * 1024 + hv * 128 + d0;
        *(v4u*)yo = pg8::pack8(df[0], df[1]); *(v4u*)(yo + 8) = pg8::pack8(df[2], df[3]);
    }
}


struct Ctx { int vcu, wave, lane; };
typedef const __attribute__((address_space(4))) Args* ArgsP;
template <int ph> __device__ __forceinline__ void run_phase(const Ctx& c, LAS unsigned char* lds, unsigned char* lds_raw) {
    ArgsP ap = (ArgsP)__builtin_amdgcn_kernarg_segment_ptr(); asm volatile("" : "+s"(ap));
    unsigned char* ws = ap->ws; const float* x = ap->in[0]; float* out = ap->out;
    int tid = threadIdx.x; asm volatile("" : "+v"(tid));
    const int G = gridDim.x, bx = blockIdx.x, vcu = (G % 8 == 0) ? (bx % 8) * (G / 8) + bx / 8 : bx, wave = __builtin_amdgcn_readfirstlane(tid >> 6), lane = tid & 63; (void)c;
    const int gw = vcu * NWAVES + wave, NGW = G * NWAVES, gt = vcu * (NWAVES * 64) + tid, NGT = G * NWAVES * 64;
    bf16* XN = (bf16*)(ws + WS_XN); float* Fb = (float*)(ws + WS_F); bf16* ACT = (bf16*)(ws + WS_ACT);
    bf16* RW = (bf16*)(ws + WS_RW); bf16* Qb = (bf16*)(ws + WS_Q); bf16* Kb = (bf16*)(ws + WS_K); bf16* Vb = (bf16*)(ws + WS_V); bf16* Yb = (bf16*)(ws + WS_Y);
    bf16* GATES = (bf16*)(ws + WS_GATES); float* LR = (float*)(ws + WS_LR); bf16* LA = (bf16*)(ws + WS_LA); bf16* OATT = (bf16*)(ws + WS_OATT);
    bf16* EA = (bf16*)(ws + WS_F);
    bf16* Gg = (bf16*)(ws + WS_G);
#ifdef OS_IN_GATES
    bf16* OS = (bf16*)(ws + WS_GATES);
#else
    bf16* OS = (bf16*)(ws + WS_XN);
#endif
    bf16* MERGED = (bf16*)(ws + WS_XN); float* Pb = (float*)(ws + WS_F);
    float* ROPE = (float*)(ws + WS_ROPE);
    (void)XN; (void)Fb; (void)ACT; (void)RW; (void)Qb; (void)Kb; (void)Vb; (void)Yb; (void)GATES; (void)LR; (void)LA; (void)OATT; (void)EA; (void)Gg; (void)OS; (void)MERGED; (void)Pb; (void)ROPE; (void)gw; (void)NGW; (void)gt; (void)NGT; (void)bx;
    (void)tid; (void)x; (void)out; (void)ws;
#ifdef ONLY_PH
    if (ph != ONLY_PH) return;
#endif
#ifdef STOP_AFTER
    if (ph > STOP_AFTER) return;
#endif
#ifdef SKIP_MASK
    if ((SKIP_MASK >> ph) & 1) return;
#endif
        switch (ph) {
        case 0: {
            LAS float* scr = (LAS float*)(lds + RING_OFF + wave * 16384);
            conv_ffn_weights(ap->in[2], ap->in[3], ws, scr, gw, NGW, lane);
            constexpr int I_IN = (D / 64) * (IN_COLS / 32), I_BR = (1024 / 64) * (D / 32), I_OUT = (D / 64) * (D / 32);
            for (int it = gw; it < I_IN + 2 * I_BR + I_OUT; it += NGW) {
                int r = it;
                if (r < I_IN) { const int nb = r % (IN_COLS / 32), kb = r / (IN_COLS / 32); transpose_item(ap->in[6], D, IN_COLS, (bf16*)(ws + WS_WIN), kb * 64, nb * 32, map_in(nb * 32), scr, lane); continue; } r -= I_IN;
                if (r < I_BR) { const int nb = r % (D / 32), kb = r / (D / 32); transpose_item(ap->in[24], 1024, D, (bf16*)(ws + WS_WA), kb * 64, nb * 32, nb * 32, scr, lane); continue; } r -= I_BR;
                if (r < I_BR) { const int nb = r % (D / 32), kb = r / (D / 32); transpose_item(ap->in[25], 1024, D, (bf16*)(ws + WS_WB), kb * 64, nb * 32, nb * 32, scr, lane); continue; } r -= I_BR;
                { const int nb = r % (D / 32), kb = r / (D / 32); transpose_item(ap->in[26], D, D, (bf16*)(ws + WS_WOUT), kb * 64, nb * 32, nb * 32, scr, lane); }
            }
            { const float* w_up = ap->in[10]; const float* a_up = ap->in[12]; const float* g_up = ap->in[13]; bf16* WL = (bf16*)(ws + WS_WLORA);
              for (int i = gt; i < NLORA * (KLORA / 8); i += NGT) { const int n = i >> 6, k0 = (i & 63) * 8, ob = n >> 10, c = n & 1023; float v[8];
#pragma unroll
                  for (int e = 0; e < 8; ++e) { const int kk = k0 + e; float val = 0.f;
                      if (ob < 2) { if ((kk >> 6) == ob) val = w_up[(size_t)kk * 1024 + c]; }
                      else if (ob < 4) { if ((kk >> 6) == ob) val = a_up[(size_t)(kk - 128) * 1024 + c]; }
                      else { if (kk >= 256 && kk < 416) val = g_up[(size_t)(kk - 256) * 1024 + c]; }
                      v[e] = val; }
                  v4u o; o.x = pk2(v[0], v[1]); o.y = pk2(v[2], v[3]); o.z = pk2(v[4], v[5]); o.w = pk2(v[6], v[7]);
                  *(v4u*)(WL + (size_t)n * KLORA + k0) = o; } }
            for (int i = gt; i < T * 32; i += NGT) { const int t = i >> 5, k = i & 31;
                const float inv = __builtin_amdgcn_exp2f(-(float)k * (13.287712379549449f / 32.0f)); const float ang = (float)t * inv;
                const double rev = (double)ang * 0.15915494309189535; const float fr = (float)(rev - floor(rev));
                ROPE[t * 64 + k] = __builtin_amdgcn_cosf(fr); ROPE[t * 64 + 32 + k] = __builtin_amdgcn_sinf(fr); }
            for (int m = gw; m < M; m += NGW) rms_row_to_bf16(x + (size_t)m * D, ap->in[1], XN + (size_t)m * D, lane);
        } break;
        case 1: case 12: {
            pg8::Gemm g{XN, (const bf16*)(ws + WS_WGU), M, NGU, D, nullptr, nullptr}; pg8::StaticOrder S; S.init(M, NGU, G, bx);
            pg8::EpiSwiglu E{ACT, FF};
            pg8::gemm_phase<pg8::EpiSwiglu, pg8::StaticOrder, true, true>(lds + RING_OFF, g, S, E);
        } break;
        case 2: case 10: case 13: {
            const bool isout = (ph == 10);
            pg8::Gemm g{isout ? MERGED : ACT, (const bf16*)(ws + (isout ? WS_WOUT : WS_WDN)), M, D, isout ? D : FF, nullptr, nullptr}; pg8::StaticOrder S; S.init(M, D, G, bx);
            pg8::EpiF32 E{Fb, D};
            pg8::gemm_phase<pg8::EpiF32, pg8::StaticOrder, true, true>(lds + RING_OFF, g, S, E);
        } break;
        case 3: case 11: case 14: {
            const float* gpost = ap->in[ph == 3 ? 4 : (ph == 11 ? 27 : 31)]; const float* gpre = ap->in[ph == 3 ? 5 : 28];
            norm_phase(Fb, ph == 3 ? x : out, out, gpost, ph == 11 ? 1.0f : 0.5f, gpre, ph == 14 ? (bf16*)nullptr : XN, gw, NGW, lane);
        } break;
        case 4: {
            pg8::Gemm g{XN, (const bf16*)(ws + WS_WIN), M, IN_PAD, D, nullptr, nullptr}; pg8::StaticOrder S; S.init(M, IN_PAD, G, bx);
            pg8::EpiIn E{RW, Qb, Kb, Vb, GATES, LR, ROPE, QSCALE};
            pg8::gemm_phase<pg8::EpiIn, pg8::StaticOrder, true, true>(lds + RING_OFF, g, S, E);
        } break;
        case 5: {
            const float* mu_prev = ap->in[7]; const float* mu_next = ap->in[8];
            for (int i = gt; i < M * 64; i += NGT) { const int m = i >> 6, grp = i & 63, c0 = grp * 8, t = m & (T - 1);
                f32x4 y0 = (f32x4){0.f, 0.f, 0.f, 0.f}, y1 = y0;
                if (grp < 52) {
                    const float* cp = LR + (size_t)m * 512 + c0; const f32x4 z = (f32x4){0.f, 0.f, 0.f, 0.f};
                    const f32x4 c_0 = *(const f32x4*)cp, c_1 = *(const f32x4*)(cp + 4);
                    const f32x4 p_0 = t > 0 ? *(const f32x4*)(cp - 512) : z, p_1 = t > 0 ? *(const f32x4*)(cp - 508) : z;
                    const f32x4 n_0 = t < T - 1 ? *(const f32x4*)(cp + 512) : z, n_1 = t < T - 1 ? *(const f32x4*)(cp + 516) : z;
                    const f32x4 mp0 = *(const f32x4*)(mu_prev + 3072 + c0), mp1 = *(const f32x4*)(mu_prev + 3076 + c0), mn0 = *(const f32x4*)(mu_next + 3072 + c0), mn1 = *(const f32x4*)(mu_next + 3076 + c0);
                    y0 = c_0 + mp0 * (p_0 - c_0) + mn0 * (n_0 - c_0); y1 = c_1 + mp1 * (p_1 - c_1) + mn1 * (n_1 - c_1);
                    if (c0 < 128) {
#pragma unroll
                        for (int e = 0; e < 4; ++e) { y0[e] = 2.0f * sigm_(2.0f * y0[e]) - 1.0f; y1[e] = 2.0f * sigm_(2.0f * y1[e]) - 1.0f; } }
                    else if (c0 >= 256) {
#pragma unroll
                        for (int e = 0; e < 4; ++e) { y0[e] = sigm_(y0[e]); y1[e] = sigm_(y1[e]); } }
                }
                *(v4u*)(LA + (size_t)m * 512 + c0) = pg8::pack8(y0, y1); }
            LAS float* scr = (LAS float*)(lds + RING_OFF + wave * 16384);
            conv_ffn_weights(ap->in[29], ap->in[30], ws, scr, gw, NGW, lane);
        } break;
        case 6: {
            pg8::Gemm g{LA, (const bf16*)(ws + WS_WLORA), M, NLORA, KLORA, nullptr, nullptr}; pg8::StaticOrder S; S.init(M, NLORA, G, bx);
            pg8::EpiLora E{EA, Gg, ap->in[9], ap->in[11]};
            pg8::gemm_phase<pg8::EpiLora, pg8::StaticOrder, true, true>(lds + RING_OFF, g, S, E);
        } break;
        case 7: {
            scan_phase(lds + RING_OFF, RW, EA, OS, ap->in[7], ap->in[8], ap->in[14], ap->in[15], vcu, G, wave, lane);
            __syncthreads();
#ifdef SKIP_ATTN
            if (true) break;
#endif
            const int upc = (1024 + G - 1) / G;
            for (int i = 0; i < upc; ++i) { const int unit = vcu * upc + i; if (unit >= 1024) break;
                const int qb = unit & 7, vh = (unit >> 3) & 1, j = (unit >> 4) & 15, b = unit >> 8;
                attn_body::attn_unit<8>(b, j, (j >> 1) * 128 + vh * 64, j * 128 + vh * 64, qb, (const attn_body::bf16*)Qb, (const attn_body::bf16*)Kb, (const attn_body::bf16*)Vb, (attn_body::bf16*)OATT, (char*)lds_raw + RING_OFF); }
        } break;
        case 8: {
            post_phase(RW, EA, Gg, OS, OATT, Yb, ap->in[7], ap->in[8], ap->in[15], ap->in[16], ap->in[17], ap->in[18], ap->in[19], ap->in[20], ap->in[21], ap->in[22], ap->in[23], gw, NGW, lane);
        } break;
        case 9: {
            pg8::Gemm g{Yb, (const bf16*)(ws + WS_WA), M, D, 1024, Yb + (size_t)M * 1024, (const bf16*)(ws + WS_WB)}; pg8::BranchOrder S; S.so.init(M, D, G, bx);
            pg8::EpiBranch E{Pb, MERGED, GATES};
            pg8::gemm_phase<pg8::EpiBranch, pg8::BranchOrder, true, true>(lds + RING_OFF, g, S, E);
        } break;
        }
}
__device__ __forceinline__ void ap_out_nan(float* out, int i) { out[i] = __builtin_nanf(""); }
#ifndef USE_XCD_BARRIER
#define USE_XCD_BARRIER 1
#endif
#if USE_XCD_BARRIER
#define GRID_SYNC() xcd_barrier(bar)
#else
#define GRID_SYNC() cooperative_groups::this_grid().sync()
#endif
#ifndef CUT_LIST
#define CUT_LIST {0, 15}
#endif
__global__ void __launch_bounds__(NWAVES * 64, 2) mk_fwd(Args args) {
    extern __shared__ __attribute__((aligned(16))) unsigned char lds_raw[];
    LAS unsigned char* lds = (LAS unsigned char*)lds_raw;
    volatile LAS unsigned* MISC = (volatile LAS unsigned*)(lds + MISC_OFF);
    const int tid = threadIdx.x, lane = tid & 63, wave = __builtin_amdgcn_readfirstlane(tid >> 6);
    const int G = gridDim.x; const int bx = blockIdx.x; const int vcu = (G % 8 == 0) ? (bx % 8) * (G / 8) + bx / 8 : bx;
    unsigned char* ws = args.ws;
    gu32* ctl = (gu32*)(ws + WS_CTL);
    for (int u = tid; u < (LDS_BYTES - LDSCTL_OFF) / 4; u += NWAVES * 64) ((LAS unsigned*)(lds + LDSCTL_OFF))[u] = 0u;
    __syncthreads();
    XcdBarrier bar = xcd_barrier_post((unsigned*)(ctl + CW_BAR) + args.li * XCD_BAR_WORDS, MISC + 8);
    const int ph_lo = args.ph_lo, ph_hi = args.ph_hi;
#ifdef DUMP_SCAN_INPUTS
    if (ph_lo == 7) {
        for (size_t i_ = (size_t)blockIdx.x * 512 + threadIdx.x; i_ < (size_t)M * D; i_ += (size_t)gridDim.x * 512) {
            float s_ = 0.f;
            { const unsigned* W_ = (const unsigned*)(ws + WS_RW); if (i_ < (size_t)48 * MiB / 4) s_ += (float)(W_[i_] & 0xfffffu) + (float)(W_[i_] >> 20); }
            { const unsigned* W_ = (const unsigned*)(ws + WS_F); s_ += (float)(W_[i_] & 0xfffffu) + (float)(W_[i_] >> 20); }
            if (i_ < 3488) s_ += args.in[7][i_] + args.in[8][i_];
            if (i_ < 1024) s_ += args.in[14][i_] + args.in[15][i_];
            args.out[i_] = s_; }
        return; }
    if (ph_lo > 7) return;
#endif
#ifdef DUMP_OS_AT8
    if (ph_lo == 8) {
        for (size_t i_ = (size_t)blockIdx.x * 512 + threadIdx.x; i_ < (size_t)M * D; i_ += (size_t)gridDim.x * 512) {
            float s_ = 0.f;
            if (DUMP_OS_AT8 & 1) { const unsigned* W_ = (const unsigned*)(ws + WS_XN); if (i_ < (size_t)32 * MiB / 4) s_ += (float)(W_[i_] & 0xfffffu) + (float)(W_[i_] >> 20); }
            if (DUMP_OS_AT8 & 4) { const unsigned* W_ = (const unsigned*)(ws + WS_GATES); s_ += (float)(W_[i_] & 0xfffffu) + (float)(W_[i_] >> 20); }
            if (DUMP_OS_AT8 & 8) { const unsigned* W_ = (const unsigned*)(ws + WS_GATES); if (i_ < 256 * 8 * 4 * 64) s_ += (float)(W_[i_] & 0xfffffu) + (float)(W_[i_] >> 20); }
            if (DUMP_OS_AT8 & 2) { const unsigned* W_ = (const unsigned*)(ws + WS_OATT); if (i_ < (size_t)32 * MiB / 4) s_ += (float)(W_[i_] & 0xfffffu) + (float)(W_[i_] >> 20); }
            args.out[i_] = s_; }
        return; }
#endif
    Ctx c{vcu, wave, lane};
#ifdef DUMP_AFTER
#define DUMP_AFTER_7X(n) ((n) == 7 && DUMP_AFTER > 70)
#define DUMPR(off, nbytes) do { const unsigned* W_ = (const unsigned*)(ws + (off)); const size_t n_ = (size_t)(nbytes) / 4; \
        for (size_t i_ = (size_t)blockIdx.x * 512 + threadIdx.x; i_ < (size_t)M * D; i_ += (size_t)gridDim.x * 512) { float s_ = 0.f; for (size_t j_ = i_; j_ < n_; j_ += (size_t)M * D) s_ += (float)(W_[j_] & 0xfffffu); args.out[i_] += s_; } } while (0)
#define DUMPCHK(k) if (DUMP_AFTER == (k)) { for (size_t i_ = (size_t)blockIdx.x * 512 + threadIdx.x; i_ < (size_t)M * D; i_ += (size_t)gridDim.x * 512) args.out[i_] = 0.f; \
        if ((k) == 4) { DUMPR(WS_RW, 48 * MiB); DUMPR(WS_Q, 48 * MiB); DUMPR(WS_GATES, 64 * MiB); } \
        if ((k) == 5) { DUMPR(WS_LA, 8 * MiB); DUMPR(WS_WGU, 66 * MiB); } \
        if ((k) == 6) { DUMPR(WS_F, 64 * MiB); DUMPR(WS_G, 16 * MiB); } \
        if ((k) == 7) { DUMPR(WS_XN, 32 * MiB); DUMPR(WS_OATT, 32 * MiB); } \
        if ((k) == 71) { DUMPR(WS_XN, 32 * MiB); } \
        if ((k) == 72) { DUMPR(WS_OATT, 32 * MiB); } \
        if ((k) == 8) { DUMPR(WS_Y, 32 * MiB); } \
        if ((k) == 9) { DUMPR(WS_XN, 32 * MiB); } \
        if ((k) == 10) { DUMPR(WS_F, 64 * MiB); } \
        return; }
#else
#define DUMPCHK(k)
#define DUMP_AFTER_7X(n) false
#endif
#ifdef HASH_AFTER
#define HASHCHK(n) if ((n) == HASH_AFTER) { unsigned hs_ = 0u; const unsigned* W_ = (const unsigned*)(ws + (size_t)(HASH_LO) * MiB); const size_t n_ = (size_t)((HASH_HI) - (HASH_LO)) * MiB / 4; \
        for (size_t i_ = (size_t)blockIdx.x * 512 + threadIdx.x; i_ < n_; i_ += (size_t)gridDim.x * 512) { const unsigned w_ = W_[i_]; hs_ += w_ * 2654435761u + (w_ >> 15) + (unsigned)i_ * (w_ | 1u); } \
        atomicAdd((unsigned*)(ctl + 100000), hs_); GRID_SYNC(); const unsigned hv_ = xb_ld((unsigned*)(ctl + 100000)); \
        for (size_t i_ = (size_t)blockIdx.x * 512 + threadIdx.x; i_ < (size_t)M * D; i_ += (size_t)gridDim.x * 512) args.out[i_] = (float)((hv_ ^ (unsigned)(i_ * 40503u)) & 0xffffu); \
        return; }
#else
#define HASHCHK(n)
#endif
#define PH(n) if (ph_lo <= (n) && (n) < ph_hi) { run_phase<n>(c, lds, lds_raw); if ((n) + 1 < ph_hi) { GRID_SYNC(); } HASHCHK(n) }
    PH(0) PH(1) PH(2) PH(3) PH(4) PH(5) PH(6) PH(7) PH(8) PH(9) PH(10) PH(11) PH(12) PH(13)
    PH(14)
    if (ph_hi == 15 && (xb_ld((unsigned*)(ctl + CW_BAR) + XB_TMO) | xb_ld((unsigned*)(ctl + CW_BAR) + XCD_BAR_WORDS + XB_TMO) | xb_ld((unsigned*)(ctl + CW_BAR) + 2 * XCD_BAR_WORDS + XB_TMO)) != 0u) { asm volatile("s_waitcnt vmcnt(0)" ::: "memory"); if (threadIdx.x < 64) ap_out_nan(args.out, blockIdx.x * 64 + threadIdx.x); }
#undef PH
}

extern "C" void kernel_launch(void* const* d_in, const int* in_sizes, int n_in, void* d_out, int out_size, void* d_ws, size_t ws_size, hipStream_t stream) {
    static int grid = 0;
    if (grid == 0) {
        if (n_in != 32 || in_sizes[0] != M * D || out_size != M * D || ws_size < WS_END) { fprintf(stderr, "kernel_launch: unexpected shapes (n_in %d, ws %zu)\n", n_in, ws_size); grid = -1; return; }
        int dev = 0, cus = 0, per_cu = 0;
        if (hipGetDevice(&dev) != hipSuccess || hipDeviceGetAttribute(&cus, hipDeviceAttributeMultiprocessorCount, dev) != hipSuccess) { grid = -1; return; }
        if (hipFuncSetAttribute((const void*)mk_fwd, hipFuncAttributeMaxDynamicSharedMemorySize, LDS_BYTES) != hipSuccess) { fprintf(stderr, "kernel_launch: hipFuncSetAttribute failed\n"); grid = -1; return; }
        if (hipOccupancyMaxActiveBlocksPerMultiprocessor(&per_cu, (const void*)mk_fwd, NWAVES * 64, LDS_BYTES) != hipSuccess || per_cu < 1) { fprintf(stderr, "kernel_launch: occupancy query says %d\n", per_cu); per_cu = 1; }
        (void)hipGetLastError();
        grid = cus;
    }
    if (grid < 0) return;
    if (hipMemsetAsync((char*)d_ws + WS_CTL, 0, CTL_ZERO_BYTES, stream) != hipSuccess) return;
    Args a{};
    for (int i = 0; i < 32; ++i) a.in[i] = (const float*)d_in[i];
    a.out = (float*)d_out; a.ws = (unsigned char*)d_ws;
#if USE_XCD_BARRIER
#ifndef N_CUTS
#define N_CUTS 1
#endif
    static const int cuts[N_CUTS + 1] = CUT_LIST;
    for (int li = 0; li < N_CUTS; ++li) { a.ph_lo = cuts[li]; a.ph_hi = cuts[li + 1]; a.li = li;
        hipLaunchKernelGGL(mk_fwd, dim3(grid), dim3(NWAVES * 64), LDS_BYTES, stream, a); }
#else
    void* kargs[] = {&a};
    hipError_t e = hipLaunchCooperativeKernel((const void*)mk_fwd, dim3(grid), dim3(NWAVES * 64), kargs, LDS_BYTES, stream);
    if (e != hipSuccess) fprintf(stderr, "cooperative launch failed: %s (grid %d)\n", hipGetErrorString(e), grid);
#endif
}
```

```cpp
#include <hip/hip_runtime.h>
#include <hip/hip_cooperative_groups.h>
#include <cstdio>
#include <cstdint>
namespace pg8 {
#define PG8_LAS __attribute__((address_space(3)))
typedef unsigned short bf16_t;
typedef short bf16x8 __attribute__((ext_vector_type(8)));
typedef float f32x4 __attribute__((ext_vector_type(4)));
typedef unsigned u32x4 __attribute__((ext_vector_type(4)));
constexpr int BM = 256, BK = 64, HALF = 128, HTB = HALF * BK * 2  , STAGE_BYTES = 8 * HTB, NXCD = 8, WGM = 8;

__host__ __device__ __forceinline__ int lds_byte(int r, int c) { const int st = (r >> 4) * 2 + (c >> 5), rr = r & 15, cc = c & 31, ob = rr * 64 + cc * 2; return st * 1024 + (ob ^ (((ob >> 9) & 1) << 5)); }
__host__ __device__ __forceinline__ void stage_rc(int b, int& R, int& C) { const int st = b / 1024, sb = b % 1024, swz = sb ^ (((sb >> 9) & 1) << 5); R = (st >> 1) * 16 + swz / 64; C = (st & 1) * 32 + (swz % 64) / 2; }
__host__ __device__ __forceinline__ int perm32(int rho) { const int n = rho >> 4, i = rho & 15; return 8 * (i >> 2) + 4 * n + (i & 3); }

struct Unit { int pm, pn, sel, kbeg, nt; };
struct Gemm { const bf16_t* A; const bf16_t* Bt; int M, N, K; const bf16_t* A2; const bf16_t* Bt2; };

struct StaticOrder {
    int nM, nN, nwg, G, c;
    __host__ __device__ void init(int M, int N, int G_, int c_) { nM = M / BM; nN = N / BM; nwg = nM * nN; G = G_; c = c_; }
    __host__ __device__ bool next(int i, Unit& u) const {
        const long L = (long)i * G + c; if (L >= nwg) return false;
        int wgid = (int)L; { const int q = nwg / NXCD, r = nwg % NXCD, xcd = wgid % NXCD, off = wgid / NXCD; wgid = (xcd < r ? xcd * (q + 1) : r * (q + 1) + (xcd - r) * q) + off; }
        const int nig = WGM * nN, gid = wgid / nig, fm = gid * WGM, gsz = (nM - fm) < WGM ? (nM - fm) : WGM;
        u.pm = fm + ((wgid % nig) % gsz); u.pn = (wgid % nig) / gsz; u.sel = 0; u.kbeg = 0; u.nt = 0; return true;
    }
    __device__ __forceinline__ void a_ready(const Unit&) const {}
    __device__ __forceinline__ void done(const Unit&) const {}
};


typedef float f32x2c_t __attribute__((ext_vector_type(2))); typedef __bf16 bf16x2c_t __attribute__((ext_vector_type(2)));
__device__ __forceinline__ unsigned cvt_pk_bf16(float lo, float hi) { f32x2c_t v = {lo, hi}; bf16x2c_t b = __builtin_convertvector(v, bf16x2c_t); return __builtin_bit_cast(unsigned, b); }
__device__ __forceinline__ float sigm(float x) { return __builtin_amdgcn_rcpf(1.0f + __builtin_amdgcn_exp2f(-1.4426950408889634f * x)); }
__device__ __forceinline__ u32x4 pack8(const f32x4 a, const f32x4 b) { u32x4 w; w.x = cvt_pk_bf16(a[0], a[1]); w.y = cvt_pk_bf16(a[2], a[3]); w.z = cvt_pk_bf16(b[0], b[1]); w.w = cvt_pk_bf16(b[2], b[3]); return w; }
__device__ __forceinline__ f32x4 unpk_lo(const u32x4 w) { return (f32x4){__uint_as_float(w.x << 16), __uint_as_float(w.x & 0xffff0000u), __uint_as_float(w.y << 16), __uint_as_float(w.y & 0xffff0000u)}; }
__device__ __forceinline__ f32x4 unpk_hi(const u32x4 w) { return (f32x4){__uint_as_float(w.z << 16), __uint_as_float(w.z & 0xffff0000u), __uint_as_float(w.w << 16), __uint_as_float(w.w & 0xffff0000u)}; }

template <int ACT>
__device__ __forceinline__ void store_nat_bf16(const f32x4 (&acc)[2][2][4][2], bf16_t* O, int ldc, int row0, int colt, int wc, int fq, const float* bias) {
    const int col0 = colt + wc * 32 + 8 * fq;
    f32x4 bv[2][2];
#pragma unroll
    for (int bj = 0; bj < 2; ++bj)
#pragma unroll
        for (int n = 0; n < 2; ++n) bv[bj][n] = bias ? *(const f32x4*)(bias + col0 + bj * HALF + 4 * n) : (f32x4){0.f, 0.f, 0.f, 0.f};
#pragma unroll
    for (int ai = 0; ai < 2; ++ai)
#pragma unroll
        for (int m = 0; m < 4; ++m) { bf16_t* rowp = O + (size_t)(row0 + ai * HALF + m * 16) * ldc + col0;
#pragma unroll
            for (int bj = 0; bj < 2; ++bj) { f32x4 v0 = acc[ai][bj][m][0] + bv[bj][0], v1 = acc[ai][bj][m][1] + bv[bj][1];
                if (ACT >= 1) {
#pragma unroll
                    for (int e = 0; e < 4; ++e) { v0[e] = sigm(v0[e]); v1[e] = sigm(v1[e]); }
                    if (ACT == 2) { v0 = v0 * 0.6065306597f; v1 = v1 * 0.6065306597f; } }
                *(u32x4*)(rowp + bj * HALF) = pack8(v0, v1); } }
}

struct EpiSwiglu {
    static constexpr bool PERM = true, AFTER_DRAIN = false;
    bf16_t* O; int ldc;
    __device__ __forceinline__ void operator()(const f32x4 (&acc)[2][2][4][2], const Unit& u, int wr, int wc, int fr, int fq) const {
        const int row0 = u.pm * BM + wr * 64 + fr, col0 = u.pn * HALF + wc * 32 + 8 * fq;
#pragma unroll
        for (int ai = 0; ai < 2; ++ai)
#pragma unroll
            for (int m = 0; m < 4; ++m) { bf16_t* rowp = O + (size_t)(row0 + ai * HALF + m * 16) * ldc + col0;
                f32x4 v0, v1;
#pragma unroll
                for (int e = 0; e < 4; ++e) { const float g0 = acc[ai][0][m][0][e], g1 = acc[ai][0][m][1][e];
                    v0[e] = g0 * sigm(g0) * acc[ai][1][m][0][e]; v1[e] = g1 * sigm(g1) * acc[ai][1][m][1][e]; }
                *(u32x4*)rowp = pack8(v0, v1); }
    }
};

struct EpiF32 {
    static constexpr bool PERM = true, AFTER_DRAIN = false;
    float* O; int ldc;
    __device__ __forceinline__ void operator()(const f32x4 (&acc)[2][2][4][2], const Unit& u, int wr, int wc, int fr, int fq) const {
        const int row0 = u.pm * BM + wr * 64 + fr, col0 = u.pn * BM + wc * 32 + 8 * fq;
#pragma unroll
        for (int ai = 0; ai < 2; ++ai)
#pragma unroll
            for (int m = 0; m < 4; ++m) { float* rowp = O + (size_t)(row0 + ai * HALF + m * 16) * ldc + col0;
#pragma unroll
                for (int bj = 0; bj < 2; ++bj) { *(f32x4*)(rowp + bj * HALF) = acc[ai][bj][m][0]; *(f32x4*)(rowp + bj * HALF + 4) = acc[ai][bj][m][1]; } }
    }
};

struct EpiB16 {
    static constexpr bool PERM = true, AFTER_DRAIN = false;
    bf16_t* O; int ldc;
    __device__ __forceinline__ void operator()(const f32x4 (&acc)[2][2][4][2], const Unit& u, int wr, int wc, int fr, int fq) const {
        store_nat_bf16<0>(acc, O, ldc, u.pm * BM + wr * 64 + fr, u.pn * BM, wc, fq, nullptr);
    }
};

struct EpiIn {
    static constexpr bool PERM = true, AFTER_DRAIN = false;
    bf16_t *RW, *Q, *K, *V, *GATES; float* LR; const float* rope; float qscale;
    __device__ __forceinline__ void operator()(const f32x4 (&acc)[2][2][4][2], const Unit& u, int wr, int wc, int fr, int fq) const {
        const int pn = u.pn, row0 = u.pm * BM + wr * 64 + fr;
        if (pn < 12) store_nat_bf16<0>(acc, RW, 3072, row0, pn * 256, wc, fq, nullptr);
        else if (pn < 14) {
            const int col0 = (pn - 12) * 256 + wc * 32 + 8 * fq;
#pragma unroll
            for (int ai = 0; ai < 2; ++ai)
#pragma unroll
                for (int m = 0; m < 4; ++m) { float* rowp = LR + (size_t)(row0 + ai * HALF + m * 16) * 512 + col0;
#pragma unroll
                    for (int bj = 0; bj < 2; ++bj) { *(f32x4*)(rowp + bj * HALF) = acc[ai][bj][m][0]; *(f32x4*)(rowp + bj * HALF + 4) = acc[ai][bj][m][1]; } }
        } else if (pn < 22) {
            const bool isk = pn >= 18; bf16_t* base = isk ? K : Q; const float sc = isk ? 1.0f : qscale;
            const int head = 4 * ((pn - 14) & 3) + wc;
#pragma unroll
            for (int ai = 0; ai < 2; ++ai)
#pragma unroll
                for (int m = 0; m < 4; ++m) { const int row = row0 + ai * HALF + m * 16; const float* cp = rope + (size_t)(row & 2047) * 64 + 8 * fq;
                    const f32x4 c0 = *(const f32x4*)cp, c1 = *(const f32x4*)(cp + 4), s0 = *(const f32x4*)(cp + 32), s1 = *(const f32x4*)(cp + 36);
                    const f32x4 x1a = acc[ai][0][m][0], x1b = acc[ai][0][m][1], x2a = acc[ai][1][m][0], x2b = acc[ai][1][m][1];
                    const f32x4 o1a = (x1a * c0 - x2a * s0) * sc, o1b = (x1b * c1 - x2b * s1) * sc, o2a = (x2a * c0 + x1a * s0) * sc, o2b = (x2b * c1 + x1b * s1) * sc;
                    bf16_t* rowp = base + (size_t)row * 1024 + head * 64 + 8 * fq;
                    *(u32x4*)rowp = pack8(o1a, o1b); *(u32x4*)(rowp + 32) = pack8(o2a, o2b); }
        } else if (pn < 26) store_nat_bf16<0>(acc, V, 1024, row0, (pn - 22) * 256, wc, fq, nullptr);
        else store_nat_bf16<1>(acc, GATES, 4096, row0, (pn - 26) * 256, wc, fq, nullptr);
    }
};

struct EpiLora {
    static constexpr bool PERM = true, AFTER_DRAIN = false;
    bf16_t* EAG; bf16_t* GG; const float* w0; const float* a0;
    __device__ __forceinline__ void operator()(const f32x4 (&acc)[2][2][4][2], const Unit& u, int wr, int wc, int fr, int fq) const {
        const int ob = u.pn >> 2, colt = (u.pn & 3) * 256, row0 = u.pm * BM + wr * 64 + fr;
        bf16_t* O = EAG + (size_t)ob * 8192 * 1024;
        if (ob < 2) store_nat_bf16<2>(acc, O, 1024, row0, colt, wc, fq, w0 + ob * 1024);
        else if (ob < 4) store_nat_bf16<1>(acc, O, 1024, row0, colt, wc, fq, a0 + (ob - 2) * 1024);
        else store_nat_bf16<0>(acc, GG, 1024, row0, colt, wc, fq, nullptr);
    }
};

struct EpiBranch {
    static constexpr bool PERM = true, AFTER_DRAIN = false;
    float* P; bf16_t* MERGED; const bf16_t* GATES;
    __device__ __forceinline__ void operator()(const f32x4 (&acc)[2][2][4][2], const Unit& u, int wr, int wc, int fr, int fq) const {
        const int row0 = u.pm * BM + wr * 64 + fr, col0 = u.pn * BM + wc * 32 + 8 * fq;
#pragma unroll
        for (int ai = 0; ai < 2; ++ai)
#pragma unroll
            for (int m = 0; m < 4; ++m) { const size_t row = (size_t)(row0 + ai * HALF + m * 16);
#pragma unroll
                for (int bj = 0; bj < 2; ++bj) { const int col = col0 + bj * HALF;
                    const u32x4 gw = *(const u32x4*)(GATES + row * 4096 + u.sel * 2048 + col);
                    const f32x4 v0 = acc[ai][bj][m][0] * unpk_lo(gw), v1 = acc[ai][bj][m][1] * unpk_hi(gw);
                    float* pp = P + row * 2048 + col;
                    if (u.sel == 0) { *(f32x4*)pp = v0; *(f32x4*)(pp + 4) = v1; }
                    else { const f32x4 p0 = *(const f32x4*)pp, p1 = *(const f32x4*)(pp + 4); *(u32x4*)(MERGED + row * 2048 + col) = pack8(p0 + v0, p1 + v1); } } }
    }
};
struct LoraOrder {
    StaticOrder so;
    __host__ __device__ bool next(int i, Unit& u) const { if (!so.next(i, u)) return false; const int ob = u.pn >> 2; u.kbeg = ob < 2 ? 0 : (ob < 4 ? 128 : 256); u.nt = ob < 4 ? 2 : 4; return true; }
    __device__ __forceinline__ void a_ready(const Unit&) const {}
    __device__ __forceinline__ void done(const Unit&) const {}
};
struct BranchOrder {
    StaticOrder so;
    __host__ __device__ bool next(int i, Unit& u) const { if (!so.next(i >> 1, u)) return false; u.sel = i & 1; return true; }
    __device__ __forceinline__ void a_ready(const Unit&) const {}
    __device__ __forceinline__ void done(const Unit&) const {}
};
template <class Epi, class Sched, bool ALIGN_EPI = false, bool SP2 = false>
__device__ __forceinline__ void gemm_phase(PG8_LAS unsigned char* lds, const Gemm g, const Sched& S, const Epi& E) {
    int tid = threadIdx.x; asm volatile("" : "+v"(tid));
    const int wid = __builtin_amdgcn_readfirstlane(tid >> 6), lane = tid & 63, wr = wid >> 2, wc = wid & 3, fr = lane & 15, fq = lane >> 4;
    const int K = g.K, nt = K / BK;
    unsigned voffA[2], voffB[2];
#pragma unroll
    for (int i = 0; i < 2; ++i) { int R, C; stage_rc(tid * 16 + i * 8192, R, C); const int Rb = Epi::PERM ? ((R & ~31) + perm32(R & 31)) : R;
        voffA[i] = (unsigned)(R * K + C) * 2u; voffB[i] = (unsigned)(Rb * K + C) * 2u; }
    const size_t kstep = (size_t)(BK * 2);
    const size_t hstep = (size_t)HALF * K * 2;
    const size_t tstep = 2 * hstep;
    const unsigned ldsw = (unsigned)wid * 1024u;
    const int aoff = lds_byte(wr * 64 + fr, fq * 8), boff = lds_byte(wc * 32 + fr, fq * 8);
#define PG8_SA(b, h) (((b) * 2 + (h)) * HTB)
#define PG8_SB(b, h) ((4 + (b) * 2 + (h)) * HTB)
#define PG8_STAGE(bufoff, gbase, voff) do { _Pragma("unroll") for (int _i = 0; _i < 2; ++_i) \
        __builtin_amdgcn_global_load_lds((const unsigned*)((const char*)(gbase) + (voff)[_i]), (PG8_LAS unsigned*)(lds + (bufoff) + ldsw + _i * 8192), 16, 0, 0); } while (0)
#define PG8_LDA(dst, b, h) do { _Pragma("unroll") for (int m = 0; m < 4; ++m) _Pragma("unroll") for (int k = 0; k < 2; ++k) dst[m][k] = *(const PG8_LAS bf16x8*)(lds + PG8_SA(b, h) + aoff + m * 2048 + k * 1024); } while (0)
#define PG8_LDB(dst, b, h) do { _Pragma("unroll") for (int n = 0; n < 2; ++n) _Pragma("unroll") for (int k = 0; k < 2; ++k) dst[n][k] = *(const PG8_LAS bf16x8*)(lds + PG8_SB(b, h) + boff + n * 2048 + k * 1024); } while (0)
#define PG8_MMA(ai, bj, At, Bt) do { __builtin_amdgcn_s_setprio(1); _Pragma("unroll") for (int m = 0; m < 4; ++m) _Pragma("unroll") for (int n = 0; n < 2; ++n) _Pragma("unroll") for (int k = 0; k < 2; ++k) \
        acc[ai][bj][m][n] = __builtin_amdgcn_mfma_f32_16x16x32_bf16(Bt[n][k], At[m][k], acc[ai][bj][m][n], 0, 0, 0); __builtin_amdgcn_s_setprio(0); } while (0)
#define PG8_WAIT_V(n) asm volatile("s_waitcnt vmcnt(" #n ")" ::: "memory")
#define PG8_WAIT_L(n) asm volatile("s_waitcnt lgkmcnt(" #n ")" ::: "memory")
#define PG8_BAR __builtin_amdgcn_s_barrier()
#define PG8_SCHED __builtin_amdgcn_sched_barrier(0)
    Unit cur, nxt; int ui = 0;
    if (!S.next(0, cur)) return;
    f32x4 acc[2][2][4][2];
#pragma unroll
    for (int a = 0; a < 2; ++a)
#pragma unroll
        for (int b = 0; b < 2; ++b)
#pragma unroll
            for (int m = 0; m < 4; ++m)
#pragma unroll
                for (int n = 0; n < 2; ++n) acc[a][b][m][n] = (f32x4){0.f, 0.f, 0.f, 0.f};
    bf16x8 At[4][2], B0[2][2], B1[2][2];
    const char* cA = (const char*)(cur.sel ? g.A2 : g.A) + (size_t)cur.pm * tstep + (size_t)cur.kbeg * 2; const char* cB = (const char*)(cur.sel ? g.Bt2 : g.Bt) + (size_t)cur.pn * tstep + (size_t)cur.kbeg * 2;
    int nt_cur = cur.nt ? cur.nt : nt;
    S.a_ready(cur);
    if constexpr (SP2) {
        PG8_STAGE(PG8_SB(0, 0), cB, voffB); PG8_STAGE(PG8_SB(0, 1), cB + hstep, voffB); PG8_STAGE(PG8_SA(0, 0), cA, voffA); PG8_STAGE(PG8_SA(0, 1), cA + hstep, voffA);
        if (wr == 1) PG8_BAR;
        PG8_WAIT_V(2); PG8_BAR;
        PG8_STAGE(PG8_SB(1, 0), cB + kstep, voffB); PG8_STAGE(PG8_SA(1, 0), cA + kstep, voffA); PG8_STAGE(PG8_SB(1, 1), cB + hstep + kstep, voffB);
        PG8_WAIT_V(6); PG8_BAR;
    } else {
        PG8_STAGE(PG8_SB(0, 0), cB, voffB); PG8_STAGE(PG8_SA(0, 0), cA, voffA); PG8_STAGE(PG8_SB(0, 1), cB + hstep, voffB); PG8_STAGE(PG8_SA(0, 1), cA + hstep, voffA);
        if (wr == 1) PG8_BAR;
        PG8_WAIT_V(4); PG8_BAR;
        PG8_STAGE(PG8_SB(1, 0), cB + kstep, voffB); PG8_STAGE(PG8_SA(1, 0), cA + kstep, voffA); PG8_STAGE(PG8_SB(1, 1), cB + hstep + kstep, voffB);
        PG8_WAIT_V(6); PG8_BAR;
    }
    for (;;) {
        const bool has_next = S.next(ui + 1, nxt);
        const char* nA = has_next ? (const char*)(nxt.sel ? g.A2 : g.A) + (size_t)nxt.pm * tstep + (size_t)nxt.kbeg * 2 : cA; const char* nB = has_next ? (const char*)(nxt.sel ? g.Bt2 : g.Bt) + (size_t)nxt.pn * tstep + (size_t)nxt.kbeg * 2 : cB;
        for (int t = 0; t < nt_cur; t += 2) {
            const bool last = (t == nt_cur - 2);
            const char* a1 = cA + (size_t)(t + 1) * kstep;
            const char* a2 = last ? nA : cA + (size_t)(t + 2) * kstep; const char* b2 = last ? nB : cB + (size_t)(t + 2) * kstep;
            const char* a3 = a2 + kstep; const char* b3 = b2 + kstep;
            if (last && has_next) S.a_ready(nxt);
            if constexpr (SP2) {
            PG8_LDB(B0, 0, 0); PG8_LDB(B1, 0, 1); PG8_SCHED; PG8_LDA(At, 0, 0); PG8_STAGE(PG8_SA(1, 1), a1 + hstep, voffA);
            PG8_WAIT_V(8); PG8_WAIT_L(0); PG8_BAR; PG8_MMA(0, 0, At, B0); PG8_MMA(0, 1, At, B1); PG8_BAR; PG8_SCHED;
            PG8_LDA(At, 0, 1); PG8_STAGE(PG8_SB(0, 0), b2, voffB); PG8_STAGE(PG8_SB(0, 1), b2 + hstep, voffB); PG8_STAGE(PG8_SA(0, 0), a2, voffA);
            PG8_WAIT_V(8); PG8_WAIT_L(0); PG8_BAR; PG8_MMA(1, 0, At, B0); PG8_MMA(1, 1, At, B1); PG8_BAR; PG8_SCHED;
            PG8_LDB(B0, 1, 0); PG8_LDB(B1, 1, 1); PG8_SCHED; PG8_LDA(At, 1, 0); PG8_STAGE(PG8_SA(0, 1), a2 + hstep, voffA);
            PG8_WAIT_V(8); PG8_WAIT_L(0); PG8_BAR; PG8_MMA(0, 0, At, B0); PG8_MMA(0, 1, At, B1); PG8_BAR; PG8_SCHED;
            PG8_LDA(At, 1, 1); PG8_STAGE(PG8_SB(1, 0), b3, voffB); PG8_STAGE(PG8_SB(1, 1), b3 + hstep, voffB); PG8_STAGE(PG8_SA(1, 0), a3, voffA);
            PG8_WAIT_V(8); PG8_WAIT_L(0); PG8_BAR; PG8_MMA(1, 0, At, B0); PG8_MMA(1, 1, At, B1); PG8_BAR; PG8_SCHED;
            } else {
            PG8_LDB(B0, 0, 0); PG8_SCHED; PG8_LDA(At, 0, 0); PG8_STAGE(PG8_SA(1, 1), a1 + hstep, voffA);
            PG8_WAIT_L(8); PG8_BAR; PG8_WAIT_L(0); PG8_MMA(0, 0, At, B0); PG8_BAR; PG8_SCHED;
            PG8_LDB(B1, 0, 1); PG8_STAGE(PG8_SB(0, 0), b2, voffB);
            PG8_BAR; PG8_WAIT_L(0); PG8_MMA(0, 1, At, B1); PG8_BAR;
            PG8_LDA(At, 0, 1); PG8_STAGE(PG8_SA(0, 0), a2, voffA);
            PG8_BAR; PG8_WAIT_L(0); PG8_MMA(1, 0, At, B0); PG8_BAR; PG8_SCHED;
            PG8_STAGE(PG8_SB(0, 1), b2 + hstep, voffB);
            PG8_WAIT_V(6); PG8_BAR; PG8_MMA(1, 1, At, B1); PG8_BAR;
            PG8_LDB(B0, 1, 0); PG8_SCHED; PG8_LDA(At, 1, 0); PG8_STAGE(PG8_SA(0, 1), a2 + hstep, voffA);
            PG8_WAIT_L(8); PG8_BAR; PG8_WAIT_L(0); PG8_MMA(0, 0, At, B0); PG8_BAR; PG8_SCHED;
            PG8_LDB(B1, 1, 1); PG8_STAGE(PG8_SB(1, 0), b3, voffB);
            PG8_BAR; PG8_WAIT_L(0); PG8_MMA(0, 1, At, B1); PG8_BAR;
            PG8_LDA(At, 1, 1); PG8_STAGE(PG8_SA(1, 0), a3, voffA);
            PG8_BAR; PG8_WAIT_L(0); PG8_MMA(1, 0, At, B0); PG8_BAR; PG8_SCHED;
            PG8_STAGE(PG8_SB(1, 1), b3 + hstep, voffB);
            PG8_WAIT_V(6); PG8_BAR; PG8_MMA(1, 1, At, B1); PG8_BAR;
            }
        }
        if constexpr (ALIGN_EPI) { if (wr == 0) PG8_BAR; }
        if constexpr (!Epi::AFTER_DRAIN) { E(acc, cur, wr, wc, fr, fq); S.done(cur); }
        if (!has_next) break;
#pragma unroll
        for (int a = 0; a < 2; ++a)
#pragma unroll
            for (int b = 0; b < 2; ++b)
#pragma unroll
                for (int m = 0; m < 4; ++m)
#pragma unroll
                    for (int n = 0; n < 2; ++n) acc[a][b][m][n] = (f32x4){0.f, 0.f, 0.f, 0.f};
        cur = nxt; cA = nA; cB = nB; ++ui; nt_cur = cur.nt ? cur.nt : nt;
        if constexpr (ALIGN_EPI) { if (wr == 1) PG8_BAR; }
    }
    PG8_WAIT_V(0);
    if constexpr (!ALIGN_EPI) { if (wr == 0) PG8_BAR; }
    PG8_BAR;
    if constexpr (Epi::AFTER_DRAIN) { E.fused(acc, cur, wr, wc, fr, fq, lds, wid, lane); S.done(cur); }
#undef PG8_SA
#undef PG8_SB
#undef PG8_STAGE
#undef PG8_LDA
#undef PG8_LDB
#undef PG8_MMA
#undef PG8_WAIT_V
#undef PG8_WAIT_L
#undef PG8_BAR
#undef PG8_SCHED
}
}

#include <hip/hip_bf16.h>
#include <cmath>
namespace attn_body {
using bf16=__hip_bfloat16;
using bf16x8=__attribute__((ext_vector_type(8)))short;
using s16x4=__attribute__((ext_vector_type(4)))short;
using f32x16=__attribute__((ext_vector_type(16)))float;
using u32x4=__attribute__((ext_vector_type(4)))unsigned;
constexpr int BATCH=4,NHEAD=16,SEQ=2048,D=64,DM=NHEAD*D,OPITCH=2048;
constexpr int NW=8,QBLK=32,QB=QBLK*NW,KVBLK=64,NQB=SEQ/QB;
constexpr int ATTN_PITCH=DM, ATTN_UNIT_ROWS=QB;
__device__ __forceinline__ int crow(int r,int hi){return (r&3)+8*(r>>2)+4*hi;}
#define SBAR() __builtin_amdgcn_sched_barrier(0)
__device__ __forceinline__ void cmask(f32x16&p0,f32x16&p1,int jb,int qrel,int hi){
  const float NEG=-INFINITY; int kb=64*jb+4*hi;
  #pragma unroll
  for(int r=0;r<16;++r){int kv=kb+(r&3)+8*(r>>2); if(kv>qrel)p0[r]=NEG; if(kv+32>qrel)p1[r]=NEG;}
}

constexpr int NSLOT=3, SLOTB=8192;
constexpr int LDS_K=0, LDS_V=NSLOT*SLOTB, LDS_WS=2*NSLOT*SLOTB, LDS_OST=LDS_WS+NW*64*4, LDS_BYTES=LDS_OST+NW*4096;
constexpr float C2=0.125f*1.4426950408889634f;
__device__ __forceinline__ void glds16(const void*gsrc,unsigned lds_dst){unsigned keep;
  asm volatile("s_mov_b32 %0, m0\n\ts_mov_b32 m0, %2\n\ts_nop 0\n\tglobal_load_lds_dwordx4 %1, off\n\ts_mov_b32 m0, %0":"=&s"(keep):"v"(gsrc),"s"(lds_dst):"memory");}
__device__ __forceinline__ float max3f(float a,float b,float c){float r;asm("v_max3_f32 %0, %1, %2, %3":"=v"(r):"v"(a),"v"(b),"v"(c));return r;}
__device__ __forceinline__ float max2f(float a,float b){float r;asm("v_max_f32_e32 %0, %1, %2":"=v"(r):"v"(a),"v"(b));return r;}
__device__ __forceinline__ float fadd_s(float a,float b){float r;asm("v_add_f32_e32 %0, %1, %2":"=v"(r):"v"(a),"v"(b));return r;}
__device__ __forceinline__ float fsub_s(float a,float b){float r;asm("v_sub_f32_e32 %0, %1, %2":"=v"(r):"v"(a),"v"(b));return r;}
typedef float f32x2_t __attribute__((ext_vector_type(2))); typedef __bf16 bf16x2_t __attribute__((ext_vector_type(2)));
__device__ __forceinline__ unsigned cvtpk_s(float lo,float hi){f32x2_t v={lo,hi};bf16x2_t b=__builtin_convertvector(v,bf16x2_t);return __builtin_bit_cast(unsigned,b);}
#define WAIT_BAR(N) asm volatile("s_waitcnt vmcnt(" #N ") lgkmcnt(0)\n\ts_barrier":::"memory")

__device__ __forceinline__ void qkt(f32x16&p0,f32x16&p1,const char*Kslot,const bf16x8*qr,const f32x16&negm,int r32,int hi){
  const char*kb=Kslot+hi*1024+r32*16;
  #pragma unroll
  for(int d0=0;d0<4;++d0){
    const bf16x8 b0=*reinterpret_cast<const bf16x8*>(kb+d0*2048);
    const bf16x8 b1=*reinterpret_cast<const bf16x8*>(kb+d0*2048+512);
    if(d0==0){p0=__builtin_amdgcn_mfma_f32_32x32x16_bf16(b0,qr[0],negm,0,0,0);p1=__builtin_amdgcn_mfma_f32_32x32x16_bf16(b1,qr[0],negm,0,0,0);}
    else{p0=__builtin_amdgcn_mfma_f32_32x32x16_bf16(b0,qr[d0],p0,0,0,0);p1=__builtin_amdgcn_mfma_f32_32x32x16_bf16(b1,qr[d0],p1,0,0,0);}}
}
typedef __attribute__((address_space(3))) const char* lds_cptr;
typedef short v4i16_t __attribute__((ext_vector_type(4)));
__device__ __forceinline__ void kload8(bf16x8*kf,lds_cptr kp){
  kf[0]=*(const __attribute__((address_space(3))) bf16x8*)(kp);      kf[1]=*(const __attribute__((address_space(3))) bf16x8*)(kp+512);
  kf[2]=*(const __attribute__((address_space(3))) bf16x8*)(kp+2048); kf[3]=*(const __attribute__((address_space(3))) bf16x8*)(kp+2560);
  kf[4]=*(const __attribute__((address_space(3))) bf16x8*)(kp+4096); kf[5]=*(const __attribute__((address_space(3))) bf16x8*)(kp+4608);
  kf[6]=*(const __attribute__((address_space(3))) bf16x8*)(kp+6144); kf[7]=*(const __attribute__((address_space(3))) bf16x8*)(kp+6656);
}
__device__ __forceinline__ void kload2(bf16x8*kf,lds_cptr kp,int j){ kf[2*j]=*(const __attribute__((address_space(3))) bf16x8*)(kp+j*2048); kf[2*j+1]=*(const __attribute__((address_space(3))) bf16x8*)(kp+j*2048+512); }
__device__ __forceinline__ s16x4 vtr(lds_cptr p){ return __builtin_bit_cast(s16x4,__builtin_amdgcn_ds_read_tr16_b64_v4i16((__attribute__((address_space(3))) v4i16_t*)p)); }
__device__ __forceinline__ float rowmax(const f32x16&p0,const f32x16&p1){
  float a=max3f(p0[0],p0[1],p1[0]),b=max3f(p0[2],p0[3],p1[1]);a=max3f(a,p1[2],p1[3]);
  #pragma unroll
  for(int r=4;r<16;r+=4){a=max3f(a,p0[r],p0[r+1]);b=max3f(b,p0[r+2],p0[r+3]);a=max3f(a,p1[r],p1[r+1]);b=max3f(b,p1[r+2],p1[r+3]);}
  const float m=max2f(a,b);
  auto rr=__builtin_amdgcn_permlane32_swap(__float_as_uint(m),__float_as_uint(m),false,false);
  return max2f(__uint_as_float(rr[0]),__uint_as_float(rr[1]));
}
__device__ __forceinline__ void pv(f32x16*o,int vb,bf16x8 pa0,bf16x8 pa1,bf16x8 pa2,bf16x8 pa3){
  #pragma unroll
  for(int d0=0;d0<2;++d0){s16x4 lo[4],hi[4];
    #pragma unroll
    for(int ks=0;ks<4;++ks){
      asm volatile("ds_read_b64_tr_b16 %0,%1 offset:%c2":"=&v"(lo[ks]):"v"(vb),"i"(d0*4096+ks*1024):"memory");
      asm volatile("ds_read_b64_tr_b16 %0,%1 offset:%c2":"=&v"(hi[ks]):"v"(vb),"i"(d0*4096+ks*1024+512):"memory");}
    asm volatile("s_waitcnt lgkmcnt(0)":::"memory");SBAR();
    #define PK(k) (bf16x8){lo[k][0],lo[k][1],lo[k][2],lo[k][3],hi[k][0],hi[k][1],hi[k][2],hi[k][3]}
    o[d0]=__builtin_amdgcn_mfma_f32_32x32x16_bf16(pa0,PK(0),o[d0],0,0,0);
    o[d0]=__builtin_amdgcn_mfma_f32_32x32x16_bf16(pa1,PK(1),o[d0],0,0,0);
    o[d0]=__builtin_amdgcn_mfma_f32_32x32x16_bf16(pa2,PK(2),o[d0],0,0,0);
    o[d0]=__builtin_amdgcn_mfma_f32_32x32x16_bf16(pa3,PK(3),o[d0],0,0,0);
    #undef PK
  }
}

#ifndef ATTN_STORE16
#define ATTN_STORE16(p,v) (*(u32x4*)(p)=(v))
#endif
template<int THRL> __device__ __forceinline__ void attn_unit(int b,int h,int vcol,int ocol,int qb,const bf16*Q,const bf16*__restrict__ K,const bf16*__restrict__ V,bf16*O,char*shm){
  int tid=threadIdx.x; asm volatile("":"+v"(tid)); const int lane=tid&63,r32=lane&31,hi=lane>>5; const int wid=__builtin_amdgcn_readfirstlane(tid>>6);
  const long rowbase=(long)b*SEQ; const int q0=qb*QB;
  const bf16*Qw=Q+(rowbase+q0+wid*QBLK)*DM+h*D;
  const bf16*Kh=K+rowbase*DM+h*D,*Vh=V+rowbase*DM+vcol;
  const unsigned lds0=(unsigned)(uintptr_t)shm;
  float*wsf=(float*)(shm+LDS_WS)+wid*64;
  const bf16*ksrc=Kh+(long)lane*DM+wid*8;
  const bf16*vsrc=Vh+(long)(16*(wid&3)+(lane>>2))*DM+(wid>>2)*32+(lane&3)*8;
  const unsigned kdst=lds0+LDS_K+wid*1024, vdst=lds0+LDS_V+wid*1024;
  #define DMA_K(t,slot) glds16(ksrc+(long)(t)*KVBLK*DM,(unsigned)__builtin_amdgcn_readfirstlane(kdst+(slot)))
  #define DMA_V(t,slot) glds16(vsrc+(long)(t)*KVBLK*DM,(unsigned)__builtin_amdgcn_readfirstlane(vdst+(slot)))
  const int vb0=(int)(lds0+LDS_V)+((lane>>4)&1)*32+(lane&3)*8+(4*hi+((lane&15)>>2))*64;
  const char*Kbase=shm+LDS_K; bf16x8 kf[8];
  const lds_cptr shm3=(lds_cptr)shm; const lds_cptr kp0=shm3+LDS_K+hi*1024+r32*16; const lds_cptr vp0=shm3+LDS_V+((lane>>4)&1)*32+(lane&3)*8+(4*hi+((lane&15)>>2))*64;
  const int NT=SEQ/KVBLK;
  DMA_K(0,0);DMA_V(0,0);DMA_K(1,SLOTB);
  bf16x8 qr[4];
  #pragma unroll
  for(int d0=0;d0<4;++d0)qr[d0]=*reinterpret_cast<const bf16x8*>(&Qw[(long)r32*DM+d0*16+hi*8]);
  float mhat=0.f,l_reg=0.f;f32x16 o[2];o[0]=f32x16{};o[1]=f32x16{};f32x16 negm=f32x16{};asm volatile("":"+v"(negm));
  const int qrel=wid*QBLK+r32;
  #define CMASK(P0,P1,t) do{}while(0)
  bool resc=false;
  #define START(P0,P1) do{ const float rm=rowmax(P0,P1); resc=false; \
    { const float dl=rm; mhat=fadd_s(mhat,dl); \
      _Pragma("unroll") for(int r=0;r<16;++r){P0[r]=fsub_s(P0[r],dl);P1[r]=fsub_s(P1[r],dl);} \
      _Pragma("unroll") for(int r=0;r<16;++r)negm[r]=-mhat; asm volatile("":"+v"(negm)); } \
    _Pragma("unroll") for(int r=0;r<16;++r)P0[r]=__builtin_amdgcn_exp2f(P0[r]); }while(0)
  #define RESC() do{ if(resc){ asm volatile("s_waitcnt lgkmcnt(0)":::"memory"); \
      _Pragma("unroll") for(int d_=0;d_<2;++d_) _Pragma("unroll") for(int r=0;r<16;++r)o[d_][r]*=wsf[crow(r,hi)]; } }while(0)
  f32x16 pA0,pA1,pB0,pB1;
  int sl_prev=0,sl_cur=0,sl_next=SLOTB;
  #define ROT() do{sl_prev=sl_cur;sl_cur=sl_next;sl_next=(sl_next==(NSLOT-1)*SLOTB)?0:sl_next+SLOTB;}while(0)
  DMA_K(2,2*SLOTB);
  WAIT_BAR(3);
  qkt(pA0,pA1,Kbase,qr,negm,r32,hi);asm volatile("s_nop 15\n\ts_nop 7":"+v"(pA0),"+v"(pA1));CMASK(pA0,pA1,0);
  START(pA0,pA1);
  _Pragma("unroll") for(int r=0;r<16;++r)pA1[r]=__builtin_amdgcn_exp2f(pA1[r]);
  WAIT_BAR(0);
  DMA_K(3,0);DMA_V(1,SLOTB);
  ROT();
  kload8(kf,kp0+sl_cur);
  WAIT_BAR(2);
  s16x4 vlo[8],vhi[8]; u32x4 pw0,pw1,pw2,pw3;
  #define PKW(P,B) cvtpk_s(P[B],P[B+1])
  #define PAF(k) __builtin_bit_cast(bf16x8,pw##k)
  #define VFR(i) (bf16x8){vlo[i][0],vlo[i][1],vlo[i][2],vlo[i][3],vhi[i][0],vhi[i][1],vhi[i][2],vhi[i][3]}
  #define PIN(x) asm volatile("":"+v"(x))
  #define MX3(a,b,c) __builtin_fmaxf(__builtin_fmaxf((a),(b)),(c))
  #define GAPA(MF,A0,A1,A2,A3,W0,W1,PW) do{ MF; sacc+=A0; sacc+=A1; sacc+=A2; sacc+=A3; PIN(sacc); W0; W1; PIN(PW); SBAR(); }while(0)
  #define EX(v) __builtin_amdgcn_exp2f(v)
  #define GAPB(MF,X,B) do{ MF; X[B]=EX(X[B]); X[B+1]=EX(X[B+1]); X[B+2]=EX(X[B+2]); X[B+3]=EX(X[B+3]); PIN(X); SBAR(); }while(0)
  #define VRD(i) do{ vlo[i]=vtr(vp_+(((i)>>2)*4096+((i)&3)*1024)); vhi[i]=vtr(vp_+(((i)>>2)*4096+((i)&3)*1024+512)); }while(0)
  #define KRD(G,j) do{ if(G){ kload2(kf,kp0+sl_next,j); SBAR(); } }while(0)
  #define STEP(C0,C1,P0,P1,t,GK,GV,GL) do{ SBAR(); \
    const lds_cptr vp_=vp0+sl_prev; \
    VRD(0); SBAR(); float sacc=(P0[0]+P0[1]); \
    GAPA(C0=__builtin_amdgcn_mfma_f32_32x32x16_bf16(kf[0],qr[0],negm,0,0,0), P0[2],P0[3],P0[4],P0[5],     pw0[0]=PKW(P0,0), pw0[1]=PKW(P0,2), pw0); \
    VRD(4); SBAR(); GAPA(C1=__builtin_amdgcn_mfma_f32_32x32x16_bf16(kf[1],qr[0],negm,0,0,0), P0[6],P0[7],P0[8],P0[9],     pw0[2]=PKW(P0,4), pw0[3]=PKW(P0,6), pw0); \
    VRD(1); SBAR(); GAPA(C0=__builtin_amdgcn_mfma_f32_32x32x16_bf16(kf[2],qr[1],C0,0,0,0),   P0[10],P0[11],P0[12],P0[13], pw1[0]=PKW(P0,8), pw1[1]=PKW(P0,10), pw1); \
    VRD(5); SBAR(); GAPA(C1=__builtin_amdgcn_mfma_f32_32x32x16_bf16(kf[3],qr[1],C1,0,0,0),   P0[14],P0[15],P1[0],P1[1],   pw1[2]=PKW(P0,12),pw1[3]=PKW(P0,14), pw1); \
    VRD(2); SBAR(); GAPA(C0=__builtin_amdgcn_mfma_f32_32x32x16_bf16(kf[4],qr[2],C0,0,0,0),   P1[2],P1[3],P1[4],P1[5],     pw2[0]=PKW(P1,0), pw2[1]=PKW(P1,2), pw2); \
    VRD(6); SBAR(); GAPA(C1=__builtin_amdgcn_mfma_f32_32x32x16_bf16(kf[5],qr[2],C1,0,0,0),   P1[6],P1[7],P1[8],P1[9],     pw2[2]=PKW(P1,4), pw2[3]=PKW(P1,6), pw2); \
    VRD(3); SBAR(); GAPA(C0=__builtin_amdgcn_mfma_f32_32x32x16_bf16(kf[6],qr[3],C0,0,0,0),   P1[10],P1[11],P1[12],P1[13], pw3[0]=PKW(P1,8), pw3[1]=PKW(P1,10), pw3); \
    VRD(7); SBAR(); GAPA(C1=__builtin_amdgcn_mfma_f32_32x32x16_bf16(kf[7],qr[3],C1,0,0,0),   P1[14],P1[15],0.f,0.f,       pw3[2]=PKW(P1,12),pw3[3]=PKW(P1,14), pw3); \
    l_reg+=sacc; \
    if(GK){DMA_K((t)+3,sl_cur);} if(GV){DMA_V((t)+1,sl_next);} \
    CMASK(C0,C1,t); \
    { float a=MX3(C0[0],C0[1],C1[0]),b=MX3(C0[2],C0[3],C1[1]); a=MX3(a,C1[2],C1[3]); \
      _Pragma("unroll") for(int r=4;r<16;r+=4){a=MX3(a,C0[r],C0[r+1]);b=MX3(b,C0[r+2],C0[r+3]);a=MX3(a,C1[r],C1[r+1]);b=MX3(b,C1[r+2],C1[r+3]);} \
      float rm=__builtin_fmaxf(a,b); { auto rr=__builtin_amdgcn_permlane32_swap(__float_as_uint(rm),__float_as_uint(rm),false,false); rm=__builtin_fmaxf(__uint_as_float(rr[0]),__uint_as_float(rr[1])); } \
      resc=false; \
      if(__builtin_expect(__any(rm>(float)THRL),0)){ const float dl=__builtin_fmaxf(rm,0.f); mhat+=dl; \
        _Pragma("unroll") for(int r=0;r<16;++r){C0[r]-=dl;C1[r]-=dl;} \
        _Pragma("unroll") for(int r=0;r<16;++r)negm[r]=-mhat; asm volatile("":"+v"(negm)); \
        const float f=__builtin_amdgcn_exp2f(-dl); l_reg*=f; if(hi==0)wsf[r32]=f; resc=true; } } \
    SBAR(); \
    GAPB(o[0]=__builtin_amdgcn_mfma_f32_32x32x16_bf16(PAF(0),VFR(0),o[0],0,0,0), C0,0); \
    GAPB(o[1]=__builtin_amdgcn_mfma_f32_32x32x16_bf16(PAF(0),VFR(4),o[1],0,0,0), C0,4); \
    KRD(GL,0); GAPB(o[0]=__builtin_amdgcn_mfma_f32_32x32x16_bf16(PAF(1),VFR(1),o[0],0,0,0), C0,8); \
    KRD(GL,1); GAPB(o[1]=__builtin_amdgcn_mfma_f32_32x32x16_bf16(PAF(1),VFR(5),o[1],0,0,0), C0,12); \
    KRD(GL,2); GAPB(o[0]=__builtin_amdgcn_mfma_f32_32x32x16_bf16(PAF(2),VFR(2),o[0],0,0,0), C1,0); \
    KRD(GL,3); GAPB(o[1]=__builtin_amdgcn_mfma_f32_32x32x16_bf16(PAF(2),VFR(6),o[1],0,0,0), C1,4); \
    GAPB(o[0]=__builtin_amdgcn_mfma_f32_32x32x16_bf16(PAF(3),VFR(3),o[0],0,0,0), C1,8); \
    GAPB(o[1]=__builtin_amdgcn_mfma_f32_32x32x16_bf16(PAF(3),VFR(7),o[1],0,0,0), C1,12); \
    }while(0)
  int t=1;
  #undef CMASK
  #define CMASK(P0,P1,t) do{}while(0)
  for(;t+5<NT;t+=2){
    STEP(pB0,pB1,pA0,pA1,t,true,true,true);     WAIT_BAR(2); RESC(); ROT();
    STEP(pA0,pA1,pB0,pB1,t+1,true,true,true);   WAIT_BAR(2); RESC(); ROT();
  }
  #undef CMASK
  #define CMASK(P0,P1,t) do{}while(0)
  #define ENDW(tt) do{ if((tt)+3<NT){WAIT_BAR(2);} else if((tt)+2<NT){WAIT_BAR(1);} else {WAIT_BAR(0);} }while(0)
  for(;t+1<NT;t+=2){
    STEP(pB0,pB1,pA0,pA1,t,(t+3<NT),(t+1<NT),(t+1<NT));       ENDW(t);   RESC(); ROT();
    STEP(pA0,pA1,pB0,pB1,t+1,(t+4<NT),(t+2<NT),(t+2<NT));     ENDW(t+1); RESC(); ROT();
  }
  STEP(pB0,pB1,pA0,pA1,NT-1,false,false,false); RESC();
  { float sacc=pB0[0]+pB0[1]; _Pragma("unroll") for(int r=2;r<16;++r)sacc+=pB0[r]; _Pragma("unroll") for(int r=0;r<16;++r)sacc+=pB1[r]; l_reg+=sacc;
    pw0=(u32x4){PKW(pB0,0),PKW(pB0,2),PKW(pB0,4),PKW(pB0,6)};pw1=(u32x4){PKW(pB0,8),PKW(pB0,10),PKW(pB0,12),PKW(pB0,14)};pw2=(u32x4){PKW(pB1,0),PKW(pB1,2),PKW(pB1,4),PKW(pB1,6)};pw3=(u32x4){PKW(pB1,8),PKW(pB1,10),PKW(pB1,12),PKW(pB1,14)};
    SBAR(); pv(o,vb0+sl_cur,PAF(0),PAF(1),PAF(2),PAF(3)); }
  #undef PKW
  #undef PAF
  #undef VFR
  #undef PIN
  #undef MX3
  #undef GAPA
  #undef GAPB
  #undef EX
  #undef VRD
  #undef KRD
  #undef STEP
  #undef ENDW
  {auto rr=__builtin_amdgcn_permlane32_swap(__float_as_uint(l_reg),__float_as_uint(l_reg),false,false);l_reg=__uint_as_float(rr[0])+__uint_as_float(rr[1]);}
  if(hi==0)wsf[32+r32]=l_reg;asm volatile("s_waitcnt lgkmcnt(0)":::"memory");
  float rli[16];
  #pragma unroll
  for(int r=0;r<16;++r)rli[r]=__builtin_amdgcn_rcpf(wsf[32+crow(r,hi)]);
  bf16*Ow=O+(rowbase+q0+wid*QBLK)*OPITCH+ocol;
  { bf16*stg=(bf16*)(shm+LDS_OST)+wid*2048;
    #pragma unroll
    for(int r=0;r<16;++r){const int orow=crow(r,hi);
      #pragma unroll
      for(int d0=0;d0<2;++d0)stg[orow*64+d0*32+r32]=__float2bfloat16(o[d0][r]*rli[r]);}
    asm volatile("s_waitcnt lgkmcnt(0)":::"memory");
    #pragma unroll
    for(int i=0;i<4;++i){const int row=i*8+(lane>>3),ch=lane&7; const u32x4 v=*(const u32x4*)(stg+row*64+ch*8); ATTN_STORE16(Ow+(long)row*OPITCH+ch*8,v);} }
  asm volatile("s_waitcnt lgkmcnt(0)\n\ts_barrier":::"memory");
  #undef DMA_K
  #undef DMA_V
  #undef CMASK
  #undef START
  #undef RESC
  #undef ROT
}
constexpr int ATTN_LDS_BYTES=LDS_BYTES;
#undef SBAR
#undef WAIT_BAR
}

#define GAS __attribute__((address_space(1)))
#define LAS __attribute__((address_space(3)))
typedef unsigned short bf16;
typedef unsigned v4u __attribute__((ext_vector_type(4)));
typedef float f32x4 __attribute__((ext_vector_type(4)));
typedef short bf16x8 __attribute__((ext_vector_type(8)));
typedef GAS unsigned gu32;
typedef GAS unsigned long long gu64;
#define RLX_AGENT __ATOMIC_RELAXED, __HIP_MEMORY_SCOPE_AGENT
#define LDS_WAIT() asm volatile("s_waitcnt lgkmcnt(0)" ::: "memory")
#define VM_WAIT() asm volatile("s_waitcnt vmcnt(0)" ::: "memory")
__device__ __forceinline__ unsigned long long rt() { return __builtin_amdgcn_s_memrealtime(); }
__device__ __forceinline__ unsigned f2bf(float f) { unsigned u = __builtin_bit_cast(unsigned, f); return (u + 0x7fffu + ((u >> 16) & 1u)) >> 16; }
__device__ __forceinline__ unsigned pk2(float lo, float hi) { return f2bf(lo) | (f2bf(hi) << 16); }

#define XB_TMO      128
#define XB_XCNT(j)  (256  + 64 * (j))
#define XB_XSUB(j)  (1280 + 64 * (j))
#define XB_XGEN(j)  (2304 + 64 * (j))
#define XB_TOP      3328
#define XB_TOPGEN   3392
#define XCD_BAR_WORDS 3456
#define XB_SPIN_CAP (1u << 18)

__device__ __forceinline__ unsigned xb_ld(unsigned* p)              { return __hip_atomic_load(p, __ATOMIC_RELAXED, __HIP_MEMORY_SCOPE_AGENT); }
__device__ __forceinline__ unsigned xb_add(unsigned* p, unsigned v) { return __hip_atomic_fetch_add(p, v, __ATOMIC_RELAXED, __HIP_MEMORY_SCOPE_AGENT); }
__device__ __forceinline__ unsigned xb_xcc_id() { return (unsigned)__builtin_amdgcn_s_getreg((3 << 11) | 20) & 0xFu; }
#define XB_SPIN(cond, bar) do { unsigned _sp = 0; while (cond) { __builtin_amdgcn_s_sleep(1); \
    if ((++_sp & 255u) == 0u) { if (xb_ld(&(bar)[XB_TMO])) break; if (_sp > XB_SPIN_CAP) { atomicAdd(&(bar)[XB_TMO], 1u); break; } } } } while (0)

struct XcdBarrier {
    unsigned* bar; unsigned x;
    volatile LAS unsigned* st;
};

__device__ __forceinline__ XcdBarrier xcd_barrier_post(unsigned* bar, volatile LAS unsigned* st) {
    XcdBarrier b; b.bar = bar; b.x = xb_xcc_id(); b.st = st;
    if (threadIdx.x == 0) (void)xb_add(&bar[XB_XCNT(b.x)], 1u);
    return b;
}
__device__ __forceinline__ void xcd_barrier_complete(unsigned* bar, unsigned x, unsigned& nloc, unsigned& nx) {
    const unsigned G = gridDim.x * gridDim.y * gridDim.z;
    unsigned sum, cnt, mine, sp = 0u;
    for (;;) {
        sum = 0u; cnt = 0u; mine = 0u;
#pragma unroll
        for (unsigned j = 0; j < 16; ++j) { const unsigned c = xb_ld(&bar[XB_XCNT(j)]); sum += c; cnt += (c > 0u) ? 1u : 0u; mine = (j == x) ? c : mine; }
        if (sum == G) break;
        __builtin_amdgcn_s_sleep(1);
        if ((++sp & 255u) == 0u) { if (xb_ld(&bar[XB_TMO])) break; if (sp > XB_SPIN_CAP) { atomicAdd(&bar[XB_TMO], 1u); break; } }
    }
    nloc = mine > 0u ? mine : 1u; nx = cnt > 0u ? cnt : 1u;
}

__device__ __forceinline__ void xcd_barrier(const XcdBarrier& b) {
    asm volatile("s_waitcnt vmcnt(0)" ::: "memory");
    __syncthreads();
    if (threadIdx.x == 0) {
        unsigned* bar = b.bar;
        __builtin_amdgcn_s_waitcnt(0);
        unsigned nloc = b.st[0], nx = b.st[1];
        if (nloc == 0u) { xcd_barrier_complete(bar, b.x, nloc, nx); b.st[0] = nloc; b.st[1] = nx; }
        const unsigned old = xb_add(&bar[XB_XSUB(b.x)], 1u);
        const unsigned gen = old / nloc;
        if (old + 1u == (gen + 1u) * nloc) {
            __builtin_amdgcn_fence(__ATOMIC_RELEASE, "agent");
            asm volatile("s_waitcnt vmcnt(0)" ::: "memory");
            const unsigned og = xb_add(&bar[XB_TOP], 1u);
            const unsigned tg = og / nx;
            if (og + 1u == (tg + 1u) * nx) xb_add(&bar[XB_TOPGEN], 1u);
            else XB_SPIN(xb_ld(&bar[XB_TOPGEN]) == tg, bar);
            __builtin_amdgcn_fence(__ATOMIC_ACQUIRE, "agent");
            xb_add(&bar[XB_XGEN(b.x)], 1u);
            asm volatile("s_waitcnt vmcnt(0)" ::: "memory");
        } else {
            XB_SPIN(xb_ld(&bar[XB_XGEN(b.x)]) == gen, bar);
            __builtin_amdgcn_fence(__ATOMIC_ACQUIRE, "agent");
            asm volatile("s_waitcnt vmcnt(0)" ::: "memory");
        }
    }
    __syncthreads();
}


#ifndef NO_HIDE_CONV
#define HIDE_CONV 1
#endif
constexpr int NWAVES = 8;
constexpr int BATCH = 4, T = 2048, D = 2048, M = BATCH * T, FF = 5632, NGU = 2 * FF;
constexpr int RWC = 3072, IN_COLS = 10656, IN_PAD = 10752, NLORA = 5120, KLORA = 512;
constexpr float NORM_EPS = 1e-6f, GN_EPS = 64e-5f, SUBLN_EPS = 1e-5f, LAM_INIT = 0.2f;
constexpr float QSCALE = 0.125f * 1.4426950408889634f;

constexpr size_t MiB = 1u << 20;
constexpr size_t WS_CTL = 0, CTL_ZERO_BYTES = 1 * MiB;
constexpr size_t WS_ROPE = 1 * MiB;
constexpr size_t WS_WGU = 2 * MiB;
constexpr size_t WS_WDN = 46 * MiB;
constexpr size_t WS_WIN = 68 * MiB;
constexpr size_t WS_WA = 110 * MiB, WS_WB = 114 * MiB;
constexpr size_t WS_WOUT = 118 * MiB;
constexpr size_t WS_WLORA = 126 * MiB;
constexpr size_t WS_XN = 131 * MiB;
constexpr size_t WS_F = 163 * MiB;
constexpr size_t WS_ACT = 227 * MiB;
constexpr size_t WS_RW = 227 * MiB;
constexpr size_t WS_Q = 275 * MiB, WS_K = 291 * MiB, WS_V = 307 * MiB;
constexpr size_t WS_Y = 275 * MiB;
constexpr size_t WS_GATES = 323 * MiB;
constexpr size_t WS_LR = 387 * MiB;
constexpr size_t WS_G = 387 * MiB;
constexpr size_t WS_LA = 403 * MiB;
constexpr size_t WS_OATT = 411 * MiB;
constexpr size_t WS_END = 443 * MiB;
constexpr int CW_BAR = 4096;

constexpr int RING_OFF = 0, RING_BYTES = 131072;
constexpr int LDSCTL_OFF = RING_BYTES, MISC_OFF = LDSCTL_OFF + 320;
constexpr int LDS_BYTES = 147456;

struct Args { const float* in[32]; float* out; unsigned char* ws; int ph_lo, ph_hi, li, pad; };

__device__ __forceinline__ float wave_sum(float v) {
#pragma unroll
    for (int o = 1; o < 64; o <<= 1) v += __shfl_xor(v, o);
    return v;
}
template <int CTRL> __device__ __forceinline__ float dppf(float x) { return __builtin_bit_cast(float, __builtin_amdgcn_mov_dpp(__builtin_bit_cast(int, x), CTRL, 0xf, 0xf, true)); }
__device__ __forceinline__ float red8(float x) { x += dppf<0xB1>(x); x += dppf<0x4E>(x); x += dppf<0x141>(x); return x; }
__device__ __forceinline__ float red16(float x) { x = red8(x); x += dppf<0x128>(x); return x; }
__device__ __forceinline__ float bf2f(unsigned short h) { return __uint_as_float((unsigned)h << 16); }
__device__ __forceinline__ float bfsel(unsigned w, int lane) { return __uint_as_float((lane & 1) ? (w & 0xffff0000u) : (w << 16)); }
__device__ __forceinline__ float sigm_(float x) { return __builtin_amdgcn_rcpf(1.0f + __builtin_amdgcn_exp2f(-1.4426950408889634f * x)); }
typedef unsigned u32x2 __attribute__((ext_vector_type(2)));
__device__ __forceinline__ f32x4 unpk4(const u32x2 w) { return (f32x4){__uint_as_float(w.x << 16), __uint_as_float(w.x & 0xffff0000u), __uint_as_float(w.y << 16), __uint_as_float(w.y & 0xffff0000u)}; }

__device__ __forceinline__ void transpose_item(const float* W, int K, int N, bf16* WT, int k0, int n0, int drow0, LAS float* scr, int lane) {
#pragma unroll 8
    for (int i = 0; i < 32; ++i) { const int kk = 2 * i + (lane >> 5); scr[kk * 33 + (lane & 31)] = W[(size_t)(k0 + kk) * N + n0 + (lane & 31)]; }
    LDS_WAIT(); asm volatile("" ::: "memory");
    const int c = lane & 7;
#pragma unroll
    for (int j = 0; j < 4; ++j) { const int n = (lane >> 3) + 8 * j; const LAS float* s = scr + (8 * c) * 33 + n;
        v4u o; o.x = pk2(s[0 * 33], s[1 * 33]); o.y = pk2(s[2 * 33], s[3 * 33]); o.z = pk2(s[4 * 33], s[5 * 33]); o.w = pk2(s[6 * 33], s[7 * 33]);
        *(GAS v4u*)(WT + (size_t)(drow0 + n) * K + k0 + 8 * c) = o; }
    LDS_WAIT(); asm volatile("" ::: "memory");
}
__device__ __forceinline__ int map_gu(int n0) { const int which = n0 / FF, cc = n0 % FF; return 256 * (cc / 128) + 128 * which + (cc % 128); }
__device__ __forceinline__ int map_in(int n0) {
    if (n0 < 3488) return n0;
    if (n0 < 5536) { const int seg = n0 - 3488, l = seg & 255, hd = l >> 6, half = (l >> 5) & 1; return 3584 + (seg & ~255) + 128 * half + 32 * hd; }
    if (n0 < 6560) return 5632 + (n0 - 5536);
    return 6656 + (n0 - 6560);
}
__device__ __forceinline__ void conv_ffn_weights(const float* wgu, const float* wdn, unsigned char* ws, LAS float* scr, int gw, int NGW, int lane, int which = 3) {
    constexpr int I_GU = (D / 64) * (NGU / 32), I_DN = (FF / 64) * (D / 32);
    for (int it = ((which & 1) ? 0 : I_GU) + gw; it < ((which & 2) ? I_GU + I_DN : I_GU); it += NGW) {
        if (it < I_GU) { const int nb = it % (NGU / 32), kb = it / (NGU / 32); transpose_item(wgu, D, NGU, (bf16*)(ws + WS_WGU), kb * 64, nb * 32, map_gu(nb * 32), scr, lane); }
        else { const int r = it - I_GU, nb = r % (D / 32), kb = r / (D / 32); transpose_item(wdn, FF, D, (bf16*)(ws + WS_WDN), kb * 64, nb * 32, nb * 32, scr, lane); }
    }
}
__device__ __forceinline__ void rms_row_to_bf16(const float* xrow, const float* g, bf16* orow, int lane) {
    const f32x4* xr = (const f32x4*)xrow + lane; const f32x4* gr = (const f32x4*)g + lane;
    f32x4 v[8]; float s = 0.f;
#pragma unroll
    for (int j = 0; j < 8; ++j) { v[j] = xr[64 * j]; s += (v[j].x * v[j].x + v[j].y * v[j].y) + (v[j].z * v[j].z + v[j].w * v[j].w); }
    const float rs = 1.0f / sqrtf(wave_sum(s) * (1.f / D) + NORM_EPS);
    u32x2* o8 = (u32x2*)orow + lane;
#pragma unroll
    for (int j = 0; j < 8; ++j) { const f32x4 gg = gr[64 * j]; const f32x4 y = v[j] * rs * gg; u32x2 w; w.x = pk2(y.x, y.y); w.y = pk2(y.z, y.w); o8[64 * j] = w; }
}
__device__ __forceinline__ void norm_phase(const float* Fb_, const float* Hin, float* Hout, const float* gpost, float coef, const float* gpre, bf16* XN, int gw, int NGW, int lane) {
    for (int m = gw; m < M; m += NGW) {
        const u32x2* fr = (const u32x2*)((const bf16*)Fb_ + (size_t)m * D) + lane; const f32x4* hr = (const f32x4*)(Hin + (size_t)m * D) + lane; f32x4* ho = (f32x4*)(Hout + (size_t)m * D) + lane;
        f32x4 f[8], h[8]; float s = 0.f;
#pragma unroll
        for (int j = 0; j < 8; ++j) { f[j] = unpk4(fr[64 * j]); h[j] = hr[64 * j]; }
#pragma unroll
        for (int j = 0; j < 8; ++j) s += (f[j].x * f[j].x + f[j].y * f[j].y) + (f[j].z * f[j].z + f[j].w * f[j].w);
        const float rs = coef / sqrtf(wave_sum(s) * (1.f / D) + NORM_EPS);
        float s2 = 0.f;
#pragma unroll
        for (int j = 0; j < 8; ++j) { const f32x4 gg = ((const f32x4*)gpost)[lane + 64 * j]; h[j] = h[j] + f[j] * rs * gg; ho[64 * j] = h[j];
            s2 += (h[j].x * h[j].x + h[j].y * h[j].y) + (h[j].z * h[j].z + h[j].w * h[j].w); }
        if (XN) {
            const float rs2 = 1.0f / sqrtf(wave_sum(s2) * (1.f / D) + NORM_EPS);
            u32x2* o8 = (u32x2*)(XN + (size_t)m * D) + lane;
#pragma unroll
            for (int j = 0; j < 8; ++j) { const f32x4 gg = ((const f32x4*)gpre)[lane + 64 * j]; const f32x4 y = h[j] * rs2 * gg; u32x2 w; w.x = pk2(y.x, y.y); w.y = pk2(y.z, y.w); o8[64 * j] = w; }
        }
    }
}

typedef float f32x2s __attribute__((ext_vector_type(2)));
#define SLO(x) __builtin_shufflevector(x, x, 0, 1)
#define SHI(x) __builtin_shufflevector(x, x, 2, 3)
constexpr int SC_TC = 32, SC_STEP_F = 352, SC_BUF_F = SC_TC * SC_STEP_F, SC_NCH = T / SC_TC;
template <int DIR>
__device__ __forceinline__ void scan_load_chunk(bf16* dbg, LAS float* wb, const bf16* RWb, const bf16* Eb, const bf16* Ab, int t0, int rh, int lane,
                                                float mpr, float mnr, float mpk, float mnk, float mpv, float mnv, float kkc, float kac) {
    constexpr int ts = DIR ? -1 : 1;
    float rr[10], kr[10], vr[10], ee[8], aa[8];
#pragma unroll
    for (int p = 0; p < 10; ++p) { const int t = t0 + (p - 1) * ts; const bool ok = (t >= 0) && (t < T); const unsigned* rp = (const unsigned*)(RWb + (size_t)(ok ? t : 0) * RWC);
        const float a0 = bfsel(rp[0], lane), a1 = bfsel(rp[512], lane), a2 = bfsel(rp[1024], lane); rr[p] = ok ? a0 : 0.f; kr[p] = ok ? a1 : 0.f; vr[p] = ok ? a2 : 0.f; }
#pragma unroll
    for (int q = 0; q < 8; ++q) { const size_t m = (size_t)(t0 + q * ts); ee[q] = bfsel(*(const unsigned*)(Eb + m * 1024), lane); aa[q] = bfsel(*(const unsigned*)(Ab + m * 1024), lane); }
#pragma unroll
    for (int q = 0; q < 8; ++q) {
        constexpr int dummy = 0; (void)dummy;
        const int pc = q + 1, pp = DIR ? q + 2 : q, pn = DIR ? q : q + 2;
        const float r = rr[pc] + mpr * (rr[pp] - rr[pc]) + mnr * (rr[pn] - rr[pc]);
        const float k = kr[pc] + mpk * (kr[pp] - kr[pc]) + mnk * (kr[pn] - kr[pc]);
        const float v = vr[pc] + mpv * (vr[pp] - vr[pc]) + mnv * (vr[pn] - vr[pc]);
        const float a = aa[q], w = __builtin_amdgcn_exp2f(-1.4426950408889634f * ee[q]);
        const float kq = k * kkc; const float n2 = wave_sum(kq * kq); const float kk = kq * (1.0f / sqrtf(fmaxf(n2, 1e-24f)));
        const float kd = k * (1.0f + (a - 1.0f) * kac);
        LAS float* o = wb + q * SC_STEP_F;
        o[lane] = kk; o[64 + lane] = w; o[128 + lane] = kk * a; o[192 + lane] = kd; o[256 + lane] = r;
        if ((lane >> 5) == rh) o[320 + (lane & 31)] = v;
#ifdef SCAN_DBG_LOADER
        if (dbg && (q & 1) == 0) dbg[(size_t)(q >> 1) * 64 + lane] = (bf16)f2bf(kk + w + kk * a + kd + r + v);
#endif
    }
}
__device__ __forceinline__ float wsum64(float x) {
    x += dppf<0xB1>(x); x += dppf<0x4E>(x); x += dppf<0x141>(x); x += dppf<0x128>(x);
    x += __shfl_xor(x, 16); x += __shfl_xor(x, 32); return x;
}
struct ScanRaw { unsigned rr[10], kr[10], vr[10], ee[8], aa[8]; };
template <int DIR>
__device__ __forceinline__ void scan_fetch(ScanRaw& R, const bf16* RWb, const bf16* Eb, const bf16* Ab, int t0) {
    constexpr int ts = DIR ? -1 : 1;
#pragma unroll
    for (int p = 0; p < 10; ++p) { const int t = t0 + (p - 1) * ts; const bool ok = (t >= 0) && (t < T); const bf16* rp = RWb + (size_t)(ok ? t : 0) * RWC;
        R.rr[p] = rp[0]; R.kr[p] = rp[1024]; R.vr[p] = rp[2048]; }
#pragma unroll
    for (int q = 0; q < 8; ++q) { const size_t m = (size_t)(t0 + q * ts); R.ee[q] = Eb[m * 1024]; R.aa[q] = Ab[m * 1024]; }
}
template <int DIR>
__device__ __forceinline__ void scan_prep_store(const ScanRaw& R, LAS float* wb, int t0, int rh, int lane,
                                                float mpr, float mnr, float mpk, float mnk, float mpv, float mnv, float kkc, float kac) {
    constexpr int ts = DIR ? -1 : 1;
    float rr[10], kr[10], vr[10];
#pragma unroll
    for (int p = 0; p < 10; ++p) { const int t = t0 + (p - 1) * ts; const bool ok = (t >= 0) && (t < T);
        rr[p] = ok ? __uint_as_float(R.rr[p] << 16) : 0.f; kr[p] = ok ? __uint_as_float(R.kr[p] << 16) : 0.f; vr[p] = ok ? __uint_as_float(R.vr[p] << 16) : 0.f; }
#pragma unroll
    for (int q = 0; q < 8; ++q) {
        const int pc = q + 1, pp = DIR ? q + 2 : q, pn = DIR ? q : q + 2;
        const float r = rr[pc] + mpr * (rr[pp] - rr[pc]) + mnr * (rr[pn] - rr[pc]);
        const float k = kr[pc] + mpk * (kr[pp] - kr[pc]) + mnk * (kr[pn] - kr[pc]);
        const float v = vr[pc] + mpv * (vr[pp] - vr[pc]) + mnv * (vr[pn] - vr[pc]);
        const float a = __uint_as_float(R.aa[q] << 16), w = __builtin_amdgcn_exp2f(-1.4426950408889634f * __uint_as_float(R.ee[q] << 16));
        const float kq = k * kkc; const float n2 = wsum64(kq * kq); const float kk = kq * __builtin_amdgcn_rsqf(fmaxf(n2, 1e-24f));
        const float kd = k * (1.0f + (a - 1.0f) * kac);
        LAS float* o = wb + q * SC_STEP_F;
        o[lane] = kk; o[64 + lane] = w; o[128 + lane] = kk * a; o[192 + lane] = kd; o[256 + lane] = r;
        if ((lane >> 5) == rh) o[320 + (lane & 31)] = v;
    }
}
#define SCAN_FLUSH(fc) do { const int fs_ = (fc) * SC_TC + lw * 8 + (lane >> 3); const int ft_ = d ? (T - 1 - fs_) : fs_; \
        const f32x4 ov_ = *(const LAS f32x4*)(obuf + ((fc) & 1) * (SC_TC * 32) + (lw * 8 + (lane >> 3)) * 32 + (lane & 7) * 4); \
        u32x2 ow_; ow_.x = pk2(ov_.x, ov_.y); ow_.y = pk2(ov_.z, ov_.w); *(u32x2*)(Od + (size_t)ft_ * 32 + (lane & 7) * 4) = ow_; } while (0)
__device__ __forceinline__ void scan_phase(LAS unsigned char* lds, const bf16* RW, const bf16* EA, bf16* OS, const float* mu_prev, const float* mu_next, const float* k_k, const float* k_a,
                                           int vcu, int G, int wave, int lane) {
    LAS float* buf = (LAS float*)(lds + 16384);
    LAS float* obuf = buf + 2 * SC_BUF_F;
    const bool is_loader = wave < 4;
    for (int wg = vcu; wg < 256; wg += G) {
        const int ch = wg >> 1, rh = wg & 1, d = ch >> 6, b = (ch >> 4) & 3, h = ch & 15;
        const size_t mb = (size_t)b * T;
        const int lw = wave & 3, c_ = h * 64 + lane;
        const float mpr = mu_prev[c_], mnr = mu_next[c_], mpk = mu_prev[1024 + c_], mnk = mu_next[1024 + c_], mpv = mu_prev[2048 + c_], mnv = mu_next[2048 + c_];
        const float kkc = k_k[c_], kac = k_a[c_];
        const int ce = c_ & ~1;
        const bf16* RWb = RW + mb * RWC + c_; const bf16* Eb = EA + ((size_t)d * M + mb) * 1024 + c_; const bf16* Ab = EA + ((size_t)(2 + d) * M + mb) * 1024 + c_; (void)ce;
        const int rowl = lane >> 3, jg = lane & 7, row_local = (wave & 3) * 8 + rowl;
        f32x2s S2[4];
#pragma unroll
        for (int e = 0; e < 4; ++e) S2[e] = (f32x2s){0.f, 0.f};
        bf16* Od = OS + ((size_t)((((d * 4 + b) * 16 + h) * 2 + rh)) * T) * 32;
        ScanRaw R;
        if (is_loader) { const int s0 = lw * 8; if (d == 0) scan_fetch<0>(R, RWb, Eb, Ab, s0); else scan_fetch<1>(R, RWb, Eb, Ab, T - 1 - s0); }
        for (int c = 0; c <= SC_NCH; ++c) {
            if (is_loader) {
                if (c >= 2) SCAN_FLUSH(c - 2);
                if (c < SC_NCH) {
                    const int s0 = c * SC_TC + lw * 8; LAS float* wb = buf + (c & 1) * SC_BUF_F + (lw * 8) * SC_STEP_F;
                    if (d == 0) scan_prep_store<0>(R, wb, s0, rh, lane, mpr, mnr, mpk, mnk, mpv, mnv, kkc, kac);
                    else scan_prep_store<1>(R, wb, T - 1 - s0, rh, lane, mpr, mnr, mpk, mnk, mpv, mnv, kkc, kac);
                    if (c + 1 < SC_NCH) { const int s1 = s0 + SC_TC; if (d == 0) scan_fetch<0>(R, RWb, Eb, Ab, s1); else scan_fetch<1>(R, RWb, Eb, Ab, T - 1 - s1); }
                }
            }
#ifdef SCAN_SYNC
            __syncthreads();
#endif
            if (!is_loader && c > 0) {
                __builtin_amdgcn_s_setprio(3);
                const int cc = c - 1;
                LAS float* obc = obuf + (cc & 1) * (SC_TC * 32);
                const LAS float* bc = buf + (cc & 1) * SC_BUF_F;
                const LAS float* p = bc + jg * 8;
                f32x4 kk0 = *(const LAS f32x4*)(p), kk1 = *(const LAS f32x4*)(p + 4), w0 = *(const LAS f32x4*)(p + 64), w1 = *(const LAS f32x4*)(p + 68), b0 = *(const LAS f32x4*)(p + 128), b1 = *(const LAS f32x4*)(p + 132),
                      k0 = *(const LAS f32x4*)(p + 192), k1 = *(const LAS f32x4*)(p + 196), r0 = *(const LAS f32x4*)(p + 256), r1 = *(const LAS f32x4*)(p + 260);
                float v = bc[320 + row_local];
#pragma unroll 8
                for (int s = 0; s < SC_TC; ++s) {
                    const int sn = (s + 1 < SC_TC) ? s + 1 : s;
                    const LAS float* pn = bc + sn * SC_STEP_F + jg * 8;
                    const f32x4 nkk0 = *(const LAS f32x4*)(pn), nkk1 = *(const LAS f32x4*)(pn + 4), nw0 = *(const LAS f32x4*)(pn + 64), nw1 = *(const LAS f32x4*)(pn + 68), nb0 = *(const LAS f32x4*)(pn + 128), nb1 = *(const LAS f32x4*)(pn + 132),
                                nk0 = *(const LAS f32x4*)(pn + 192), nk1 = *(const LAS f32x4*)(pn + 196), nr0 = *(const LAS f32x4*)(pn + 256), nr1 = *(const LAS f32x4*)(pn + 260);
                    const float nv = bc[sn * SC_STEP_F + 320 + row_local];
                    const f32x2s pa_ = S2[1] * SHI(kk0) + S2[0] * SLO(kk0), pb_ = S2[3] * SHI(kk1) + S2[2] * SLO(kk1); const f32x2s p_ = pa_ + pb_;
                    const f32x2s t0_ = S2[0] * SLO(w0), t1_ = S2[1] * SHI(w0), t2_ = S2[2] * SLO(w1), t3_ = S2[3] * SHI(w1);
                    const float nsa = -red8(p_.x + p_.y);
                    const f32x2s ns2 = (f32x2s){nsa, nsa}, v2 = (f32x2s){v, v};
                    S2[0] = ns2 * SLO(b0) + (v2 * SLO(k0) + t0_); S2[1] = ns2 * SHI(b0) + (v2 * SHI(k0) + t1_);
                    S2[2] = ns2 * SLO(b1) + (v2 * SLO(k1) + t2_); S2[3] = ns2 * SHI(b1) + (v2 * SHI(k1) + t3_);
                    const f32x2s qa_ = S2[1] * SHI(r0) + S2[0] * SLO(r0), qb_ = S2[3] * SHI(r1) + S2[2] * SLO(r1); const f32x2s q_ = qa_ + qb_;
#ifdef SCAN_TRIVIAL
                    const float o = v;
#else
                    const float o = red8(q_.x + q_.y);
#endif
                    if (jg == 0) obc[s * 32 + row_local] = o;
                    kk0 = nkk0; kk1 = nkk1; w0 = nw0; w1 = nw1; b0 = nb0; b1 = nb1; k0 = nk0; k1 = nk1; r0 = nr0; r1 = nr1; v = nv;
                }
                __builtin_amdgcn_s_setprio(0);
            }
            __syncthreads();
        }
        if (is_loader) SCAN_FLUSH(SC_NCH - 1);
        __syncthreads();
    }
}

__device__ __forceinline__ void post_phase(const bf16* __restrict__ RW, const bf16* __restrict__ EAG, const bf16* __restrict__ GG, const bf16* __restrict__ OS, const bf16* __restrict__ OATT, bf16* __restrict__ Y, const float* __restrict__ mu_prev, const float* __restrict__ mu_next, const float* __restrict__ k_a, const float* __restrict__ r_k,
                                           const float* gn_w, const float* gn_b, const float* lq1, const float* lk1, const float* lq2, const float* lk2, const float* subln_g, int gw, int NGW, int lane) {
#pragma unroll 2
    for (int it = gw; it < M * 4; it += NGW) {
        const int m = it >> 2, hq = it & 3, c0 = hq * 256 + 4 * lane, t = m & (T - 1);
        const bool hasp = t > 0, hasn = t < T - 1;
        const int hh = hq * 4 + (lane >> 4), i0 = (lane & 15) * 4, bb = m >> 11;
        const size_t oso = ((size_t)((((bb * 16 + hh) * 2 + (i0 >> 5))) * T) + t) * 32 + (i0 & 31);
        const f32x4 o = unpk4(*(const u32x2*)(OS + oso)) + unpk4(*(const u32x2*)(OS + (size_t)4 * 16 * 2 * T * 32 + oso));
        const bf16* rp = RW + (size_t)m * RWC + c0;
        f32x4 x[3], xp[3], xn[3];
#pragma unroll
        for (int q = 0; q < 3; ++q) { x[q] = unpk4(*(const u32x2*)(rp + q * 1024));
            xp[q] = unpk4(*(const u32x2*)(rp + q * 1024 - (hasp ? RWC : 0))); xn[q] = unpk4(*(const u32x2*)(rp + q * 1024 + (hasn ? RWC : 0)));
            if (!hasp) xp[q] = (f32x4){0.f, 0.f, 0.f, 0.f}; if (!hasn) xn[q] = (f32x4){0.f, 0.f, 0.f, 0.f};
            const f32x4 mp = *(const f32x4*)(mu_prev + q * 1024 + c0), mn = *(const f32x4*)(mu_next + q * 1024 + c0);
            x[q] = x[q] + mp * (xp[q] - x[q]) + mn * (xn[q] - x[q]); }
        const f32x4 a0 = unpk4(*(const u32x2*)(EAG + (size_t)(2 * M + m) * 1024 + c0)), a1 = unpk4(*(const u32x2*)(EAG + (size_t)(3 * M + m) * 1024 + c0));
        const f32x4 g = unpk4(*(const u32x2*)(GG + (size_t)m * 1024 + c0));
        const f32x4 ka = *(const f32x4*)(k_a + c0), rk = *(const f32x4*)(r_k + c0), gw4 = *(const f32x4*)(gn_w + c0), gb4 = *(const f32x4*)(gn_b + c0);
        const float mean = red16((o.x + o.y) + (o.z + o.w)) * (1.f / 64.f);
        const f32x4 dv = o - mean;
        const float var = red16((dv.x * dv.x + dv.y * dv.y) + (dv.z * dv.z + dv.w * dv.w)) * (1.f / 64.f);
        const float rstd = 1.0f / sqrtf(var + GN_EPS);
        const f32x4 ksum = x[1] * (2.0f + (a0 + a1 - 2.0f) * ka);
        const f32x4 bt = x[0] * ksum * rk;
        const float bs = red16((bt.x + bt.y) + (bt.z + bt.w));
        const f32x4 y = (dv * rstd * gw4 + gb4 + x[2] * bs) * g;
        u32x2 w; w.x = pk2(y.x, y.y); w.y = pk2(y.z, y.w);
        *(u32x2*)(Y + (size_t)m * 1024 + c0) = w;
    }
    const float lam = __expf(wave_sum(lq1[lane] * lk1[lane])) - __expf(wave_sum(lq2[lane] * lk2[lane])) + LAM_INIT;
#pragma unroll 2
    for (int m = gw; m < M; m += NGW) {
        const int hv = lane >> 3, d0 = 16 * (lane & 7);
        const bf16* p1 = OATT + (size_t)m * 2048 + (2 * hv) * 128 + d0; const bf16* p2 = p1 + 128;
        const v4u a0 = *(const v4u*)p1, a1 = *(const v4u*)(p1 + 8), b0 = *(const v4u*)p2, b1 = *(const v4u*)(p2 + 8);
        f32x4 df[4];
        df[0] = pg8::unpk_lo(a0) - lam * pg8::unpk_lo(b0); df[1] = pg8::unpk_hi(a0) - lam * pg8::unpk_hi(b0); df[2] = pg8::unpk_lo(a1) - lam * pg8::unpk_lo(b1); df[3] = pg8::unpk_hi(a1) - lam * pg8::unpk_hi(b1);
        float ss = 0.f;
#pragma unroll
        for (int q = 0; q < 4; ++q) ss += (df[q].x * df[q].x + df[q].y * df[q].y) + (df[q].z * df[q].z + df[q].w * df[q].w);
        const float rs = (1.0f - LAM_INIT) / sqrtf(red8(ss) * (1.f / 128.f) + SUBLN_EPS);
#pragma unroll
        for (int q = 0; q < 4; ++q) df[q] = df[q] * rs * *(const f32x4*)(subln_g + d0 + 4 * q);
        bf16* yo = Y + (size_t)(M + m) * 1024 + hv * 128 + d0;
        *(v4u*)yo = pg8::pack8(df[0], df[1]); *(v4u*)(yo + 8) = pg8::pack8(df[2], df[3]);
    }
}


struct Ctx { int vcu, wave, lane; };
typedef const __attribute__((address_space(4))) Args* ArgsP;
template <int ph> __device__ __forceinline__ void run_phase(const Ctx& c, LAS unsigned char* lds, unsigned char* lds_raw) {
    ArgsP ap = (ArgsP)__builtin_amdgcn_kernarg_segment_ptr(); asm volatile("" : "+s"(ap));
    unsigned char* ws = ap->ws; const float* x = ap->in[0]; float* out = ap->out;
    int tid = threadIdx.x; asm volatile("" : "+v"(tid));
    const int G = gridDim.x, bx = blockIdx.x, vcu = (G % 8 == 0) ? (bx % 8) * (G / 8) + bx / 8 : bx, wave = __builtin_amdgcn_readfirstlane(tid >> 6), lane = tid & 63; (void)c;
    const int gw = vcu * NWAVES + wave, NGW = G * NWAVES, gt = vcu * (NWAVES * 64) + tid, NGT = G * NWAVES * 64;
    bf16* XN = (bf16*)(ws + WS_XN); float* Fb = (float*)(ws + WS_F); bf16* ACT = (bf16*)(ws + WS_ACT);
    bf16* RW = (bf16*)(ws + WS_RW); bf16* Qb = (bf16*)(ws + WS_Q); bf16* Kb = (bf16*)(ws + WS_K); bf16* Vb = (bf16*)(ws + WS_V); bf16* Yb = (bf16*)(ws + WS_Y);
    bf16* GATES = (bf16*)(ws + WS_GATES); float* LR = (float*)(ws + WS_LR); bf16* LA = (bf16*)(ws + WS_LA); bf16* OATT = (bf16*)(ws + WS_OATT);
    bf16* EA = (bf16*)(ws + WS_F);
    bf16* Gg = (bf16*)(ws + WS_G);
#ifdef OS_IN_GATES
    bf16* OS = (bf16*)(ws + WS_GATES);
#else
    bf16* OS = (bf16*)(ws + WS_XN);
#endif
    bf16* MERGED = (bf16*)(ws + WS_XN); float* Pb = (float*)(ws + WS_F);
    float* ROPE = (float*)(ws + WS_ROPE);
    (void)XN; (void)Fb; (void)ACT; (void)RW; (void)Qb; (void)Kb; (void)Vb; (void)Yb; (void)GATES; (void)LR; (void)LA; (void)OATT; (void)EA; (void)Gg; (void)OS; (void)MERGED; (void)Pb; (void)ROPE; (void)gw; (void)NGW; (void)gt; (void)NGT; (void)bx;
    (void)tid; (void)x; (void)out; (void)ws;
#ifdef ONLY_PH
    if (ph != ONLY_PH) return;
#endif
#ifdef STOP_AFTER
    if (ph > STOP_AFTER) return;
#endif
#ifdef SKIP_MASK
    if ((SKIP_MASK >> ph) & 1) return;
#endif
        switch (ph) {
        case 0: {
            LAS float* scr = (LAS float*)(lds + RING_OFF + wave * 16384);
#ifdef HIDE_CONV
            conv_ffn_weights(ap->in[2], ap->in[3], ws, scr, gw, NGW, lane, 1);
#else
            conv_ffn_weights(ap->in[2], ap->in[3], ws, scr, gw, NGW, lane);
#endif
#ifndef HIDE_CONV
            constexpr int I_IN = (D / 64) * (IN_COLS / 32), I_BR = (1024 / 64) * (D / 32), I_OUT = (D / 64) * (D / 32);
            for (int it = gw; it < I_IN + 2 * I_BR + I_OUT; it += NGW) {
                int r = it;
                if (r < I_IN) { const int nb = r % (IN_COLS / 32), kb = r / (IN_COLS / 32); transpose_item(ap->in[6], D, IN_COLS, (bf16*)(ws + WS_WIN), kb * 64, nb * 32, map_in(nb * 32), scr, lane); continue; } r -= I_IN;
                if (r < I_BR) { const int nb = r % (D / 32), kb = r / (D / 32); transpose_item(ap->in[24], 1024, D, (bf16*)(ws + WS_WA), kb * 64, nb * 32, nb * 32, scr, lane); continue; } r -= I_BR;
                if (r < I_BR) { const int nb = r % (D / 32), kb = r / (D / 32); transpose_item(ap->in[25], 1024, D, (bf16*)(ws + WS_WB), kb * 64, nb * 32, nb * 32, scr, lane); continue; } r -= I_BR;
                { const int nb = r % (D / 32), kb = r / (D / 32); transpose_item(ap->in[26], D, D, (bf16*)(ws + WS_WOUT), kb * 64, nb * 32, nb * 32, scr, lane); }
            }
#endif
#ifndef HIDE_CONV
            { const float* w_up = ap->in[10]; const float* a_up = ap->in[12]; const float* g_up = ap->in[13]; bf16* WL = (bf16*)(ws + WS_WLORA);
              for (int i = gt; i < NLORA * (KLORA / 8); i += NGT) { const int n = i >> 6, k0 = (i & 63) * 8, ob = n >> 10, c = n & 1023; float v[8];
#pragma unroll
                  for (int e = 0; e < 8; ++e) { const int kk = k0 + e; float val = 0.f;
                      if (ob < 2) { if ((kk >> 6) == ob) val = w_up[(size_t)kk * 1024 + c]; }
                      else if (ob < 4) { if ((kk >> 6) == ob) val = a_up[(size_t)(kk - 128) * 1024 + c]; }
                      else { if (kk >= 256 && kk < 416) val = g_up[(size_t)(kk - 256) * 1024 + c]; }
                      v[e] = val; }
                  v4u o; o.x = pk2(v[0], v[1]); o.y = pk2(v[2], v[3]); o.z = pk2(v[4], v[5]); o.w = pk2(v[6], v[7]);
                  *(v4u*)(WL + (size_t)n * KLORA + k0) = o; } }
#endif
            for (int i = gt; i < T * 32; i += NGT) { const int t = i >> 5, k = i & 31;
                const float inv = __builtin_amdgcn_exp2f(-(float)k * (13.287712379549449f / 32.0f)); const float ang = (float)t * inv;
                const double rev = (double)ang * 0.15915494309189535; const float fr = (float)(rev - floor(rev));
                ROPE[t * 64 + k] = __builtin_amdgcn_cosf(fr); ROPE[t * 64 + 32 + k] = __builtin_amdgcn_sinf(fr); }
            for (int m = gw; m < M; m += NGW) rms_row_to_bf16(x + (size_t)m * D, ap->in[1], XN + (size_t)m * D, lane);
        } break;
        case 1: case 12: {
            pg8::Gemm g{XN, (const bf16*)(ws + WS_WGU), M, NGU, D, nullptr, nullptr}; pg8::StaticOrder S; S.init(M, NGU, G, bx);
            pg8::EpiSwiglu E{ACT, FF};
            pg8::gemm_phase<pg8::EpiSwiglu, pg8::StaticOrder, true, true>(lds + RING_OFF, g, S, E);
#ifdef HIDE_CONV
            if (ph == 1 && G == 256 ? bx >= 128 : ph == 1) { LAS float* scr = (LAS float*)(lds + RING_OFF + wave * 16384);
                const int gw2 = (G == 256) ? (bx - 128) * NWAVES + wave : gw, NGW2 = (G == 256) ? 128 * NWAVES : NGW;
                constexpr int I_IN = (D / 64) * (IN_COLS / 32);
                for (int r = gw2; r < I_IN; r += NGW2) { const int nb = r % (IN_COLS / 32), kb = r / (IN_COLS / 32); transpose_item(ap->in[6], D, IN_COLS, (bf16*)(ws + WS_WIN), kb * 64, nb * 32, map_in(nb * 32), scr, lane); }
                conv_ffn_weights(ap->in[2], ap->in[3], ws, scr, gw2, NGW2, lane, 2);
            }
            if (ph == 12 && G == 256 ? bx >= 128 : ph == 12) { LAS float* scr = (LAS float*)(lds + RING_OFF + wave * 16384);
                conv_ffn_weights(ap->in[29], ap->in[30], ws, scr, (G == 256) ? (bx - 128) * NWAVES + wave : gw, (G == 256) ? 128 * NWAVES : NGW, lane, 2); }
#endif
        } break;
        case 2: case 10: case 13: {
            const bool isout = (ph == 10);
            pg8::Gemm g{isout ? MERGED : ACT, (const bf16*)(ws + (isout ? WS_WOUT : WS_WDN)), M, D, isout ? D : FF, nullptr, nullptr}; pg8::StaticOrder S; S.init(M, D, G, bx);
            pg8::EpiB16 E{(bf16*)Fb, D};
            pg8::gemm_phase<pg8::EpiB16, pg8::StaticOrder, true, true>(lds + RING_OFF, g, S, E);
        } break;
        case 3: case 11: case 14: {
            const float* gpost = ap->in[ph == 3 ? 4 : (ph == 11 ? 27 : 31)]; const float* gpre = ap->in[ph == 3 ? 5 : 28];
            norm_phase(Fb, ph == 3 ? x : out, out, gpost, ph == 11 ? 1.0f : 0.5f, gpre, ph == 14 ? (bf16*)nullptr : XN, gw, NGW, lane);
        } break;
        case 4: {
            pg8::Gemm g{XN, (const bf16*)(ws + WS_WIN), M, IN_PAD, D, nullptr, nullptr}; pg8::StaticOrder S; S.init(M, IN_PAD, G, bx);
            pg8::EpiIn E{RW, Qb, Kb, Vb, GATES, LR, ROPE, QSCALE};
            pg8::gemm_phase<pg8::EpiIn, pg8::StaticOrder, true, true>(lds + RING_OFF, g, S, E);
#ifdef HIDE_CONV
            if (G == 256 ? bx >= 64 : true) { LAS float* scr = (LAS float*)(lds + RING_OFF + wave * 16384);
                const int gw2 = (G == 256) ? (bx - 64) * NWAVES + wave : gw, NGW2 = (G == 256) ? 192 * NWAVES : NGW;
                conv_ffn_weights(ap->in[29], ap->in[30], ws, scr, gw2, NGW2, lane, 1);
                constexpr int I_BR = (1024 / 64) * (D / 32), I_OUT = (D / 64) * (D / 32);
                for (int it = gw2; it < 2 * I_BR + I_OUT; it += NGW2) { int r = it;
                    if (r < I_BR) { const int nb = r % (D / 32), kb = r / (D / 32); transpose_item(ap->in[24], 1024, D, (bf16*)(ws + WS_WA), kb * 64, nb * 32, nb * 32, scr, lane); continue; } r -= I_BR;
                    if (r < I_BR) { const int nb = r % (D / 32), kb = r / (D / 32); transpose_item(ap->in[25], 1024, D, (bf16*)(ws + WS_WB), kb * 64, nb * 32, nb * 32, scr, lane); continue; } r -= I_BR;
                    { const int nb = r % (D / 32), kb = r / (D / 32); transpose_item(ap->in[26], D, D, (bf16*)(ws + WS_WOUT), kb * 64, nb * 32, nb * 32, scr, lane); } }
                const int gt2 = (G == 256) ? (bx - 64) * (NWAVES * 64) + tid : gt, NGT2 = (G == 256) ? 192 * NWAVES * 64 : NGT;
            { const float* w_up = ap->in[10]; const float* a_up = ap->in[12]; const float* g_up = ap->in[13]; bf16* WL = (bf16*)(ws + WS_WLORA);
              for (int i = gt2; i < NLORA * (KLORA / 8); i += NGT2) { const int n = i >> 6, k0 = (i & 63) * 8, ob = n >> 10, c = n & 1023; float v[8];
#pragma unroll
                  for (int e = 0; e < 8; ++e) { const int kk = k0 + e; float val = 0.f;
                      if (ob < 2) { if ((kk >> 6) == ob) val = w_up[(size_t)kk * 1024 + c]; }
                      else if (ob < 4) { if ((kk >> 6) == ob) val = a_up[(size_t)(kk - 128) * 1024 + c]; }
                      else { if (kk >= 256 && kk < 416) val = g_up[(size_t)(kk - 256) * 1024 + c]; }
                      v[e] = val; }
                  v4u o; o.x = pk2(v[0], v[1]); o.y = pk2(v[2], v[3]); o.z = pk2(v[4], v[5]); o.w = pk2(v[6], v[7]);
                  *(v4u*)(WL + (size_t)n * KLORA + k0) = o; } }
            }
#endif
        } break;
        case 5: {
            const float* mu_prev = ap->in[7]; const float* mu_next = ap->in[8];
            for (int i = gt; i < M * 64; i += NGT) { const int m = i >> 6, grp = i & 63, c0 = grp * 8, t = m & (T - 1);
                f32x4 y0 = (f32x4){0.f, 0.f, 0.f, 0.f}, y1 = y0;
                if (grp < 52) {
                    const float* cp = LR + (size_t)m * 512 + c0; const f32x4 z = (f32x4){0.f, 0.f, 0.f, 0.f};
                    const f32x4 c_0 = *(const f32x4*)cp, c_1 = *(const f32x4*)(cp + 4);
                    const f32x4 p_0 = t > 0 ? *(const f32x4*)(cp - 512) : z, p_1 = t > 0 ? *(const f32x4*)(cp - 508) : z;
                    const f32x4 n_0 = t < T - 1 ? *(const f32x4*)(cp + 512) : z, n_1 = t < T - 1 ? *(const f32x4*)(cp + 516) : z;
                    const f32x4 mp0 = *(const f32x4*)(mu_prev + 3072 + c0), mp1 = *(const f32x4*)(mu_prev + 3076 + c0), mn0 = *(const f32x4*)(mu_next + 3072 + c0), mn1 = *(const f32x4*)(mu_next + 3076 + c0);
                    y0 = c_0 + mp0 * (p_0 - c_0) + mn0 * (n_0 - c_0); y1 = c_1 + mp1 * (p_1 - c_1) + mn1 * (n_1 - c_1);
                    if (c0 < 128) {
#pragma unroll
                        for (int e = 0; e < 4; ++e) { y0[e] = 2.0f * sigm_(2.0f * y0[e]) - 1.0f; y1[e] = 2.0f * sigm_(2.0f * y1[e]) - 1.0f; } }
                    else if (c0 >= 256) {
#pragma unroll
                        for (int e = 0; e < 4; ++e) { y0[e] = sigm_(y0[e]); y1[e] = sigm_(y1[e]); } }
                }
                *(v4u*)(LA + (size_t)m * 512 + c0) = pg8::pack8(y0, y1); }
#ifndef HIDE_CONV
            LAS float* scr = (LAS float*)(lds + RING_OFF + wave * 16384);
            conv_ffn_weights(ap->in[29], ap->in[30], ws, scr, gw, NGW, lane);
#endif
        } break;
        case 6: {
            pg8::Gemm g{LA, (const bf16*)(ws + WS_WLORA), M, NLORA, KLORA, nullptr, nullptr}; pg8::LoraOrder S; S.so.init(M, NLORA, G, bx);
            pg8::EpiLora E{EA, Gg, ap->in[9], ap->in[11]};
            pg8::gemm_phase<pg8::EpiLora, pg8::LoraOrder, true, true>(lds + RING_OFF, g, S, E);
        } break;
        case 7: {
            scan_phase(lds + RING_OFF, RW, EA, OS, ap->in[7], ap->in[8], ap->in[14], ap->in[15], vcu, G, wave, lane);
            __syncthreads();
#ifdef SKIP_ATTN
            if (true) break;
#endif
            const int upc = (1024 + G - 1) / G;
            for (int i = 0; i < upc; ++i) { const int unit = vcu * upc + i; if (unit >= 1024) break;
                const int qb = unit & 7, vh = (unit >> 3) & 1, j = (unit >> 4) & 15, b = unit >> 8;
                attn_body::attn_unit<8>(b, j, (j >> 1) * 128 + vh * 64, j * 128 + vh * 64, qb, (const attn_body::bf16*)Qb, (const attn_body::bf16*)Kb, (const attn_body::bf16*)Vb, (attn_body::bf16*)OATT, (char*)lds_raw + RING_OFF); }
        } break;
        case 8: {
            post_phase(RW, EA, Gg, OS, OATT, Yb, ap->in[7], ap->in[8], ap->in[15], ap->in[16], ap->in[17], ap->in[18], ap->in[19], ap->in[20], ap->in[21], ap->in[22], ap->in[23], gw, NGW, lane);
        } break;
        case 9: {
            pg8::Gemm g{Yb, (const bf16*)(ws + WS_WA), M, D, 1024, Yb + (size_t)M * 1024, (const bf16*)(ws + WS_WB)}; pg8::BranchOrder S; S.so.init(M, D, G, bx);
            pg8::EpiBranch E{Pb, MERGED, GATES};
            pg8::gemm_phase<pg8::EpiBranch, pg8::BranchOrder, true, true>(lds + RING_OFF, g, S, E);
        } break;
        }
}
__device__ __forceinline__ void ap_out_nan(float* out, int i) { out[i] = __builtin_nanf(""); }
#ifndef USE_XCD_BARRIER
#define USE_XCD_BARRIER 1
#endif
#if USE_XCD_BARRIER
#define GRID_SYNC() xcd_barrier(bar)
#else
#define GRID_SYNC() cooperative_groups::this_grid().sync()
#endif
#ifndef CUT_LIST
#define CUT_LIST {0, 15}
#endif
__global__ void __launch_bounds__(NWAVES * 64, 2) mk_fwd(Args args) {
    extern __shared__ __attribute__((aligned(16))) unsigned char lds_raw[];
    LAS unsigned char* lds = (LAS unsigned char*)lds_raw;
    volatile LAS unsigned* MISC = (volatile LAS unsigned*)(lds + MISC_OFF);
    const int tid = threadIdx.x, lane = tid & 63, wave = __builtin_amdgcn_readfirstlane(tid >> 6);
    const int G = gridDim.x; const int bx = blockIdx.x; const int vcu = (G % 8 == 0) ? (bx % 8) * (G / 8) + bx / 8 : bx;
    unsigned char* ws = args.ws;
    gu32* ctl = (gu32*)(ws + WS_CTL);
    for (int u = tid; u < (LDS_BYTES - LDSCTL_OFF) / 4; u += NWAVES * 64) ((LAS unsigned*)(lds + LDSCTL_OFF))[u] = 0u;
    __syncthreads();
    XcdBarrier bar = xcd_barrier_post((unsigned*)(ctl + CW_BAR) + args.li * XCD_BAR_WORDS, MISC + 8);
    const int ph_lo = args.ph_lo, ph_hi = args.ph_hi;
#ifdef DUMP_SCAN_INPUTS
    if (ph_lo == 7) {
        for (size_t i_ = (size_t)blockIdx.x * 512 + threadIdx.x; i_ < (size_t)M * D; i_ += (size_t)gridDim.x * 512) {
            float s_ = 0.f;
            { const unsigned* W_ = (const unsigned*)(ws + WS_RW); if (i_ < (size_t)48 * MiB / 4) s_ += (float)(W_[i_] & 0xfffffu) + (float)(W_[i_] >> 20); }
            { const unsigned* W_ = (const unsigned*)(ws + WS_F); s_ += (float)(W_[i_] & 0xfffffu) + (float)(W_[i_] >> 20); }
            if (i_ < 3488) s_ += args.in[7][i_] + args.in[8][i_];
            if (i_ < 1024) s_ += args.in[14][i_] + args.in[15][i_];
            args.out[i_] = s_; }
        return; }
    if (ph_lo > 7) return;
#endif
#ifdef DUMP_OS_AT8
    if (ph_lo == 8) {
        for (size_t i_ = (size_t)blockIdx.x * 512 + threadIdx.x; i_ < (size_t)M * D; i_ += (size_t)gridDim.x * 512) {
            float s_ = 0.f;
            if (DUMP_OS_AT8 & 1) { const unsigned* W_ = (const unsigned*)(ws + WS_XN); if (i_ < (size_t)32 * MiB / 4) s_ += (float)(W_[i_] & 0xfffffu) + (float)(W_[i_] >> 20); }
            if (DUMP_OS_AT8 & 4) { const unsigned* W_ = (const unsigned*)(ws + WS_GATES); s_ += (float)(W_[i_] & 0xfffffu) + (float)(W_[i_] >> 20); }
            if (DUMP_OS_AT8 & 8) { const unsigned* W_ = (const unsigned*)(ws + WS_GATES); if (i_ < 256 * 8 * 4 * 64) s_ += (float)(W_[i_] & 0xfffffu) + (float)(W_[i_] >> 20); }
            if (DUMP_OS_AT8 & 2) { const unsigned* W_ = (const unsigned*)(ws + WS_OATT); if (i_ < (size_t)32 * MiB / 4) s_ += (float)(W_[i_] & 0xfffffu) + (float)(W_[i_] >> 20); }
            args.out[i_] = s_; }
        return; }
#endif
    Ctx c{vcu, wave, lane};
#ifdef DUMP_AFTER
#define DUMP_AFTER_7X(n) ((n) == 7 && DUMP_AFTER > 70)
#define DUMPR(off, nbytes) do { const unsigned* W_ = (const unsigned*)(ws + (off)); const size_t n_ = (size_t)(nbytes) / 4; \
        for (size_t i_ = (size_t)blockIdx.x * 512 + threadIdx.x; i_ < (size_t)M * D; i_ += (size_t)gridDim.x * 512) { float s_ = 0.f; for (size_t j_ = i_; j_ < n_; j_ += (size_t)M * D) s_ += (float)(W_[j_] & 0xfffffu); args.out[i_] += s_; } } while (0)
#define DUMPCHK(k) if (DUMP_AFTER == (k)) { for (size_t i_ = (size_t)blockIdx.x * 512 + threadIdx.x; i_ < (size_t)M * D; i_ += (size_t)gridDim.x * 512) args.out[i_] = 0.f; \
        if ((k) == 4) { DUMPR(WS_RW, 48 * MiB); DUMPR(WS_Q, 48 * MiB); DUMPR(WS_GATES, 64 * MiB); } \
        if ((k) == 5) { DUMPR(WS_LA, 8 * MiB); DUMPR(WS_WGU, 66 * MiB); } \
        if ((k) == 6) { DUMPR(WS_F, 64 * MiB); DUMPR(WS_G, 16 * MiB); } \
        if ((k) == 7) { DUMPR(WS_XN, 32 * MiB); DUMPR(WS_OATT, 32 * MiB); } \
        if ((k) == 71) { DUMPR(WS_XN, 32 * MiB); } \
        if ((k) == 72) { DUMPR(WS_OATT, 32 * MiB); } \
        if ((k) == 8) { DUMPR(WS_Y, 32 * MiB); } \
        if ((k) == 9) { DUMPR(WS_XN, 32 * MiB); } \
        if ((k) == 10) { DUMPR(WS_F, 64 * MiB); } \
        return; }
#else
#define DUMPCHK(k)
#define DUMP_AFTER_7X(n) false
#endif
#ifdef HASH_AFTER
#define HASHCHK(n) if ((n) == HASH_AFTER) { unsigned hs_ = 0u; const unsigned* W_ = (const unsigned*)(ws + (size_t)(HASH_LO) * MiB); const size_t n_ = (size_t)((HASH_HI) - (HASH_LO)) * MiB / 4; \
        for (size_t i_ = (size_t)blockIdx.x * 512 + threadIdx.x; i_ < n_; i_ += (size_t)gridDim.x * 512) { const unsigned w_ = W_[i_]; hs_ += w_ * 2654435761u + (w_ >> 15) + (unsigned)i_ * (w_ | 1u); } \
        atomicAdd((unsigned*)(ctl + 100000), hs_); GRID_SYNC(); const unsigned hv_ = xb_ld((unsigned*)(ctl + 100000)); \
        for (size_t i_ = (size_t)blockIdx.x * 512 + threadIdx.x; i_ < (size_t)M * D; i_ += (size_t)gridDim.x * 512) args.out[i_] = (float)((hv_ ^ (unsigned)(i_ * 40503u)) & 0xffffu); \
        return; }
#else
#define HASHCHK(n)
#endif
#ifdef DUP_PHASE
#define DUPRUN(n) if ((n) == DUP_PHASE) { run_phase<n>(c, lds, lds_raw); GRID_SYNC(); }
#else
#define DUPRUN(n)
#endif
#define PH(n) if (ph_lo <= (n) && (n) < ph_hi) { DUPRUN(n) run_phase<n>(c, lds, lds_raw); if ((n) + 1 < ph_hi) { GRID_SYNC(); } HASHCHK(n) }
    PH(0) PH(1) PH(2) PH(3) PH(4) PH(5) PH(6) PH(7) PH(8) PH(9) PH(10) PH(11) PH(12) PH(13)
    PH(14)
    if (ph_hi == 15 && (xb_ld((unsigned*)(ctl + CW_BAR) + XB_TMO) | xb_ld((unsigned*)(ctl + CW_BAR) + XCD_BAR_WORDS + XB_TMO) | xb_ld((unsigned*)(ctl + CW_BAR) + 2 * XCD_BAR_WORDS + XB_TMO)) != 0u) { asm volatile("s_waitcnt vmcnt(0)" ::: "memory"); if (threadIdx.x < 64) ap_out_nan(args.out, blockIdx.x * 64 + threadIdx.x); }
#undef PH
}

extern "C" void kernel_launch(void* const* d_in, const int* in_sizes, int n_in, void* d_out, int out_size, void* d_ws, size_t ws_size, hipStream_t stream) {
    static int grid = 0;
    if (grid == 0) {
        if (n_in != 32 || in_sizes[0] != M * D || out_size != M * D || ws_size < WS_END) { fprintf(stderr, "kernel_launch: unexpected shapes (n_in %d, ws %zu)\n", n_in, ws_size); grid = -1; return; }
        int dev = 0, cus = 0, per_cu = 0;
        if (hipGetDevice(&dev) != hipSuccess || hipDeviceGetAttribute(&cus, hipDeviceAttributeMultiprocessorCount, dev) != hipSuccess) { grid = -1; return; }
        if (hipFuncSetAttribute((const void*)mk_fwd, hipFuncAttributeMaxDynamicSharedMemorySize, LDS_BYTES) != hipSuccess) { fprintf(stderr, "kernel_launch: hipFuncSetAttribute failed\n"); grid = -1; return; }
        if (hipOccupancyMaxActiveBlocksPerMultiprocessor(&per_cu, (const void*)mk_fwd, NWAVES * 64, LDS_BYTES) != hipSuccess || per_cu < 1) { fprintf(stderr, "kernel_launch: occupancy query says %d\n", per_cu); per_cu = 1; }
        (void)hipGetLastError();
        grid = cus;
    }
    if (grid < 0) return;
    if (hipMemsetAsync((char*)d_ws + WS_CTL, 0, CTL_ZERO_BYTES, stream) != hipSuccess) return;
    Args a{};
    for (int i = 0; i < 32; ++i) a.in[i] = (const float*)d_in[i];
    a.out = (float*)d_out; a.ws = (unsigned char*)d_ws;
#if USE_XCD_BARRIER
#ifndef N_CUTS
#define N_CUTS 1
#endif
    static const int cuts[N_CUTS + 1] = CUT_LIST;
    for (int li = 0; li < N_CUTS; ++li) { a.ph_lo = cuts[li]; a.ph_hi = cuts[li + 1]; a.li = li;
        hipLaunchKernelGGL(mk_fwd, dim3(grid), dim3(NWAVES * 64), LDS_BYTES, stream, a); }
#else
    void* kargs[] = {&a};
    hipError_t e = hipLaunchCooperativeKernel((const void*)mk_fwd, dim3(grid), dim3(NWAVES * 64), kargs, LDS_BYTES, stream);
    if (e != hipSuccess) fprintf(stderr, "cooperative launch failed: %s (grid %d)\n", hipGetErrorString(e), grid);
#endif
}
```

```cpp
#include <hip/hip_runtime.h>
#include <hip/hip_cooperative_groups.h>
#include <cstdio>
#include <cstdint>
namespace pg8 {
#define PG8_LAS __attribute__((address_space(3)))
typedef unsigned short bf16_t;
typedef short bf16x8 __attribute__((ext_vector_type(8)));
typedef float f32x4 __attribute__((ext_vector_type(4)));
typedef unsigned u32x4 __attribute__((ext_vector_type(4)));
constexpr int BM = 256, BK = 64, HALF = 128, HTB = HALF * BK * 2  , STAGE_BYTES = 8 * HTB, NXCD = 8, WGM = 8;

__host__ __device__ __forceinline__ int lds_byte(int r, int c) { const int st = (r >> 4) * 2 + (c >> 5), rr = r & 15, cc = c & 31, ob = rr * 64 + cc * 2; return st * 1024 + (ob ^ (((ob >> 9) & 1) << 5)); }
__host__ __device__ __forceinline__ void stage_rc(int b, int& R, int& C) { const int st = b / 1024, sb = b % 1024, swz = sb ^ (((sb >> 9) & 1) << 5); R = (st >> 1) * 16 + swz / 64; C = (st & 1) * 32 + (swz % 64) / 2; }
__host__ __device__ __forceinline__ int perm32(int rho) { const int n = rho >> 4, i = rho & 15; return 8 * (i >> 2) + 4 * n + (i & 3); }

struct Unit { int pm, pn, sel, kbeg, nt; };
struct Gemm { const bf16_t* A; const bf16_t* Bt; int M, N, K; const bf16_t* A2; const bf16_t* Bt2; };

struct StaticOrder {
    int nM, nN, nwg, G, c;
    __host__ __device__ void init(int M, int N, int G_, int c_) { nM = M / BM; nN = N / BM; nwg = nM * nN; G = G_; c = c_; }
    __host__ __device__ bool next(int i, Unit& u) const {
        const long L = (long)i * G + c; if (L >= nwg) return false;
        int wgid = (int)L; { const int q = nwg / NXCD, r = nwg % NXCD, xcd = wgid % NXCD, off = wgid / NXCD; wgid = (xcd < r ? xcd * (q + 1) : r * (q + 1) + (xcd - r) * q) + off; }
        const int nig = WGM * nN, gid = wgid / nig, fm = gid * WGM, gsz = (nM - fm) < WGM ? (nM - fm) : WGM;
        u.pm = fm + ((wgid % nig) % gsz); u.pn = (wgid % nig) / gsz; u.sel = 0; u.kbeg = 0; u.nt = 0; return true;
    }
    __device__ __forceinline__ void a_ready(const Unit&) const {}
    __device__ __forceinline__ void done(const Unit&) const {}
};


typedef float f32x2c_t __attribute__((ext_vector_type(2))); typedef __bf16 bf16x2c_t __attribute__((ext_vector_type(2)));
__device__ __forceinline__ unsigned cvt_pk_bf16(float lo, float hi) { f32x2c_t v = {lo, hi}; bf16x2c_t b = __builtin_convertvector(v, bf16x2c_t); return __builtin_bit_cast(unsigned, b); }
__device__ __forceinline__ float sigm(float x) { return __builtin_amdgcn_rcpf(1.0f + __builtin_amdgcn_exp2f(-1.4426950408889634f * x)); }
__device__ __forceinline__ u32x4 pack8(const f32x4 a, const f32x4 b) { u32x4 w; w.x = cvt_pk_bf16(a[0], a[1]); w.y = cvt_pk_bf16(a[2], a[3]); w.z = cvt_pk_bf16(b[0], b[1]); w.w = cvt_pk_bf16(b[2], b[3]); return w; }
__device__ __forceinline__ f32x4 unpk_lo(const u32x4 w) { return (f32x4){__uint_as_float(w.x << 16), __uint_as_float(w.x & 0xffff0000u), __uint_as_float(w.y << 16), __uint_as_float(w.y & 0xffff0000u)}; }
__device__ __forceinline__ f32x4 unpk_hi(const u32x4 w) { return (f32x4){__uint_as_float(w.z << 16), __uint_as_float(w.z & 0xffff0000u), __uint_as_float(w.w << 16), __uint_as_float(w.w & 0xffff0000u)}; }

template <int ACT>
__device__ __forceinline__ void store_nat_bf16(const f32x4 (&acc)[2][2][4][2], bf16_t* O, int ldc, int row0, int colt, int wc, int fq, const float* bias) {
    const int col0 = colt + wc * 32 + 8 * fq;
    f32x4 bv[2][2];
#pragma unroll
    for (int bj = 0; bj < 2; ++bj)
#pragma unroll
        for (int n = 0; n < 2; ++n) bv[bj][n] = bias ? *(const f32x4*)(bias + col0 + bj * HALF + 4 * n) : (f32x4){0.f, 0.f, 0.f, 0.f};
#pragma unroll
    for (int ai = 0; ai < 2; ++ai)
#pragma unroll
        for (int m = 0; m < 4; ++m) { bf16_t* rowp = O + (size_t)(row0 + ai * HALF + m * 16) * ldc + col0;
#pragma unroll
            for (int bj = 0; bj < 2; ++bj) { f32x4 v0 = acc[ai][bj][m][0] + bv[bj][0], v1 = acc[ai][bj][m][1] + bv[bj][1];
                if (ACT >= 1) {
#pragma unroll
                    for (int e = 0; e < 4; ++e) { v0[e] = sigm(v0[e]); v1[e] = sigm(v1[e]); }
                    if (ACT == 2) { v0 = v0 * 0.6065306597f; v1 = v1 * 0.6065306597f; } }
                *(u32x4*)(rowp + bj * HALF) = pack8(v0, v1); } }
}

struct EpiSwiglu {
    static constexpr bool PERM = true, AFTER_DRAIN = false;
    bf16_t* O; int ldc;
    __device__ __forceinline__ void operator()(const f32x4 (&acc)[2][2][4][2], const Unit& u, int wr, int wc, int fr, int fq) const {
        const int row0 = u.pm * BM + wr * 64 + fr, col0 = u.pn * HALF + wc * 32 + 8 * fq;
#pragma unroll
        for (int ai = 0; ai < 2; ++ai)
#pragma unroll
            for (int m = 0; m < 4; ++m) { bf16_t* rowp = O + (size_t)(row0 + ai * HALF + m * 16) * ldc + col0;
                f32x4 v0, v1;
#pragma unroll
                for (int e = 0; e < 4; ++e) { const float g0 = acc[ai][0][m][0][e], g1 = acc[ai][0][m][1][e];
                    v0[e] = g0 * sigm(g0) * acc[ai][1][m][0][e]; v1[e] = g1 * sigm(g1) * acc[ai][1][m][1][e]; }
                *(u32x4*)rowp = pack8(v0, v1); }
    }
};

struct EpiF32 {
    static constexpr bool PERM = true, AFTER_DRAIN = false;
    float* O; int ldc;
    __device__ __forceinline__ void operator()(const f32x4 (&acc)[2][2][4][2], const Unit& u, int wr, int wc, int fr, int fq) const {
        const int row0 = u.pm * BM + wr * 64 + fr, col0 = u.pn * BM + wc * 32 + 8 * fq;
#pragma unroll
        for (int ai = 0; ai < 2; ++ai)
#pragma unroll
            for (int m = 0; m < 4; ++m) { float* rowp = O + (size_t)(row0 + ai * HALF + m * 16) * ldc + col0;
#pragma unroll
                for (int bj = 0; bj < 2; ++bj) { *(f32x4*)(rowp + bj * HALF) = acc[ai][bj][m][0]; *(f32x4*)(rowp + bj * HALF + 4) = acc[ai][bj][m][1]; } }
    }
};

struct EpiB16 {
    static constexpr bool PERM = true, AFTER_DRAIN = false;
    bf16_t* O; int ldc;
    __device__ __forceinline__ void operator()(const f32x4 (&acc)[2][2][4][2], const Unit& u, int wr, int wc, int fr, int fq) const {
        store_nat_bf16<0>(acc, O, ldc, u.pm * BM + wr * 64 + fr, u.pn * BM, wc, fq, nullptr);
    }
};

struct EpiIn {
    static constexpr bool PERM = true, AFTER_DRAIN = false;
    bf16_t *RW, *Q, *K, *V, *GATES; float* LR; const float* rope; float qscale;
    __device__ __forceinline__ void operator()(const f32x4 (&acc)[2][2][4][2], const Unit& u, int wr, int wc, int fr, int fq) const {
        const int pn = u.pn, row0 = u.pm * BM + wr * 64 + fr;
        if (pn < 12) store_nat_bf16<0>(acc, RW, 3072, row0, pn * 256, wc, fq, nullptr);
        else if (pn < 14) {
            const int col0 = (pn - 12) * 256 + wc * 32 + 8 * fq;
#pragma unroll
            for (int ai = 0; ai < 2; ++ai)
#pragma unroll
                for (int m = 0; m < 4; ++m) { float* rowp = LR + (size_t)(row0 + ai * HALF + m * 16) * 512 + col0;
#pragma unroll
                    for (int bj = 0; bj < 2; ++bj) { *(f32x4*)(rowp + bj * HALF) = acc[ai][bj][m][0]; *(f32x4*)(rowp + bj * HALF + 4) = acc[ai][bj][m][1]; } }
        } else if (pn < 22) {
            const bool isk = pn >= 18; bf16_t* base = isk ? K : Q; const float sc = isk ? 1.0f : qscale;
            const int head = 4 * ((pn - 14) & 3) + wc;
#pragma unroll
            for (int ai = 0; ai < 2; ++ai)
#pragma unroll
                for (int m = 0; m < 4; ++m) { const int row = row0 + ai * HALF + m * 16; const float* cp = rope + (size_t)(row & 2047) * 64 + 8 * fq;
                    const f32x4 c0 = *(const f32x4*)cp, c1 = *(const f32x4*)(cp + 4), s0 = *(const f32x4*)(cp + 32), s1 = *(const f32x4*)(cp + 36);
                    const f32x4 x1a = acc[ai][0][m][0], x1b = acc[ai][0][m][1], x2a = acc[ai][1][m][0], x2b = acc[ai][1][m][1];
                    const f32x4 o1a = (x1a * c0 - x2a * s0) * sc, o1b = (x1b * c1 - x2b * s1) * sc, o2a = (x2a * c0 + x1a * s0) * sc, o2b = (x2b * c1 + x1b * s1) * sc;
                    bf16_t* rowp = base + (size_t)row * 1024 + head * 64 + 8 * fq;
                    *(u32x4*)rowp = pack8(o1a, o1b); *(u32x4*)(rowp + 32) = pack8(o2a, o2b); }
        } else if (pn < 26) store_nat_bf16<0>(acc, V, 1024, row0, (pn - 22) * 256, wc, fq, nullptr);
        else store_nat_bf16<1>(acc, GATES, 4096, row0, (pn - 26) * 256, wc, fq, nullptr);
    }
};

struct EpiLora {
    static constexpr bool PERM = true, AFTER_DRAIN = false;
    bf16_t* EAG; bf16_t* GG; const float* w0; const float* a0;
    __device__ __forceinline__ void operator()(const f32x4 (&acc)[2][2][4][2], const Unit& u, int wr, int wc, int fr, int fq) const {
        const int ob = u.pn >> 2, colt = (u.pn & 3) * 256, row0 = u.pm * BM + wr * 64 + fr;
        bf16_t* O = EAG + (size_t)ob * 8192 * 1024;
        if (ob < 2) store_nat_bf16<2>(acc, O, 1024, row0, colt, wc, fq, w0 + ob * 1024);
        else if (ob < 4) store_nat_bf16<1>(acc, O, 1024, row0, colt, wc, fq, a0 + (ob - 2) * 1024);
        else store_nat_bf16<0>(acc, GG, 1024, row0, colt, wc, fq, nullptr);
    }
};

struct EpiBranch {
    static constexpr bool PERM = true, AFTER_DRAIN = false;
    float* P; bf16_t* MERGED; const bf16_t* GATES;
    __device__ __forceinline__ void operator()(const f32x4 (&acc)[2][2][4][2], const Unit& u, int wr, int wc, int fr, int fq) const {
        const int row0 = u.pm * BM + wr * 64 + fr, col0 = u.pn * BM + wc * 32 + 8 * fq;
#pragma unroll
        for (int ai = 0; ai < 2; ++ai)
#pragma unroll
            for (int m = 0; m < 4; ++m) { const size_t row = (size_t)(row0 + ai * HALF + m * 16);
#pragma unroll
                for (int bj = 0; bj < 2; ++bj) { const int col = col0 + bj * HALF;
                    const u32x4 gw = *(const u32x4*)(GATES + row * 4096 + u.sel * 2048 + col);
                    const f32x4 v0 = acc[ai][bj][m][0] * unpk_lo(gw), v1 = acc[ai][bj][m][1] * unpk_hi(gw);
                    float* pp = P + row * 2048 + col;
                    if (u.sel == 0) { *(f32x4*)pp = v0; *(f32x4*)(pp + 4) = v1; }
                    else { const f32x4 p0 = *(const f32x4*)pp, p1 = *(const f32x4*)(pp + 4); *(u32x4*)(MERGED + row * 2048 + col) = pack8(p0 + v0, p1 + v1); } } }
    }
};
struct LoraOrder {
    StaticOrder so;
    __host__ __device__ bool next(int i, Unit& u) const { if (!so.next(i, u)) return false; const int ob = u.pn >> 2; u.kbeg = ob < 2 ? 0 : (ob < 4 ? 128 : 256); u.nt = ob < 4 ? 2 : 4; return true; }
    __device__ __forceinline__ void a_ready(const Unit&) const {}
    __device__ __forceinline__ void done(const Unit&) const {}
};
struct BranchOrder {
    StaticOrder so;
    __host__ __device__ bool next(int i, Unit& u) const { if (!so.next(i >> 1, u)) return false; u.sel = i & 1; return true; }
    __device__ __forceinline__ void a_ready(const Unit&) const {}
    __device__ __forceinline__ void done(const Unit&) const {}
};
template <class Epi, class Sched, bool ALIGN_EPI = false, bool SP2 = false>
__device__ __forceinline__ void gemm_phase(PG8_LAS unsigned char* lds, const Gemm g, const Sched& S, const Epi& E) {
    int tid = threadIdx.x; asm volatile("" : "+v"(tid));
    const int wid = __builtin_amdgcn_readfirstlane(tid >> 6), lane = tid & 63, wr = wid >> 2, wc = wid & 3, fr = lane & 15, fq = lane >> 4;
    const int K = g.K, nt = K / BK;
    unsigned voffA[2], voffB[2];
#pragma unroll
    for (int i = 0; i < 2; ++i) { int R, C; stage_rc(tid * 16 + i * 8192, R, C); const int Rb = Epi::PERM ? ((R & ~31) + perm32(R & 31)) : R;
        voffA[i] = (unsigned)(R * K + C) * 2u; voffB[i] = (unsigned)(Rb * K + C) * 2u; }
    const size_t kstep = (size_t)(BK * 2);
    const size_t hstep = (size_t)HALF * K * 2;
    const size_t tstep = 2 * hstep;
    const unsigned ldsw = (unsigned)wid * 1024u;
    const int aoff = lds_byte(wr * 64 + fr, fq * 8), boff = lds_byte(wc * 32 + fr, fq * 8);
#define PG8_SA(b, h) (((b) * 2 + (h)) * HTB)
#define PG8_SB(b, h) ((4 + (b) * 2 + (h)) * HTB)
#define PG8_STAGE(bufoff, gbase, voff) do { _Pragma("unroll") for (int _i = 0; _i < 2; ++_i) \
        __builtin_amdgcn_global_load_lds((const unsigned*)((const char*)(gbase) + (voff)[_i]), (PG8_LAS unsigned*)(lds + (bufoff) + ldsw + _i * 8192), 16, 0, 0); } while (0)
#define PG8_LDA(dst, b, h) do { _Pragma("unroll") for (int m = 0; m < 4; ++m) _Pragma("unroll") for (int k = 0; k < 2; ++k) dst[m][k] = *(const PG8_LAS bf16x8*)(lds + PG8_SA(b, h) + aoff + m * 2048 + k * 1024); } while (0)
#define PG8_LDB(dst, b, h) do { _Pragma("unroll") for (int n = 0; n < 2; ++n) _Pragma("unroll") for (int k = 0; k < 2; ++k) dst[n][k] = *(const PG8_LAS bf16x8*)(lds + PG8_SB(b, h) + boff + n * 2048 + k * 1024); } while (0)
#define PG8_MMA(ai, bj, At, Bt) do { __builtin_amdgcn_s_setprio(1); _Pragma("unroll") for (int m = 0; m < 4; ++m) _Pragma("unroll") for (int n = 0; n < 2; ++n) _Pragma("unroll") for (int k = 0; k < 2; ++k) \
        acc[ai][bj][m][n] = __builtin_amdgcn_mfma_f32_16x16x32_bf16(Bt[n][k], At[m][k], acc[ai][bj][m][n], 0, 0, 0); __builtin_amdgcn_s_setprio(0); } while (0)
#define PG8_WAIT_V(n) asm volatile("s_waitcnt vmcnt(" #n ")" ::: "memory")
#define PG8_WAIT_L(n) asm volatile("s_waitcnt lgkmcnt(" #n ")" ::: "memory")
#define PG8_BAR __builtin_amdgcn_s_barrier()
#define PG8_SCHED __builtin_amdgcn_sched_barrier(0)
    Unit cur, nxt; int ui = 0;
    if (!S.next(0, cur)) return;
    f32x4 acc[2][2][4][2];
#pragma unroll
    for (int a = 0; a < 2; ++a)
#pragma unroll
        for (int b = 0; b < 2; ++b)
#pragma unroll
            for (int m = 0; m < 4; ++m)
#pragma unroll
                for (int n = 0; n < 2; ++n) acc[a][b][m][n] = (f32x4){0.f, 0.f, 0.f, 0.f};
    bf16x8 At[4][2], B0[2][2], B1[2][2];
    const char* cA = (const char*)(cur.sel ? g.A2 : g.A) + (size_t)cur.pm * tstep + (size_t)cur.kbeg * 2; const char* cB = (const char*)(cur.sel ? g.Bt2 : g.Bt) + (size_t)cur.pn * tstep + (size_t)cur.kbeg * 2;
    int nt_cur = cur.nt ? cur.nt : nt;
    S.a_ready(cur);
    if constexpr (SP2) {
        PG8_STAGE(PG8_SB(0, 0), cB, voffB); PG8_STAGE(PG8_SB(0, 1), cB + hstep, voffB); PG8_STAGE(PG8_SA(0, 0), cA, voffA); PG8_STAGE(PG8_SA(0, 1), cA + hstep, voffA);
        if (wr == 1) PG8_BAR;
        PG8_WAIT_V(2); PG8_BAR;
        PG8_STAGE(PG8_SB(1, 0), cB + kstep, voffB); PG8_STAGE(PG8_SA(1, 0), cA + kstep, voffA); PG8_STAGE(PG8_SB(1, 1), cB + hstep + kstep, voffB);
        PG8_WAIT_V(6); PG8_BAR;
    } else {
        PG8_STAGE(PG8_SB(0, 0), cB, voffB); PG8_STAGE(PG8_SA(0, 0), cA, voffA); PG8_STAGE(PG8_SB(0, 1), cB + hstep, voffB); PG8_STAGE(PG8_SA(0, 1), cA + hstep, voffA);
        if (wr == 1) PG8_BAR;
        PG8_WAIT_V(4); PG8_BAR;
        PG8_STAGE(PG8_SB(1, 0), cB + kstep, voffB); PG8_STAGE(PG8_SA(1, 0), cA + kstep, voffA); PG8_STAGE(PG8_SB(1, 1), cB + hstep + kstep, voffB);
        PG8_WAIT_V(6); PG8_BAR;
    }
    for (;;) {
        const bool has_next = S.next(ui + 1, nxt);
        const char* nA = has_next ? (const char*)(nxt.sel ? g.A2 : g.A) + (size_t)nxt.pm * tstep + (size_t)nxt.kbeg * 2 : cA; const char* nB = has_next ? (const char*)(nxt.sel ? g.Bt2 : g.Bt) + (size_t)nxt.pn * tstep + (size_t)nxt.kbeg * 2 : cB;
        for (int t = 0; t < nt_cur; t += 2) {
            const bool last = (t == nt_cur - 2);
            const char* a1 = cA + (size_t)(t + 1) * kstep;
            const char* a2 = last ? nA : cA + (size_t)(t + 2) * kstep; const char* b2 = last ? nB : cB + (size_t)(t + 2) * kstep;
            const char* a3 = a2 + kstep; const char* b3 = b2 + kstep;
            if (last && has_next) S.a_ready(nxt);
            if constexpr (SP2) {
            PG8_LDB(B0, 0, 0); PG8_LDB(B1, 0, 1); PG8_SCHED; PG8_LDA(At, 0, 0); PG8_STAGE(PG8_SA(1, 1), a1 + hstep, voffA);
            PG8_WAIT_V(8); PG8_WAIT_L(0); PG8_BAR; PG8_MMA(0, 0, At, B0); PG8_MMA(0, 1, At, B1); PG8_BAR; PG8_SCHED;
            PG8_LDA(At, 0, 1); PG8_STAGE(PG8_SB(0, 0), b2, voffB); PG8_STAGE(PG8_SB(0, 1), b2 + hstep, voffB); PG8_STAGE(PG8_SA(0, 0), a2, voffA);
            PG8_WAIT_V(8); PG8_WAIT_L(0); PG8_BAR; PG8_MMA(1, 0, At, B0); PG8_MMA(1, 1, At, B1); PG8_BAR; PG8_SCHED;
            PG8_LDB(B0, 1, 0); PG8_LDB(B1, 1, 1); PG8_SCHED; PG8_LDA(At, 1, 0); PG8_STAGE(PG8_SA(0, 1), a2 + hstep, voffA);
            PG8_WAIT_V(8); PG8_WAIT_L(0); PG8_BAR; PG8_MMA(0, 0, At, B0); PG8_MMA(0, 1, At, B1); PG8_BAR; PG8_SCHED;
            PG8_LDA(At, 1, 1); PG8_STAGE(PG8_SB(1, 0), b3, voffB); PG8_STAGE(PG8_SB(1, 1), b3 + hstep, voffB); PG8_STAGE(PG8_SA(1, 0), a3, voffA);
            PG8_WAIT_V(8); PG8_WAIT_L(0); PG8_BAR; PG8_MMA(1, 0, At, B0); PG8_MMA(1, 1, At, B1); PG8_BAR; PG8_SCHED;
            } else {
            PG8_LDB(B0, 0, 0); PG8_SCHED; PG8_LDA(At, 0, 0); PG8_STAGE(PG8_SA(1, 1), a1 + hstep, voffA);
            PG8_WAIT_L(8); PG8_BAR; PG8_WAIT_L(0); PG8_MMA(0, 0, At, B0); PG8_BAR; PG8_SCHED;
            PG8_LDB(B1, 0, 1); PG8_STAGE(PG8_SB(0, 0), b2, voffB);
            PG8_BAR; PG8_WAIT_L(0); PG8_MMA(0, 1, At, B1); PG8_BAR;
            PG8_LDA(At, 0, 1); PG8_STAGE(PG8_SA(0, 0), a2, voffA);
            PG8_BAR; PG8_WAIT_L(0); PG8_MMA(1, 0, At, B0); PG8_BAR; PG8_SCHED;
            PG8_STAGE(PG8_SB(0, 1), b2 + hstep, voffB);
            PG8_WAIT_V(6); PG8_BAR; PG8_MMA(1, 1, At, B1); PG8_BAR;
            PG8_LDB(B0, 1, 0); PG8_SCHED; PG8_LDA(At, 1, 0); PG8_STAGE(PG8_SA(0, 1), a2 + hstep, voffA);
            PG8_WAIT_L(8); PG8_BAR; PG8_WAIT_L(0); PG8_MMA(0, 0, At, B0); PG8_BAR; PG8_SCHED;
            PG8_LDB(B1, 1, 1); PG8_STAGE(PG8_SB(1, 0), b3, voffB);
            PG8_BAR; PG8_WAIT_L(0); PG8_MMA(0, 1, At, B1); PG8_BAR;
            PG8_LDA(At, 1, 1); PG8_STAGE(PG8_SA(1, 0), a3, voffA);
            PG8_BAR; PG8_WAIT_L(0); PG8_MMA(1, 0, At, B0); PG8_BAR; PG8_SCHED;
            PG8_STAGE(PG8_SB(1, 1), b3 + hstep, voffB);
            PG8_WAIT_V(6); PG8_BAR; PG8_MMA(1, 1, At, B1); PG8_BAR;
            }
        }
        if constexpr (ALIGN_EPI) { if (wr == 0) PG8_BAR; }
        if constexpr (!Epi::AFTER_DRAIN) { E(acc, cur, wr, wc, fr, fq); S.done(cur); }
        if (!has_next) break;
#pragma unroll
        for (int a = 0; a < 2; ++a)
#pragma unroll
            for (int b = 0; b < 2; ++b)
#pragma unroll
                for (int m = 0; m < 4; ++m)
#pragma unroll
                    for (int n = 0; n < 2; ++n) acc[a][b][m][n] = (f32x4){0.f, 0.f, 0.f, 0.f};
        cur = nxt; cA = nA; cB = nB; ++ui; nt_cur = cur.nt ? cur.nt : nt;
        if constexpr (ALIGN_EPI) { if (wr == 1) PG8_BAR; }
    }
    PG8_WAIT_V(0);
    if constexpr (!ALIGN_EPI) { if (wr == 0) PG8_BAR; }
    PG8_BAR;
    if constexpr (Epi::AFTER_DRAIN) { E.fused(acc, cur, wr, wc, fr, fq, lds, wid, lane); S.done(cur); }
#undef PG8_SA
#undef PG8_SB
#undef PG8_STAGE
#undef PG8_LDA
#undef PG8_LDB
#undef PG8_MMA
#undef PG8_WAIT_V
#undef PG8_WAIT_L
#undef PG8_BAR
#undef PG8_SCHED
}
}

#include <hip/hip_bf16.h>
#include <cmath>
namespace attn_body {
using bf16=__hip_bfloat16;
using bf16x8=__attribute__((ext_vector_type(8)))short;
using s16x4=__attribute__((ext_vector_type(4)))short;
using f32x16=__attribute__((ext_vector_type(16)))float;
using u32x4=__attribute__((ext_vector_type(4)))unsigned;
constexpr int BATCH=4,NHEAD=16,SEQ=2048,D=64,DM=NHEAD*D,OPITCH=2048;
constexpr int NW=8,QBLK=32,QB=QBLK*NW,KVBLK=64,NQB=SEQ/QB;
constexpr int ATTN_PITCH=DM, ATTN_UNIT_ROWS=QB;
__device__ __forceinline__ int crow(int r,int hi){return (r&3)+8*(r>>2)+4*hi;}
#define SBAR() __builtin_amdgcn_sched_barrier(0)
__device__ __forceinline__ void cmask(f32x16&p0,f32x16&p1,int jb,int qrel,int hi){
  const float NEG=-INFINITY; int kb=64*jb+4*hi;
  #pragma unroll
  for(int r=0;r<16;++r){int kv=kb+(r&3)+8*(r>>2); if(kv>qrel)p0[r]=NEG; if(kv+32>qrel)p1[r]=NEG;}
}

constexpr int NSLOT=3, SLOTB=8192;
constexpr int LDS_K=0, LDS_V=NSLOT*SLOTB, LDS_WS=2*NSLOT*SLOTB, LDS_OST=LDS_WS+NW*64*4, LDS_BYTES=LDS_OST+NW*4096;
constexpr float C2=0.125f*1.4426950408889634f;
__device__ __forceinline__ void glds16(const void*gsrc,unsigned lds_dst){unsigned keep;
  asm volatile("s_mov_b32 %0, m0\n\ts_mov_b32 m0, %2\n\ts_nop 0\n\tglobal_load_lds_dwordx4 %1, off\n\ts_mov_b32 m0, %0":"=&s"(keep):"v"(gsrc),"s"(lds_dst):"memory");}
__device__ __forceinline__ float max3f(float a,float b,float c){float r;asm("v_max3_f32 %0, %1, %2, %3":"=v"(r):"v"(a),"v"(b),"v"(c));return r;}
__device__ __forceinline__ float max2f(float a,float b){float r;asm("v_max_f32_e32 %0, %1, %2":"=v"(r):"v"(a),"v"(b));return r;}
__device__ __forceinline__ float fadd_s(float a,float b){float r;asm("v_add_f32_e32 %0, %1, %2":"=v"(r):"v"(a),"v"(b));return r;}
__device__ __forceinline__ float fsub_s(float a,float b){float r;asm("v_sub_f32_e32 %0, %1, %2":"=v"(r):"v"(a),"v"(b));return r;}
typedef float f32x2_t __attribute__((ext_vector_type(2))); typedef __bf16 bf16x2_t __attribute__((ext_vector_type(2)));
__device__ __forceinline__ unsigned cvtpk_s(float lo,float hi){f32x2_t v={lo,hi};bf16x2_t b=__builtin_convertvector(v,bf16x2_t);return __builtin_bit_cast(unsigned,b);}
#define WAIT_BAR(N) asm volatile("s_waitcnt vmcnt(" #N ") lgkmcnt(0)\n\ts_barrier":::"memory")

__device__ __forceinline__ void qkt(f32x16&p0,f32x16&p1,const char*Kslot,const bf16x8*qr,const f32x16&negm,int r32,int hi){
  const char*kb=Kslot+hi*1024+r32*16;
  #pragma unroll
  for(int d0=0;d0<4;++d0){
    const bf16x8 b0=*reinterpret_cast<const bf16x8*>(kb+d0*2048);
    const bf16x8 b1=*reinterpret_cast<const bf16x8*>(kb+d0*2048+512);
    if(d0==0){p0=__builtin_amdgcn_mfma_f32_32x32x16_bf16(b0,qr[0],negm,0,0,0);p1=__builtin_amdgcn_mfma_f32_32x32x16_bf16(b1,qr[0],negm,0,0,0);}
    else{p0=__builtin_amdgcn_mfma_f32_32x32x16_bf16(b0,qr[d0],p0,0,0,0);p1=__builtin_amdgcn_mfma_f32_32x32x16_bf16(b1,qr[d0],p1,0,0,0);}}
}
typedef __attribute__((address_space(3))) const char* lds_cptr;
typedef short v4i16_t __attribute__((ext_vector_type(4)));
__device__ __forceinline__ void kload8(bf16x8*kf,lds_cptr kp){
  kf[0]=*(const __attribute__((address_space(3))) bf16x8*)(kp);      kf[1]=*(const __attribute__((address_space(3))) bf16x8*)(kp+512);
  kf[2]=*(const __attribute__((address_space(3))) bf16x8*)(kp+2048); kf[3]=*(const __attribute__((address_space(3))) bf16x8*)(kp+2560);
  kf[4]=*(const __attribute__((address_space(3))) bf16x8*)(kp+4096); kf[5]=*(const __attribute__((address_space(3))) bf16x8*)(kp+4608);
  kf[6]=*(const __attribute__((address_space(3))) bf16x8*)(kp+6144); kf[7]=*(const __attribute__((address_space(3))) bf16x8*)(kp+6656);
}
__device__ __forceinline__ void kload2(bf16x8*kf,lds_cptr kp,int j){ kf[2*j]=*(const __attribute__((address_space(3))) bf16x8*)(kp+j*2048); kf[2*j+1]=*(const __attribute__((address_space(3))) bf16x8*)(kp+j*2048+512); }
__device__ __forceinline__ s16x4 vtr(lds_cptr p){ return __builtin_bit_cast(s16x4,__builtin_amdgcn_ds_read_tr16_b64_v4i16((__attribute__((address_space(3))) v4i16_t*)p)); }
__device__ __forceinline__ float rowmax(const f32x16&p0,const f32x16&p1){
  float a=max3f(p0[0],p0[1],p1[0]),b=max3f(p0[2],p0[3],p1[1]);a=max3f(a,p1[2],p1[3]);
  #pragma unroll
  for(int r=4;r<16;r+=4){a=max3f(a,p0[r],p0[r+1]);b=max3f(b,p0[r+2],p0[r+3]);a=max3f(a,p1[r],p1[r+1]);b=max3f(b,p1[r+2],p1[r+3]);}
  const float m=max2f(a,b);
  auto rr=__builtin_amdgcn_permlane32_swap(__float_as_uint(m),__float_as_uint(m),false,false);
  return max2f(__uint_as_float(rr[0]),__uint_as_float(rr[1]));
}
__device__ __forceinline__ void pv(f32x16*o,int vb,bf16x8 pa0,bf16x8 pa1,bf16x8 pa2,bf16x8 pa3){
  #pragma unroll
  for(int d0=0;d0<2;++d0){s16x4 lo[4],hi[4];
    #pragma unroll
    for(int ks=0;ks<4;++ks){
      asm volatile("ds_read_b64_tr_b16 %0,%1 offset:%c2":"=&v"(lo[ks]):"v"(vb),"i"(d0*4096+ks*1024):"memory");
      asm volatile("ds_read_b64_tr_b16 %0,%1 offset:%c2":"=&v"(hi[ks]):"v"(vb),"i"(d0*4096+ks*1024+512):"memory");}
    asm volatile("s_waitcnt lgkmcnt(0)":::"memory");SBAR();
    #define PK(k) (bf16x8){lo[k][0],lo[k][1],lo[k][2],lo[k][3],hi[k][0],hi[k][1],hi[k][2],hi[k][3]}
    o[d0]=__builtin_amdgcn_mfma_f32_32x32x16_bf16(pa0,PK(0),o[d0],0,0,0);
    o[d0]=__builtin_amdgcn_mfma_f32_32x32x16_bf16(pa1,PK(1),o[d0],0,0,0);
    o[d0]=__builtin_amdgcn_mfma_f32_32x32x16_bf16(pa2,PK(2),o[d0],0,0,0);
    o[d0]=__builtin_amdgcn_mfma_f32_32x32x16_bf16(pa3,PK(3),o[d0],0,0,0);
    #undef PK
  }
}

#ifndef ATTN_STORE16
#define ATTN_STORE16(p,v) (*(u32x4*)(p)=(v))
#endif
template<int THRL> __device__ __forceinline__ void attn_unit(int b,int h,int vcol,int ocol,int qb,const bf16*Q,const bf16*__restrict__ K,const bf16*__restrict__ V,bf16*O,char*shm){
  int tid=threadIdx.x; asm volatile("":"+v"(tid)); const int lane=tid&63,r32=lane&31,hi=lane>>5; const int wid=__builtin_amdgcn_readfirstlane(tid>>6);
  const long rowbase=(long)b*SEQ; const int q0=qb*QB;
  const bf16*Qw=Q+(rowbase+q0+wid*QBLK)*DM+h*D;
  const bf16*Kh=K+rowbase*DM+h*D,*Vh=V+rowbase*DM+vcol;
  const unsigned lds0=(unsigned)(uintptr_t)shm;
  float*wsf=(float*)(shm+LDS_WS)+wid*64;
  const bf16*ksrc=Kh+(long)lane*DM+wid*8;
  const bf16*vsrc=Vh+(long)(16*(wid&3)+(lane>>2))*DM+(wid>>2)*32+(lane&3)*8;
  const unsigned kdst=lds0+LDS_K+wid*1024, vdst=lds0+LDS_V+wid*1024;
  #define DMA_K(t,slot) glds16(ksrc+(long)(t)*KVBLK*DM,(unsigned)__builtin_amdgcn_readfirstlane(kdst+(slot)))
  #define DMA_V(t,slot) glds16(vsrc+(long)(t)*KVBLK*DM,(unsigned)__builtin_amdgcn_readfirstlane(vdst+(slot)))
  const int vb0=(int)(lds0+LDS_V)+((lane>>4)&1)*32+(lane&3)*8+(4*hi+((lane&15)>>2))*64;
  const char*Kbase=shm+LDS_K; bf16x8 kf[8];
  const lds_cptr shm3=(lds_cptr)shm; const lds_cptr kp0=shm3+LDS_K+hi*1024+r32*16; const lds_cptr vp0=shm3+LDS_V+((lane>>4)&1)*32+(lane&3)*8+(4*hi+((lane&15)>>2))*64;
  const int NT=SEQ/KVBLK;
  DMA_K(0,0);DMA_V(0,0);DMA_K(1,SLOTB);
  bf16x8 qr[4];
  #pragma unroll
  for(int d0=0;d0<4;++d0)qr[d0]=*reinterpret_cast<const bf16x8*>(&Qw[(long)r32*DM+d0*16+hi*8]);
  float mhat=0.f,l_reg=0.f;f32x16 o[2];o[0]=f32x16{};o[1]=f32x16{};f32x16 negm=f32x16{};asm volatile("":"+v"(negm));
  const int qrel=wid*QBLK+r32;
  #define CMASK(P0,P1,t) do{}while(0)
  bool resc=false;
  #define START(P0,P1) do{ const float rm=rowmax(P0,P1); resc=false; \
    { const float dl=rm; mhat=fadd_s(mhat,dl); \
      _Pragma("unroll") for(int r=0;r<16;++r){P0[r]=fsub_s(P0[r],dl);P1[r]=fsub_s(P1[r],dl);} \
      _Pragma("unroll") for(int r=0;r<16;++r)negm[r]=-mhat; asm volatile("":"+v"(negm)); } \
    _Pragma("unroll") for(int r=0;r<16;++r)P0[r]=__builtin_amdgcn_exp2f(P0[r]); }while(0)
  #define RESC() do{ if(resc){ asm volatile("s_waitcnt lgkmcnt(0)":::"memory"); \
      _Pragma("unroll") for(int d_=0;d_<2;++d_) _Pragma("unroll") for(int r=0;r<16;++r)o[d_][r]*=wsf[crow(r,hi)]; } }while(0)
  f32x16 pA0,pA1,pB0,pB1;
  int sl_prev=0,sl_cur=0,sl_next=SLOTB;
  #define ROT() do{sl_prev=sl_cur;sl_cur=sl_next;sl_next=(sl_next==(NSLOT-1)*SLOTB)?0:sl_next+SLOTB;}while(0)
  DMA_K(2,2*SLOTB);
  WAIT_BAR(3);
  qkt(pA0,pA1,Kbase,qr,negm,r32,hi);asm volatile("s_nop 15\n\ts_nop 7":"+v"(pA0),"+v"(pA1));CMASK(pA0,pA1,0);
  START(pA0,pA1);
  _Pragma("unroll") for(int r=0;r<16;++r)pA1[r]=__builtin_amdgcn_exp2f(pA1[r]);
  WAIT_BAR(0);
  DMA_K(3,0);DMA_V(1,SLOTB);
  ROT();
  kload8(kf,kp0+sl_cur);
  WAIT_BAR(2);
  s16x4 vlo[8],vhi[8]; u32x4 pw0,pw1,pw2,pw3;
  #define PKW(P,B) cvtpk_s(P[B],P[B+1])
  #define PAF(k) __builtin_bit_cast(bf16x8,pw##k)
  #define VFR(i) (bf16x8){vlo[i][0],vlo[i][1],vlo[i][2],vlo[i][3],vhi[i][0],vhi[i][1],vhi[i][2],vhi[i][3]}
  #define PIN(x) asm volatile("":"+v"(x))
  #define MX3(a,b,c) __builtin_fmaxf(__builtin_fmaxf((a),(b)),(c))
  #define GAPA(MF,A0,A1,A2,A3,W0,W1,PW) do{ MF; sacc+=A0; sacc+=A1; sacc+=A2; sacc+=A3; PIN(sacc); W0; W1; PIN(PW); SBAR(); }while(0)
  #define EX(v) __builtin_amdgcn_exp2f(v)
  #define GAPB(MF,X,B) do{ MF; X[B]=EX(X[B]); X[B+1]=EX(X[B+1]); X[B+2]=EX(X[B+2]); X[B+3]=EX(X[B+3]); PIN(X); SBAR(); }while(0)
  #define VRD(i) do{ vlo[i]=vtr(vp_+(((i)>>2)*4096+((i)&3)*1024)); vhi[i]=vtr(vp_+(((i)>>2)*4096+((i)&3)*1024+512)); }while(0)
  #define KRD(G,j) do{ if(G){ kload2(kf,kp0+sl_next,j); SBAR(); } }while(0)
  #define STEP(C0,C1,P0,P1,t,GK,GV,GL) do{ SBAR(); \
    const lds_cptr vp_=vp0+sl_prev; \
    VRD(0); SBAR(); float sacc=(P0[0]+P0[1]); \
    GAPA(C0=__builtin_amdgcn_mfma_f32_32x32x16_bf16(kf[0],qr[0],negm,0,0,0), P0[2],P0[3],P0[4],P0[5],     pw0[0]=PKW(P0,0), pw0[1]=PKW(P0,2), pw0); \
    VRD(4); SBAR(); GAPA(C1=__builtin_amdgcn_mfma_f32_32x32x16_bf16(kf[1],qr[0],negm,0,0,0), P0[6],P0[7],P0[8],P0[9],     pw0[2]=PKW(P0,4), pw0[3]=PKW(P0,6), pw0); \
    VRD(1); SBAR(); GAPA(C0=__builtin_amdgcn_mfma_f32_32x32x16_bf16(kf[2],qr[1],C0,0,0,0),   P0[10],P0[11],P0[12],P0[13], pw1[0]=PKW(P0,8), pw1[1]=PKW(P0,10), pw1); \
    VRD(5); SBAR(); GAPA(C1=__builtin_amdgcn_mfma_f32_32x32x16_bf16(kf[3],qr[1],C1,0,0,0),   P0[14],P0[15],P1[0],P1[1],   pw1[2]=PKW(P0,12),pw1[3]=PKW(P0,14), pw1); \
    VRD(2); SBAR(); GAPA(C0=__builtin_amdgcn_mfma_f32_32x32x16_bf16(kf[4],qr[2],C0,0,0,0),   P1[2],P1[3],P1[4],P1[5],     pw2[0]=PKW(P1,0), pw2[1]=PKW(P1,2), pw2); \
    VRD(6); SBAR(); GAPA(C1=__builtin_amdgcn_mfma_f32_32x32x16_bf16(kf[5],qr[2],C1,0,0,0),   P1[6],P1[7],P1[8],P1[9],     pw2[2]=PKW(P1,4), pw2[3]=PKW(P1,6), pw2); \
    VRD(3); SBAR(); GAPA(C0=__builtin_amdgcn_mfma_f32_32x32x16_bf16(kf[6],qr[3],C0,0,0,0),   P1[10],P1[11],P1[12],P1[13], pw3[0]=PKW(P1,8), pw3[1]=PKW(P1,10), pw3); \
    VRD(7); SBAR(); GAPA(C1=__builtin_amdgcn_mfma_f32_32x32x16_bf16(kf[7],qr[3],C1,0,0,0),   P1[14],P1[15],0.f,0.f,       pw3[2]=PKW(P1,12),pw3[3]=PKW(P1,14), pw3); \
    l_reg+=sacc; \
    if(GK){DMA_K((t)+3,sl_cur);} if(GV){DMA_V((t)+1,sl_next);} \
    CMASK(C0,C1,t); \
    { float a=MX3(C0[0],C0[1],C1[0]),b=MX3(C0[2],C0[3],C1[1]); a=MX3(a,C1[2],C1[3]); \
      _Pragma("unroll") for(int r=4;r<16;r+=4){a=MX3(a,C0[r],C0[r+1]);b=MX3(b,C0[r+2],C0[r+3]);a=MX3(a,C1[r],C1[r+1]);b=MX3(b,C1[r+2],C1[r+3]);} \
      float rm=__builtin_fmaxf(a,b); { auto rr=__builtin_amdgcn_permlane32_swap(__float_as_uint(rm),__float_as_uint(rm),false,false); rm=__builtin_fmaxf(__uint_as_float(rr[0]),__uint_as_float(rr[1])); } \
      resc=false; \
      if(__builtin_expect(__any(rm>(float)THRL),0)){ const float dl=__builtin_fmaxf(rm,0.f); mhat+=dl; \
        _Pragma("unroll") for(int r=0;r<16;++r){C0[r]-=dl;C1[r]-=dl;} \
        _Pragma("unroll") for(int r=0;r<16;++r)negm[r]=-mhat; asm volatile("":"+v"(negm)); \
        const float f=__builtin_amdgcn_exp2f(-dl); l_reg*=f; if(hi==0)wsf[r32]=f; resc=true; } } \
    SBAR(); \
    GAPB(o[0]=__builtin_amdgcn_mfma_f32_32x32x16_bf16(PAF(0),VFR(0),o[0],0,0,0), C0,0); \
    GAPB(o[1]=__builtin_amdgcn_mfma_f32_32x32x16_bf16(PAF(0),VFR(4),o[1],0,0,0), C0,4); \
    KRD(GL,0); GAPB(o[0]=__builtin_amdgcn_mfma_f32_32x32x16_bf16(PAF(1),VFR(1),o[0],0,0,0), C0,8); \
    KRD(GL,1); GAPB(o[1]=__builtin_amdgcn_mfma_f32_32x32x16_bf16(PAF(1),VFR(5),o[1],0,0,0), C0,12); \
    KRD(GL,2); GAPB(o[0]=__builtin_amdgcn_mfma_f32_32x32x16_bf16(PAF(2),VFR(2),o[0],0,0,0), C1,0); \
    KRD(GL,3); GAPB(o[1]=__builtin_amdgcn_mfma_f32_32x32x16_bf16(PAF(2),VFR(6),o[1],0,0,0), C1,4); \
    GAPB(o[0]=__builtin_amdgcn_mfma_f32_32x32x16_bf16(PAF(3),VFR(3),o[0],0,0,0), C1,8); \
    GAPB(o[1]=__builtin_amdgcn_mfma_f32_32x32x16_bf16(PAF(3),VFR(7),o[1],0,0,0), C1,12); \
    }while(0)
  int t=1;
  #undef CMASK
  #define CMASK(P0,P1,t) do{}while(0)
  for(;t+5<NT;t+=2){
    STEP(pB0,pB1,pA0,pA1,t,true,true,true);     WAIT_BAR(2); RESC(); ROT();
    STEP(pA0,pA1,pB0,pB1,t+1,true,true,true);   WAIT_BAR(2); RESC(); ROT();
  }
  #undef CMASK
  #define CMASK(P0,P1,t) do{}while(0)
  #define ENDW(tt) do{ if((tt)+3<NT){WAIT_BAR(2);} else if((tt)+2<NT){WAIT_BAR(1);} else {WAIT_BAR(0);} }while(0)
  for(;t+1<NT;t+=2){
    STEP(pB0,pB1,pA0,pA1,t,(t+3<NT),(t+1<NT),(t+1<NT));       ENDW(t);   RESC(); ROT();
    STEP(pA0,pA1,pB0,pB1,t+1,(t+4<NT),(t+2<NT),(t+2<NT));     ENDW(t+1); RESC(); ROT();
  }
  STEP(pB0,pB1,pA0,pA1,NT-1,false,false,false); RESC();
  { float sacc=pB0[0]+pB0[1]; _Pragma("unroll") for(int r=2;r<16;++r)sacc+=pB0[r]; _Pragma("unroll") for(int r=0;r<16;++r)sacc+=pB1[r]; l_reg+=sacc;
    pw0=(u32x4){PKW(pB0,0),PKW(pB0,2),PKW(pB0,4),PKW(pB0,6)};pw1=(u32x4){PKW(pB0,8),PKW(pB0,10),PKW(pB0,12),PKW(pB0,14)};pw2=(u32x4){PKW(pB1,0),PKW(pB1,2),PKW(pB1,4),PKW(pB1,6)};pw3=(u32x4){PKW(pB1,8),PKW(pB1,10),PKW(pB1,12),PKW(pB1,14)};
    SBAR(); pv(o,vb0+sl_cur,PAF(0),PAF(1),PAF(2),PAF(3)); }
  #undef PKW
  #undef PAF
  #undef VFR
  #undef PIN
  #undef MX3
  #undef GAPA
  #undef GAPB
  #undef EX
  #undef VRD
  #undef KRD
  #undef STEP
  #undef ENDW
  {auto rr=__builtin_amdgcn_permlane32_swap(__float_as_uint(l_reg),__float_as_uint(l_reg),false,false);l_reg=__uint_as_float(rr[0])+__uint_as_float(rr[1]);}
  if(hi==0)wsf[32+r32]=l_reg;asm volatile("s_waitcnt lgkmcnt(0)":::"memory");
  float rli[16];
  #pragma unroll
  for(int r=0;r<16;++r)rli[r]=__builtin_amdgcn_rcpf(wsf[32+crow(r,hi)]);
  bf16*Ow=O+(rowbase+q0+wid*QBLK)*OPITCH+ocol;
  { bf16*stg=(bf16*)(shm+LDS_OST)+wid*2048;
    #pragma unroll
    for(int r=0;r<16;++r){const int orow=crow(r,hi);
      #pragma unroll
      for(int d0=0;d0<2;++d0)stg[orow*64+d0*32+r32]=__float2bfloat16(o[d0][r]*rli[r]);}
    asm volatile("s_waitcnt lgkmcnt(0)":::"memory");
    #pragma unroll
    for(int i=0;i<4;++i){const int row=i*8+(lane>>3),ch=lane&7; const u32x4 v=*(const u32x4*)(stg+row*64+ch*8); ATTN_STORE16(Ow+(long)row*OPITCH+ch*8,v);} }
  asm volatile("s_waitcnt lgkmcnt(0)\n\ts_barrier":::"memory");
  #undef DMA_K
  #undef DMA_V
  #undef CMASK
  #undef START
  #undef RESC
  #undef ROT
}
constexpr int ATTN_LDS_BYTES=LDS_BYTES;
#undef SBAR
#undef WAIT_BAR
}

#define GAS __attribute__((address_space(1)))
#define LAS __attribute__((address_space(3)))
typedef unsigned short bf16;
typedef unsigned v4u __attribute__((ext_vector_type(4)));
typedef float f32x4 __attribute__((ext_vector_type(4)));
typedef short bf16x8 __attribute__((ext_vector_type(8)));
typedef GAS unsigned gu32;
typedef GAS unsigned long long gu64;
#define RLX_AGENT __ATOMIC_RELAXED, __HIP_MEMORY_SCOPE_AGENT
#define LDS_WAIT() asm volatile("s_waitcnt lgkmcnt(0)" ::: "memory")
#define VM_WAIT() asm volatile("s_waitcnt vmcnt(0)" ::: "memory")
__device__ __forceinline__ unsigned long long rt() { return __builtin_amdgcn_s_memrealtime(); }
__device__ __forceinline__ unsigned f2bf(float f) { unsigned u = __builtin_bit_cast(unsigned, f); return (u + 0x7fffu + ((u >> 16) & 1u)) >> 16; }
__device__ __forceinline__ unsigned pk2(float lo, float hi) { return f2bf(lo) | (f2bf(hi) << 16); }

#define XB_TMO      128
#define XB_XCNT(j)  (256  + 64 * (j))
#define XB_XSUB(j)  (1280 + 64 * (j))
#define XB_XGEN(j)  (2304 + 64 * (j))
#define XB_TOP      3328
#define XB_TOPGEN   3392
#define XCD_BAR_WORDS 3456
#define XB_SPIN_CAP (1u << 18)

__device__ __forceinline__ unsigned xb_ld(unsigned* p)              { return __hip_atomic_load(p, __ATOMIC_RELAXED, __HIP_MEMORY_SCOPE_AGENT); }
__device__ __forceinline__ unsigned xb_add(unsigned* p, unsigned v) { return __hip_atomic_fetch_add(p, v, __ATOMIC_RELAXED, __HIP_MEMORY_SCOPE_AGENT); }
__device__ __forceinline__ unsigned xb_xcc_id() { return (unsigned)__builtin_amdgcn_s_getreg((3 << 11) | 20) & 0xFu; }
#define XB_SPIN(cond, bar) do { unsigned _sp = 0; while (cond) { __builtin_amdgcn_s_sleep(1); \
    if ((++_sp & 255u) == 0u) { if (xb_ld(&(bar)[XB_TMO])) break; if (_sp > XB_SPIN_CAP) { atomicAdd(&(bar)[XB_TMO], 1u); break; } } } } while (0)

struct XcdBarrier {
    unsigned* bar; unsigned x;
    volatile LAS unsigned* st;
};

__device__ __forceinline__ XcdBarrier xcd_barrier_post(unsigned* bar, volatile LAS unsigned* st) {
    XcdBarrier b; b.bar = bar; b.x = xb_xcc_id(); b.st = st;
    if (threadIdx.x == 0) (void)xb_add(&bar[XB_XCNT(b.x)], 1u);
    return b;
}
__device__ __forceinline__ void xcd_barrier_complete(unsigned* bar, unsigned x, unsigned& nloc, unsigned& nx) {
    const unsigned G = gridDim.x * gridDim.y * gridDim.z;
    unsigned sum, cnt, mine, sp = 0u;
    for (;;) {
        sum = 0u; cnt = 0u; mine = 0u;
#pragma unroll
        for (unsigned j = 0; j < 16; ++j) { const unsigned c = xb_ld(&bar[XB_XCNT(j)]); sum += c; cnt += (c > 0u) ? 1u : 0u; mine = (j == x) ? c : mine; }
        if (sum == G) break;
        __builtin_amdgcn_s_sleep(1);
        if ((++sp & 255u) == 0u) { if (xb_ld(&bar[XB_TMO])) break; if (sp > XB_SPIN_CAP) { atomicAdd(&bar[XB_TMO], 1u); break; } }
    }
    nloc = mine > 0u ? mine : 1u; nx = cnt > 0u ? cnt : 1u;
}

__device__ __forceinline__ void xcd_barrier(const XcdBarrier& b) {
    asm volatile("s_waitcnt vmcnt(0)" ::: "memory");
    __syncthreads();
    if (threadIdx.x == 0) {
        unsigned* bar = b.bar;
        __builtin_amdgcn_s_waitcnt(0);
        unsigned nloc = b.st[0], nx = b.st[1];
        if (nloc == 0u) { xcd_barrier_complete(bar, b.x, nloc, nx); b.st[0] = nloc; b.st[1] = nx; }
        const unsigned old = xb_add(&bar[XB_XSUB(b.x)], 1u);
        const unsigned gen = old / nloc;
        if (old + 1u == (gen + 1u) * nloc) {
            __builtin_amdgcn_fence(__ATOMIC_RELEASE, "agent");
            asm volatile("s_waitcnt vmcnt(0)" ::: "memory");
            const unsigned og = xb_add(&bar[XB_TOP], 1u);
            const unsigned tg = og / nx;
            if (og + 1u == (tg + 1u) * nx) xb_add(&bar[XB_TOPGEN], 1u);
            else XB_SPIN(xb_ld(&bar[XB_TOPGEN]) == tg, bar);
            __builtin_amdgcn_fence(__ATOMIC_ACQUIRE, "agent");
            xb_add(&bar[XB_XGEN(b.x)], 1u);
            asm volatile("s_waitcnt vmcnt(0)" ::: "memory");
        } else {
            XB_SPIN(xb_ld(&bar[XB_XGEN(b.x)]) == gen, bar);
            __builtin_amdgcn_fence(__ATOMIC_ACQUIRE, "agent");
            asm volatile("s_waitcnt vmcnt(0)" ::: "memory");
        }
    }
    __syncthreads();
}


#ifndef NO_HIDE_CONV
#define HIDE_CONV 1
#endif
constexpr int NWAVES = 8;
constexpr int BATCH = 4, T = 2048, D = 2048, M = BATCH * T, FF = 5632, NGU = 2 * FF;
constexpr int RWC = 3072, IN_COLS = 10656, IN_PAD = 10752, NLORA = 5120, KLORA = 512;
constexpr float NORM_EPS = 1e-6f, GN_EPS = 64e-5f, SUBLN_EPS = 1e-5f, LAM_INIT = 0.2f;
constexpr float QSCALE = 0.125f * 1.4426950408889634f;

constexpr size_t MiB = 1u << 20;
constexpr size_t WS_CTL = 0, CTL_ZERO_BYTES = 1 * MiB;
constexpr size_t WS_ROPE = 1 * MiB;
constexpr size_t WS_WGU = 2 * MiB;
constexpr size_t WS_WDN = 46 * MiB;
constexpr size_t WS_WIN = 68 * MiB;
constexpr size_t WS_WA = 110 * MiB, WS_WB = 114 * MiB;
constexpr size_t WS_WOUT = 118 * MiB;
constexpr size_t WS_WLORA = 126 * MiB;
constexpr size_t WS_XN = 131 * MiB;
constexpr size_t WS_F = 163 * MiB;
constexpr size_t WS_ACT = 227 * MiB;
constexpr size_t WS_RW = 227 * MiB;
constexpr size_t WS_Q = 275 * MiB, WS_K = 291 * MiB, WS_V = 307 * MiB;
constexpr size_t WS_Y = 275 * MiB;
constexpr size_t WS_GATES = 323 * MiB;
constexpr size_t WS_LR = 387 * MiB;
constexpr size_t WS_G = 387 * MiB;
constexpr size_t WS_LA = 403 * MiB;
constexpr size_t WS_OATT = 411 * MiB;
constexpr size_t WS_END = 443 * MiB;
constexpr int CW_BAR = 4096;

constexpr int RING_OFF = 0, RING_BYTES = 131072;
constexpr int LDSCTL_OFF = RING_BYTES, MISC_OFF = LDSCTL_OFF + 320;
constexpr int LDS_BYTES = 147456;

struct Args { const float* in[32]; float* out; unsigned char* ws; int ph_lo, ph_hi, li, pad; };

__device__ __forceinline__ float wave_sum(float v) {
#pragma unroll
    for (int o = 1; o < 64; o <<= 1) v += __shfl_xor(v, o);
    return v;
}
template <int CTRL> __device__ __forceinline__ float dppf(float x) { return __builtin_bit_cast(float, __builtin_amdgcn_mov_dpp(__builtin_bit_cast(int, x), CTRL, 0xf, 0xf, true)); }
__device__ __forceinline__ float red8(float x) { x += dppf<0xB1>(x); x += dppf<0x4E>(x); x += dppf<0x141>(x); return x; }
__device__ __forceinline__ float red16(float x) { x = red8(x); x += dppf<0x128>(x); return x; }
__device__ __forceinline__ float bf2f(unsigned short h) { return __uint_as_float((unsigned)h << 16); }
__device__ __forceinline__ float bfsel(unsigned w, int lane) { return __uint_as_float((lane & 1) ? (w & 0xffff0000u) : (w << 16)); }
__device__ __forceinline__ float sigm_(float x) { return __builtin_amdgcn_rcpf(1.0f + __builtin_amdgcn_exp2f(-1.4426950408889634f * x)); }
typedef unsigned u32x2 __attribute__((ext_vector_type(2)));
__device__ __forceinline__ f32x4 unpk4(const u32x2 w) { return (f32x4){__uint_as_float(w.x << 16), __uint_as_float(w.x & 0xffff0000u), __uint_as_float(w.y << 16), __uint_as_float(w.y & 0xffff0000u)}; }

__device__ __forceinline__ void transpose_item(const float* W, int K, int N, bf16* WT, int k0, int n0, int drow0, LAS float* scr, int lane) {
#pragma unroll 8
    for (int i = 0; i < 32; ++i) { const int kk = 2 * i + (lane >> 5); scr[kk * 33 + (lane & 31)] = __builtin_nontemporal_load(&W[(size_t)(k0 + kk) * N + n0 + (lane & 31)]); }
    LDS_WAIT(); asm volatile("" ::: "memory");
    const int c = lane & 7;
#pragma unroll
    for (int j = 0; j < 4; ++j) { const int n = (lane >> 3) + 8 * j; const LAS float* s = scr + (8 * c) * 33 + n;
        v4u o; o.x = pk2(s[0 * 33], s[1 * 33]); o.y = pk2(s[2 * 33], s[3 * 33]); o.z = pk2(s[4 * 33], s[5 * 33]); o.w = pk2(s[6 * 33], s[7 * 33]);
        *(GAS v4u*)(WT + (size_t)(drow0 + n) * K + k0 + 8 * c) = o; }
    LDS_WAIT(); asm volatile("" ::: "memory");
}
__device__ __forceinline__ int map_gu(int n0) { const int which = n0 / FF, cc = n0 % FF; return 256 * (cc / 128) + 128 * which + (cc % 128); }
__device__ __forceinline__ int map_in(int n0) {
    if (n0 < 3488) return n0;
    if (n0 < 5536) { const int seg = n0 - 3488, l = seg & 255, hd = l >> 6, half = (l >> 5) & 1; return 3584 + (seg & ~255) + 128 * half + 32 * hd; }
    if (n0 < 6560) return 5632 + (n0 - 5536);
    return 6656 + (n0 - 6560);
}
__device__ __forceinline__ void conv_ffn_weights(const float* wgu, const float* wdn, unsigned char* ws, LAS float* scr, int gw, int NGW, int lane, int which = 3) {
    constexpr int I_GU = (D / 64) * (NGU / 32), I_DN = (FF / 64) * (D / 32);
    for (int it = ((which & 1) ? 0 : I_GU) + gw; it < ((which & 2) ? I_GU + I_DN : I_GU); it += NGW) {
        if (it < I_GU) { const int nb = it % (NGU / 32), kb = it / (NGU / 32); transpose_item(wgu, D, NGU, (bf16*)(ws + WS_WGU), kb * 64, nb * 32, map_gu(nb * 32), scr, lane); }
        else { const int r = it - I_GU, nb = r % (D / 32), kb = r / (D / 32); transpose_item(wdn, FF, D, (bf16*)(ws + WS_WDN), kb * 64, nb * 32, nb * 32, scr, lane); }
    }
}
__device__ __forceinline__ void rms_row_to_bf16(const float* xrow, const float* g, bf16* orow, int lane) {
    const f32x4* xr = (const f32x4*)xrow + lane; const f32x4* gr = (const f32x4*)g + lane;
    f32x4 v[8]; float s = 0.f;
#pragma unroll
    for (int j = 0; j < 8; ++j) { v[j] = xr[64 * j]; s += (v[j].x * v[j].x + v[j].y * v[j].y) + (v[j].z * v[j].z + v[j].w * v[j].w); }
    const float rs = 1.0f / sqrtf(wave_sum(s) * (1.f / D) + NORM_EPS);
    u32x2* o8 = (u32x2*)orow + lane;
#pragma unroll
    for (int j = 0; j < 8; ++j) { const f32x4 gg = gr[64 * j]; const f32x4 y = v[j] * rs * gg; u32x2 w; w.x = pk2(y.x, y.y); w.y = pk2(y.z, y.w); o8[64 * j] = w; }
}
__device__ __forceinline__ void norm_phase(const float* Fb_, const float* Hin, float* Hout, const float* gpost, float coef, const float* gpre, bf16* XN, int gw, int NGW, int lane) {
    for (int m = gw; m < M; m += NGW) {
        const u32x2* fr = (const u32x2*)((const bf16*)Fb_ + (size_t)m * D) + lane; const f32x4* hr = (const f32x4*)(Hin + (size_t)m * D) + lane; f32x4* ho = (f32x4*)(Hout + (size_t)m * D) + lane;
        f32x4 f[8], h[8]; float s = 0.f;
#pragma unroll
        for (int j = 0; j < 8; ++j) { f[j] = unpk4(fr[64 * j]); h[j] = hr[64 * j]; }
#pragma unroll
        for (int j = 0; j < 8; ++j) s += (f[j].x * f[j].x + f[j].y * f[j].y) + (f[j].z * f[j].z + f[j].w * f[j].w);
        const float rs = coef / sqrtf(wave_sum(s) * (1.f / D) + NORM_EPS);
        float s2 = 0.f;
#pragma unroll
        for (int j = 0; j < 8; ++j) { const f32x4 gg = ((const f32x4*)gpost)[lane + 64 * j]; h[j] = h[j] + f[j] * rs * gg; ho[64 * j] = h[j];
            s2 += (h[j].x * h[j].x + h[j].y * h[j].y) + (h[j].z * h[j].z + h[j].w * h[j].w); }
        if (XN) {
            const float rs2 = 1.0f / sqrtf(wave_sum(s2) * (1.f / D) + NORM_EPS);
            u32x2* o8 = (u32x2*)(XN + (size_t)m * D) + lane;
#pragma unroll
            for (int j = 0; j < 8; ++j) { const f32x4 gg = ((const f32x4*)gpre)[lane + 64 * j]; const f32x4 y = h[j] * rs2 * gg; u32x2 w; w.x = pk2(y.x, y.y); w.y = pk2(y.z, y.w); o8[64 * j] = w; }
        }
    }
}

typedef float f32x2s __attribute__((ext_vector_type(2)));
#define SLO(x) __builtin_shufflevector(x, x, 0, 1)
#define SHI(x) __builtin_shufflevector(x, x, 2, 3)
constexpr int SC_TC = 32, SC_STEP_F = 352, SC_BUF_F = SC_TC * SC_STEP_F, SC_NCH = T / SC_TC;
template <int DIR>
__device__ __forceinline__ void scan_load_chunk(bf16* dbg, LAS float* wb, const bf16* RWb, const bf16* Eb, const bf16* Ab, int t0, int rh, int lane,
                                                float mpr, float mnr, float mpk, float mnk, float mpv, float mnv, float kkc, float kac) {
    constexpr int ts = DIR ? -1 : 1;
    float rr[10], kr[10], vr[10], ee[8], aa[8];
#pragma unroll
    for (int p = 0; p < 10; ++p) { const int t = t0 + (p - 1) * ts; const bool ok = (t >= 0) && (t < T); const unsigned* rp = (const unsigned*)(RWb + (size_t)(ok ? t : 0) * RWC);
        const float a0 = bfsel(rp[0], lane), a1 = bfsel(rp[512], lane), a2 = bfsel(rp[1024], lane); rr[p] = ok ? a0 : 0.f; kr[p] = ok ? a1 : 0.f; vr[p] = ok ? a2 : 0.f; }
#pragma unroll
    for (int q = 0; q < 8; ++q) { const size_t m = (size_t)(t0 + q * ts); ee[q] = bfsel(*(const unsigned*)(Eb + m * 1024), lane); aa[q] = bfsel(*(const unsigned*)(Ab + m * 1024), lane); }
#pragma unroll
    for (int q = 0; q < 8; ++q) {
        constexpr int dummy = 0; (void)dummy;
        const int pc = q + 1, pp = DIR ? q + 2 : q, pn = DIR ? q : q + 2;
        const float r = rr[pc] + mpr * (rr[pp] - rr[pc]) + mnr * (rr[pn] - rr[pc]);
        const float k = kr[pc] + mpk * (kr[pp] - kr[pc]) + mnk * (kr[pn] - kr[pc]);
        const float v = vr[pc] + mpv * (vr[pp] - vr[pc]) + mnv * (vr[pn] - vr[pc]);
        const float a = aa[q], w = __builtin_amdgcn_exp2f(-1.4426950408889634f * ee[q]);
        const float kq = k * kkc; const float n2 = wave_sum(kq * kq); const float kk = kq * (1.0f / sqrtf(fmaxf(n2, 1e-24f)));
        const float kd = k * (1.0f + (a - 1.0f) * kac);
        LAS float* o = wb + q * SC_STEP_F;
        o[lane] = kk; o[64 + lane] = w; o[128 + lane] = kk * a; o[192 + lane] = kd; o[256 + lane] = r;
        if ((lane >> 5) == rh) o[320 + (lane & 31)] = v;
#ifdef SCAN_DBG_LOADER
        if (dbg && (q & 1) == 0) dbg[(size_t)(q >> 1) * 64 + lane] = (bf16)f2bf(kk + w + kk * a + kd + r + v);
#endif
    }
}
__device__ __forceinline__ float wsum64(float x) {
    x += dppf<0xB1>(x); x += dppf<0x4E>(x); x += dppf<0x141>(x); x += dppf<0x128>(x);
    x += __shfl_xor(x, 16); x += __shfl_xor(x, 32); return x;
}
struct ScanRaw { unsigned rr[10], kr[10], vr[10], ee[8], aa[8]; };
template <int DIR>
__device__ __forceinline__ void scan_fetch(ScanRaw& R, const bf16* RWb, const bf16* Eb, const bf16* Ab, int t0) {
    constexpr int ts = DIR ? -1 : 1;
#pragma unroll
    for (int p = 0; p < 10; ++p) { const int t = t0 + (p - 1) * ts; const bool ok = (t >= 0) && (t < T); const bf16* rp = RWb + (size_t)(ok ? t : 0) * RWC;
        R.rr[p] = rp[0]; R.kr[p] = rp[1024]; R.vr[p] = rp[2048]; }
#pragma unroll
    for (int q = 0; q < 8; ++q) { const size_t m = (size_t)(t0 + q * ts); R.ee[q] = Eb[m * 1024]; R.aa[q] = Ab[m * 1024]; }
}
template <int DIR>
__device__ __forceinline__ void scan_prep_store(const ScanRaw& R, LAS float* wb, int t0, int rh, int lane,
                                                float mpr, float mnr, float mpk, float mnk, float mpv, float mnv, float kkc, float kac) {
    constexpr int ts = DIR ? -1 : 1;
    float rr[10], kr[10], vr[10];
#pragma unroll
    for (int p = 0; p < 10; ++p) { const int t = t0 + (p - 1) * ts; const bool ok = (t >= 0) && (t < T);
        rr[p] = ok ? __uint_as_float(R.rr[p] << 16) : 0.f; kr[p] = ok ? __uint_as_float(R.kr[p] << 16) : 0.f; vr[p] = ok ? __uint_as_float(R.vr[p] << 16) : 0.f; }
#pragma unroll
    for (int q = 0; q < 8; ++q) {
        const int pc = q + 1, pp = DIR ? q + 2 : q, pn = DIR ? q : q + 2;
        const float r = rr[pc] + mpr * (rr[pp] - rr[pc]) + mnr * (rr[pn] - rr[pc]);
        const float k = kr[pc] + mpk * (kr[pp] - kr[pc]) + mnk * (kr[pn] - kr[pc]);
        const float v = vr[pc] + mpv * (vr[pp] - vr[pc]) + mnv * (vr[pn] - vr[pc]);
        const float a = __uint_as_float(R.aa[q] << 16), w = __builtin_amdgcn_exp2f(-1.4426950408889634f * __uint_as_float(R.ee[q] << 16));
        const float kq = k * kkc; const float n2 = wsum64(kq * kq); const float kk = kq * __builtin_amdgcn_rsqf(fmaxf(n2, 1e-24f));
        const float kd = k * (1.0f + (a - 1.0f) * kac);
        LAS float* o = wb + q * SC_STEP_F;
        o[lane] = kk; o[64 + lane] = w; o[128 + lane] = kk * a; o[192 + lane] = kd; o[256 + lane] = r;
        if ((lane >> 5) == rh) o[320 + (lane & 31)] = v;
    }
}
#define SCAN_FLUSH(fc) do { const int fs_ = (fc) * SC_TC + lw * 8 + (lane >> 3); const int ft_ = d ? (T - 1 - fs_) : fs_; \
        const f32x4 ov_ = *(const LAS f32x4*)(obuf + ((fc) & 1) * (SC_TC * 32) + (lw * 8 + (lane >> 3)) * 32 + (lane & 7) * 4); \
        u32x2 ow_; ow_.x = pk2(ov_.x, ov_.y); ow_.y = pk2(ov_.z, ov_.w); *(u32x2*)(Od + (size_t)ft_ * 32 + (lane & 7) * 4) = ow_; } while (0)
__device__ __forceinline__ void scan_phase(LAS unsigned char* lds, const bf16* RW, const bf16* EA, bf16* OS, const float* mu_prev, const float* mu_next, const float* k_k, const float* k_a,
                                           int vcu, int G, int wave, int lane) {
    LAS float* buf = (LAS float*)(lds + 16384);
    LAS float* obuf = buf + 2 * SC_BUF_F;
    const bool is_loader = wave < 4;
    for (int wg = vcu; wg < 256; wg += G) {
        const int ch = wg >> 1, rh = wg & 1, d = ch >> 6, b = (ch >> 4) & 3, h = ch & 15;
        const size_t mb = (size_t)b * T;
        const int lw = wave & 3, c_ = h * 64 + lane;
        const float mpr = mu_prev[c_], mnr = mu_next[c_], mpk = mu_prev[1024 + c_], mnk = mu_next[1024 + c_], mpv = mu_prev[2048 + c_], mnv = mu_next[2048 + c_];
        const float kkc = k_k[c_], kac = k_a[c_];
        const int ce = c_ & ~1;
        const bf16* RWb = RW + mb * RWC + c_; const bf16* Eb = EA + ((size_t)d * M + mb) * 1024 + c_; const bf16* Ab = EA + ((size_t)(2 + d) * M + mb) * 1024 + c_; (void)ce;
        const int rowl = lane >> 3, jg = lane & 7, row_local = (wave & 3) * 8 + rowl;
        f32x2s S2[4];
#pragma unroll
        for (int e = 0; e < 4; ++e) S2[e] = (f32x2s){0.f, 0.f};
        bf16* Od = OS + ((size_t)((((d * 4 + b) * 16 + h) * 2 + rh)) * T) * 32;
        ScanRaw R;
        if (is_loader) { const int s0 = lw * 8; if (d == 0) scan_fetch<0>(R, RWb, Eb, Ab, s0); else scan_fetch<1>(R, RWb, Eb, Ab, T - 1 - s0); }
        for (int c = 0; c <= SC_NCH; ++c) {
            if (is_loader) {
                if (c >= 2) SCAN_FLUSH(c - 2);
                if (c < SC_NCH) {
                    const int s0 = c * SC_TC + lw * 8; LAS float* wb = buf + (c & 1) * SC_BUF_F + (lw * 8) * SC_STEP_F;
                    if (d == 0) scan_prep_store<0>(R, wb, s0, rh, lane, mpr, mnr, mpk, mnk, mpv, mnv, kkc, kac);
                    else scan_prep_store<1>(R, wb, T - 1 - s0, rh, lane, mpr, mnr, mpk, mnk, mpv, mnv, kkc, kac);
                    if (c + 1 < SC_NCH) { const int s1 = s0 + SC_TC; if (d == 0) scan_fetch<0>(R, RWb, Eb, Ab, s1); else scan_fetch<1>(R, RWb, Eb, Ab, T - 1 - s1); }
                }
            }
#ifdef SCAN_SYNC
            __syncthreads();
#endif
            if (!is_loader && c > 0) {
                __builtin_amdgcn_s_setprio(3);
                const int cc = c - 1;
                LAS float* obc = obuf + (cc & 1) * (SC_TC * 32);
                const LAS float* bc = buf + (cc & 1) * SC_BUF_F;
                const LAS float* p = bc + jg * 8;
                f32x4 kk0 = *(const LAS f32x4*)(p), kk1 = *(const LAS f32x4*)(p + 4), w0 = *(const LAS f32x4*)(p + 64), w1 = *(const LAS f32x4*)(p + 68), b0 = *(const LAS f32x4*)(p + 128), b1 = *(const LAS f32x4*)(p + 132),
                      k0 = *(const LAS f32x4*)(p + 192), k1 = *(const LAS f32x4*)(p + 196), r0 = *(const LAS f32x4*)(p + 256), r1 = *(const LAS f32x4*)(p + 260);
                float v = bc[320 + row_local];
#pragma unroll 8
                for (int s = 0; s < SC_TC; ++s) {
                    const int sn = (s + 1 < SC_TC) ? s + 1 : s;
                    const LAS float* pn = bc + sn * SC_STEP_F + jg * 8;
                    const f32x4 nkk0 = *(const LAS f32x4*)(pn), nkk1 = *(const LAS f32x4*)(pn + 4), nw0 = *(const LAS f32x4*)(pn + 64), nw1 = *(const LAS f32x4*)(pn + 68), nb0 = *(const LAS f32x4*)(pn + 128), nb1 = *(const LAS f32x4*)(pn + 132),
                                nk0 = *(const LAS f32x4*)(pn + 192), nk1 = *(const LAS f32x4*)(pn + 196), nr0 = *(const LAS f32x4*)(pn + 256), nr1 = *(const LAS f32x4*)(pn + 260);
                    const float nv = bc[sn * SC_STEP_F + 320 + row_local];
                    const f32x2s pa_ = S2[1] * SHI(kk0) + S2[0] * SLO(kk0), pb_ = S2[3] * SHI(kk1) + S2[2] * SLO(kk1); const f32x2s p_ = pa_ + pb_;
                    const f32x2s t0_ = S2[0] * SLO(w0), t1_ = S2[1] * SHI(w0), t2_ = S2[2] * SLO(w1), t3_ = S2[3] * SHI(w1);
                    const float nsa = -red8(p_.x + p_.y);
                    const f32x2s ns2 = (f32x2s){nsa, nsa}, v2 = (f32x2s){v, v};
                    S2[0] = ns2 * SLO(b0) + (v2 * SLO(k0) + t0_); S2[1] = ns2 * SHI(b0) + (v2 * SHI(k0) + t1_);
                    S2[2] = ns2 * SLO(b1) + (v2 * SLO(k1) + t2_); S2[3] = ns2 * SHI(b1) + (v2 * SHI(k1) + t3_);
                    const f32x2s qa_ = S2[1] * SHI(r0) + S2[0] * SLO(r0), qb_ = S2[3] * SHI(r1) + S2[2] * SLO(r1); const f32x2s q_ = qa_ + qb_;
#ifdef SCAN_TRIVIAL
                    const float o = v;
#else
                    const float o = red8(q_.x + q_.y);
#endif
                    if (jg == 0) obc[s * 32 + row_local] = o;
                    kk0 = nkk0; kk1 = nkk1; w0 = nw0; w1 = nw1; b0 = nb0; b1 = nb1; k0 = nk0; k1 = nk1; r0 = nr0; r1 = nr1; v = nv;
                }
                __builtin_amdgcn_s_setprio(0);
            }
            __syncthreads();
        }
        if (is_loader) SCAN_FLUSH(SC_NCH - 1);
        __syncthreads();
    }
}

__device__ __forceinline__ void post_phase(const bf16* __restrict__ RW, const bf16* __restrict__ EAG, const bf16* __restrict__ GG, const bf16* __restrict__ OS, const bf16* __restrict__ OATT, bf16* __restrict__ Y, const float* __restrict__ mu_prev, const float* __restrict__ mu_next, const float* __restrict__ k_a, const float* __restrict__ r_k,
                                           const float* gn_w, const float* gn_b, const float* lq1, const float* lk1, const float* lq2, const float* lk2, const float* subln_g, int gw, int NGW, int lane) {
#pragma unroll 2
    for (int it = gw; it < M * 4; it += NGW) {
        const int m = it >> 2, hq = it & 3, c0 = hq * 256 + 4 * lane, t = m & (T - 1);
        const bool hasp = t > 0, hasn = t < T - 1;
        const int hh = hq * 4 + (lane >> 4), i0 = (lane & 15) * 4, bb = m >> 11;
        const size_t oso = ((size_t)((((bb * 16 + hh) * 2 + (i0 >> 5))) * T) + t) * 32 + (i0 & 31);
        const f32x4 o = unpk4(*(const u32x2*)(OS + oso)) + unpk4(*(const u32x2*)(OS + (size_t)4 * 16 * 2 * T * 32 + oso));
        const bf16* rp = RW + (size_t)m * RWC + c0;
        f32x4 x[3], xp[3], xn[3];
#pragma unroll
        for (int q = 0; q < 3; ++q) { x[q] = unpk4(*(const u32x2*)(rp + q * 1024));
            xp[q] = unpk4(*(const u32x2*)(rp + q * 1024 - (hasp ? RWC : 0))); xn[q] = unpk4(*(const u32x2*)(rp + q * 1024 + (hasn ? RWC : 0)));
            if (!hasp) xp[q] = (f32x4){0.f, 0.f, 0.f, 0.f}; if (!hasn) xn[q] = (f32x4){0.f, 0.f, 0.f, 0.f};
            const f32x4 mp = *(const f32x4*)(mu_prev + q * 1024 + c0), mn = *(const f32x4*)(mu_next + q * 1024 + c0);
            x[q] = x[q] + mp * (xp[q] - x[q]) + mn * (xn[q] - x[q]); }
        const f32x4 a0 = unpk4(*(const u32x2*)(EAG + (size_t)(2 * M + m) * 1024 + c0)), a1 = unpk4(*(const u32x2*)(EAG + (size_t)(3 * M + m) * 1024 + c0));
        const f32x4 g = unpk4(*(const u32x2*)(GG + (size_t)m * 1024 + c0));
        const f32x4 ka = *(const f32x4*)(k_a + c0), rk = *(const f32x4*)(r_k + c0), gw4 = *(const f32x4*)(gn_w + c0), gb4 = *(const f32x4*)(gn_b + c0);
        const float mean = red16((o.x + o.y) + (o.z + o.w)) * (1.f / 64.f);
        const f32x4 dv = o - mean;
        const float var = red16((dv.x * dv.x + dv.y * dv.y) + (dv.z * dv.z + dv.w * dv.w)) * (1.f / 64.f);
        const float rstd = 1.0f / sqrtf(var + GN_EPS);
        const f32x4 ksum = x[1] * (2.0f + (a0 + a1 - 2.0f) * ka);
        const f32x4 bt = x[0] * ksum * rk;
        const float bs = red16((bt.x + bt.y) + (bt.z + bt.w));
        const f32x4 y = (dv * rstd * gw4 + gb4 + x[2] * bs) * g;
        u32x2 w; w.x = pk2(y.x, y.y); w.y = pk2(y.z, y.w);
        *(u32x2*)(Y + (size_t)m * 1024 + c0) = w;
    }
    const float lam = __expf(wave_sum(lq1[lane] * lk1[lane])) - __expf(wave_sum(lq2[lane] * lk2[lane])) + LAM_INIT;
#pragma unroll 2
    for (int m = gw; m < M; m += NGW) {
        const int hv = lane >> 3, d0 = 16 * (lane & 7);
        const bf16* p1 = OATT + (size_t)m * 2048 + (2 * hv) * 128 + d0; const bf16* p2 = p1 + 128;
        const v4u a0 = *(const v4u*)p1, a1 = *(const v4u*)(p1 + 8), b0 = *(const v4u*)p2, b1 = *(const v4u*)(p2 + 8);
        f32x4 df[4];
        df[0] = pg8::unpk_lo(a0) - lam * pg8::unpk_lo(b0); df[1] = pg8::unpk_hi(a0) - lam * pg8::unpk_hi(b0); df[2] = pg8::unpk_lo(a1) - lam * pg8::unpk_lo(b1); df[3] = pg8::unpk_hi(a1) - lam * pg8::unpk_hi(b1);
        float ss = 0.f;
#pragma unroll
        for (int q = 0; q < 4; ++q) ss += (df[q].x * df[q].x + df[q].y * df[q].y) + (df[q].z * df[q].z + df[q].w * df[q].w);
        const float rs = (1.0f - LAM_INIT) / sqrtf(red8(ss) * (1.f / 128.f) + SUBLN_EPS);
#pragma unroll
        for (int q = 0; q < 4; ++q) df[q] = df[q] * rs * *(const f32x4*)(subln_g + d0 + 4 * q);
        bf16* yo = Y + (size_t)(M + m) * 1024 + hv * 128 + d0;
        *(v4u*)yo = pg8::pack8(df[0], df[1]); *(v4u*)(yo + 8) = pg8::pack8(df[2], df[3]);
    }
}


struct Ctx { int vcu, wave, lane; };
typedef const __attribute__((address_space(4))) Args* ArgsP;
template <int ph> __device__ __forceinline__ void run_phase(const Ctx& c, LAS unsigned char* lds, unsigned char* lds_raw) {
    ArgsP ap = (ArgsP)__builtin_amdgcn_kernarg_segment_ptr(); asm volatile("" : "+s"(ap));
    unsigned char* ws = ap->ws; const float* x = ap->in[0]; float* out = ap->out;
    int tid = threadIdx.x; asm volatile("" : "+v"(tid));
    const int G = gridDim.x, bx = blockIdx.x, vcu = (G % 8 == 0) ? (bx % 8) * (G / 8) + bx / 8 : bx, wave = __builtin_amdgcn_readfirstlane(tid >> 6), lane = tid & 63; (void)c;
    const int gw = vcu * NWAVES + wave, NGW = G * NWAVES, gt = vcu * (NWAVES * 64) + tid, NGT = G * NWAVES * 64;
    bf16* XN = (bf16*)(ws + WS_XN); float* Fb = (float*)(ws + WS_F); bf16* ACT = (bf16*)(ws + WS_ACT);
    bf16* RW = (bf16*)(ws + WS_RW); bf16* Qb = (bf16*)(ws + WS_Q); bf16* Kb = (bf16*)(ws + WS_K); bf16* Vb = (bf16*)(ws + WS_V); bf16* Yb = (bf16*)(ws + WS_Y);
    bf16* GATES = (bf16*)(ws + WS_GATES); float* LR = (float*)(ws + WS_LR); bf16* LA = (bf16*)(ws + WS_LA); bf16* OATT = (bf16*)(ws + WS_OATT);
    bf16* EA = (bf16*)(ws + WS_F);
    bf16* Gg = (bf16*)(ws + WS_G);
#ifdef OS_IN_GATES
    bf16* OS = (bf16*)(ws + WS_GATES);
#else
    bf16* OS = (bf16*)(ws + WS_XN);
#endif
    bf16* MERGED = (bf16*)(ws + WS_XN); float* Pb = (float*)(ws + WS_F);
    float* ROPE = (float*)(ws + WS_ROPE);
    (void)XN; (void)Fb; (void)ACT; (void)RW; (void)Qb; (void)Kb; (void)Vb; (void)Yb; (void)GATES; (void)LR; (void)LA; (void)OATT; (void)EA; (void)Gg; (void)OS; (void)MERGED; (void)Pb; (void)ROPE; (void)gw; (void)NGW; (void)gt; (void)NGT; (void)bx;
    (void)tid; (void)x; (void)out; (void)ws;
#ifdef ONLY_PH
    if (ph != ONLY_PH) return;
#endif
#ifdef STOP_AFTER
    if (ph > STOP_AFTER) return;
#endif
#ifdef SKIP_MASK
    if ((SKIP_MASK >> ph) & 1) return;
#endif
        switch (ph) {
        case 0: {
            LAS float* scr = (LAS float*)(lds + RING_OFF + wave * 16384);
#ifdef HIDE_CONV
            conv_ffn_weights(ap->in[2], ap->in[3], ws, scr, gw, NGW, lane, 1);
#else
            conv_ffn_weights(ap->in[2], ap->in[3], ws, scr, gw, NGW, lane);
#endif
#ifndef HIDE_CONV
            constexpr int I_IN = (D / 64) * (IN_COLS / 32), I_BR = (1024 / 64) * (D / 32), I_OUT = (D / 64) * (D / 32);
            for (int it = gw; it < I_IN + 2 * I_BR + I_OUT; it += NGW) {
                int r = it;
                if (r < I_IN) { const int nb = r % (IN_COLS / 32), kb = r / (IN_COLS / 32); transpose_item(ap->in[6], D, IN_COLS, (bf16*)(ws + WS_WIN), kb * 64, nb * 32, map_in(nb * 32), scr, lane); continue; } r -= I_IN;
                if (r < I_BR) { const int nb = r % (D / 32), kb = r / (D / 32); transpose_item(ap->in[24], 1024, D, (bf16*)(ws + WS_WA), kb * 64, nb * 32, nb * 32, scr, lane); continue; } r -= I_BR;
                if (r < I_BR) { const int nb = r % (D / 32), kb = r / (D / 32); transpose_item(ap->in[25], 1024, D, (bf16*)(ws + WS_WB), kb * 64, nb * 32, nb * 32, scr, lane); continue; } r -= I_BR;
                { const int nb = r % (D / 32), kb = r / (D / 32); transpose_item(ap->in[26], D, D, (bf16*)(ws + WS_WOUT), kb * 64, nb * 32, nb * 32, scr, lane); }
            }
#endif
#ifndef HIDE_CONV
            { const float* w_up = ap->in[10]; const float* a_up = ap->in[12]; const float* g_up = ap->in[13]; bf16* WL = (bf16*)(ws + WS_WLORA);
              for (int i = gt; i < NLORA * (KLORA / 8); i += NGT) { const int n = i >> 6, k0 = (i & 63) * 8, ob = n >> 10, c = n & 1023; float v[8];
#pragma unroll
                  for (int e = 0; e < 8; ++e) { const int kk = k0 + e; float val = 0.f;
                      if (ob < 2) { if ((kk >> 6) == ob) val = w_up[(size_t)kk * 1024 + c]; }
                      else if (ob < 4) { if ((kk >> 6) == ob) val = a_up[(size_t)(kk - 128) * 1024 + c]; }
                      else { if (kk >= 256 && kk < 416) val = g_up[(size_t)(kk - 256) * 1024 + c]; }
                      v[e] = val; }
                  v4u o; o.x = pk2(v[0], v[1]); o.y = pk2(v[2], v[3]); o.z = pk2(v[4], v[5]); o.w = pk2(v[6], v[7]);
                  *(v4u*)(WL + (size_t)n * KLORA + k0) = o; } }
#endif
            for (int i = gt; i < T * 32; i += NGT) { const int t = i >> 5, k = i & 31;
                const float inv = __builtin_amdgcn_exp2f(-(float)k * (13.287712379549449f / 32.0f)); const float ang = (float)t * inv;
                const double rev = (double)ang * 0.15915494309189535; const float fr = (float)(rev - floor(rev));
                ROPE[t * 64 + k] = __builtin_amdgcn_cosf(fr); ROPE[t * 64 + 32 + k] = __builtin_amdgcn_sinf(fr); }
            for (int m = gw; m < M; m += NGW) rms_row_to_bf16(x + (size_t)m * D, ap->in[1], XN + (size_t)m * D, lane);
        } break;
        case 1: case 12: {
            pg8::Gemm g{XN, (const bf16*)(ws + WS_WGU), M, NGU, D, nullptr, nullptr}; pg8::StaticOrder S; S.init(M, NGU, G, bx);
            pg8::EpiSwiglu E{ACT, FF};
            pg8::gemm_phase<pg8::EpiSwiglu, pg8::StaticOrder, true, true>(lds + RING_OFF, g, S, E);
#ifdef HIDE_CONV
            if (ph == 1 && G == 256 ? bx >= 128 : ph == 1) { LAS float* scr = (LAS float*)(lds + RING_OFF + wave * 16384);
                const int gw2 = (G == 256) ? (bx - 128) * NWAVES + wave : gw, NGW2 = (G == 256) ? 128 * NWAVES : NGW;
                constexpr int I_IN = (D / 64) * (IN_COLS / 32);
                for (int r = gw2; r < I_IN; r += NGW2) { const int nb = r % (IN_COLS / 32), kb = r / (IN_COLS / 32); transpose_item(ap->in[6], D, IN_COLS, (bf16*)(ws + WS_WIN), kb * 64, nb * 32, map_in(nb * 32), scr, lane); }
                conv_ffn_weights(ap->in[2], ap->in[3], ws, scr, gw2, NGW2, lane, 2);
            }
#endif
        } break;
        case 2: case 10: case 13: {
            const bool isout = (ph == 10);
            pg8::Gemm g{isout ? MERGED : ACT, (const bf16*)(ws + (isout ? WS_WOUT : WS_WDN)), M, D, isout ? D : FF, nullptr, nullptr}; pg8::StaticOrder S; S.init(M, D, G, bx);
            pg8::EpiB16 E{(bf16*)Fb, D};
            pg8::gemm_phase<pg8::EpiB16, pg8::StaticOrder, true, true>(lds + RING_OFF, g, S, E);
        } break;
        case 3: case 11: case 14: {
            const float* gpost = ap->in[ph == 3 ? 4 : (ph == 11 ? 27 : 31)]; const float* gpre = ap->in[ph == 3 ? 5 : 28];
            norm_phase(Fb, ph == 3 ? x : out, out, gpost, ph == 11 ? 1.0f : 0.5f, gpre, ph == 14 ? (bf16*)nullptr : XN, gw, NGW, lane);
        } break;
        case 4: {
            pg8::Gemm g{XN, (const bf16*)(ws + WS_WIN), M, IN_PAD, D, nullptr, nullptr}; pg8::StaticOrder S; S.init(M, IN_PAD, G, bx);
            pg8::EpiIn E{RW, Qb, Kb, Vb, GATES, LR, ROPE, QSCALE};
            pg8::gemm_phase<pg8::EpiIn, pg8::StaticOrder, true, true>(lds + RING_OFF, g, S, E);
#ifdef HIDE_CONV
            if (G == 256 ? bx >= 64 : true) { LAS float* scr = (LAS float*)(lds + RING_OFF + wave * 16384);
                const int gw2 = (G == 256) ? (bx - 64) * NWAVES + wave : gw, NGW2 = (G == 256) ? 192 * NWAVES : NGW;
                conv_ffn_weights(ap->in[29], ap->in[30], ws, scr, gw2, NGW2, lane);
                constexpr int I_BR = (1024 / 64) * (D / 32), I_OUT = (D / 64) * (D / 32);
                for (int it = gw2; it < 2 * I_BR + I_OUT; it += NGW2) { int r = it;
                    if (r < I_BR) { const int nb = r % (D / 32), kb = r / (D / 32); transpose_item(ap->in[24], 1024, D, (bf16*)(ws + WS_WA), kb * 64, nb * 32, nb * 32, scr, lane); continue; } r -= I_BR;
                    if (r < I_BR) { const int nb = r % (D / 32), kb = r / (D / 32); transpose_item(ap->in[25], 1024, D, (bf16*)(ws + WS_WB), kb * 64, nb * 32, nb * 32, scr, lane); continue; } r -= I_BR;
                    { const int nb = r % (D / 32), kb = r / (D / 32); transpose_item(ap->in[26], D, D, (bf16*)(ws + WS_WOUT), kb * 64, nb * 32, nb * 32, scr, lane); } }
                const int gt2 = (G == 256) ? (bx - 64) * (NWAVES * 64) + tid : gt, NGT2 = (G == 256) ? 192 * NWAVES * 64 : NGT;
            { const float* w_up = ap->in[10]; const float* a_up = ap->in[12]; const float* g_up = ap->in[13]; bf16* WL = (bf16*)(ws + WS_WLORA);
              for (int i = gt2; i < NLORA * (KLORA / 8); i += NGT2) { const int n = i >> 6, k0 = (i & 63) * 8, ob = n >> 10, c = n & 1023; float v[8];
#pragma unroll
                  for (int e = 0; e < 8; ++e) { const int kk = k0 + e; float val = 0.f;
                      if (ob < 2) { if ((kk >> 6) == ob) val = w_up[(size_t)kk * 1024 + c]; }
                      else if (ob < 4) { if ((kk >> 6) == ob) val = a_up[(size_t)(kk - 128) * 1024 + c]; }
                      else { if (kk >= 256 && kk < 416) val = g_up[(size_t)(kk - 256) * 1024 + c]; }
                      v[e] = val; }
                  v4u o; o.x = pk2(v[0], v[1]); o.y = pk2(v[2], v[3]); o.z = pk2(v[4], v[5]); o.w = pk2(v[6], v[7]);
                  *(v4u*)(WL + (size_t)n * KLORA + k0) = o; } }
            }
#endif
        } break;
        case 5: {
            const float* mu_prev = ap->in[7]; const float* mu_next = ap->in[8];
            for (int i = gt; i < M * 64; i += NGT) { const int m = i >> 6, grp = i & 63, c0 = grp * 8, t = m & (T - 1);
                f32x4 y0 = (f32x4){0.f, 0.f, 0.f, 0.f}, y1 = y0;
                if (grp < 52) {
                    const float* cp = LR + (size_t)m * 512 + c0; const f32x4 z = (f32x4){0.f, 0.f, 0.f, 0.f};
                    const f32x4 c_0 = *(const f32x4*)cp, c_1 = *(const f32x4*)(cp + 4);
                    const f32x4 p_0 = t > 0 ? *(const f32x4*)(cp - 512) : z, p_1 = t > 0 ? *(const f32x4*)(cp - 508) : z;
                    const f32x4 n_0 = t < T - 1 ? *(const f32x4*)(cp + 512) : z, n_1 = t < T - 1 ? *(const f32x4*)(cp + 516) : z;
                    const f32x4 mp0 = *(const f32x4*)(mu_prev + 3072 + c0), mp1 = *(const f32x4*)(mu_prev + 3076 + c0), mn0 = *(const f32x4*)(mu_next + 3072 + c0), mn1 = *(const f32x4*)(mu_next + 3076 + c0);
                    y0 = c_0 + mp0 * (p_0 - c_0) + mn0 * (n_0 - c_0); y1 = c_1 + mp1 * (p_1 - c_1) + mn1 * (n_1 - c_1);
                    if (c0 < 128) {
#pragma unroll
                        for (int e = 0; e < 4; ++e) { y0[e] = 2.0f * sigm_(2.0f * y0[e]) - 1.0f; y1[e] = 2.0f * sigm_(2.0f * y1[e]) - 1.0f; } }
                    else if (c0 >= 256) {
#pragma unroll
                        for (int e = 0; e < 4; ++e) { y0[e] = sigm_(y0[e]); y1[e] = sigm_(y1[e]); } }
                }
                *(v4u*)(LA + (size_t)m * 512 + c0) = pg8::pack8(y0, y1); }
#ifndef HIDE_CONV
            LAS float* scr = (LAS float*)(lds + RING_OFF + wave * 16384);
            conv_ffn_weights(ap->in[29], ap->in[30], ws, scr, gw, NGW, lane);
#endif
        } break;
        case 6: {
            pg8::Gemm g{LA, (const bf16*)(ws + WS_WLORA), M, NLORA, KLORA, nullptr, nullptr}; pg8::LoraOrder S; S.so.init(M, NLORA, G, bx);
            pg8::EpiLora E{EA, Gg, ap->in[9], ap->in[11]};
            pg8::gemm_phase<pg8::EpiLora, pg8::LoraOrder, true, true>(lds + RING_OFF, g, S, E);
        } break;
        case 7: {
            scan_phase(lds + RING_OFF, RW, EA, OS, ap->in[7], ap->in[8], ap->in[14], ap->in[15], vcu, G, wave, lane);
            __syncthreads();
#ifdef SKIP_ATTN
            if (true) break;
#endif
            const int upc = (1024 + G - 1) / G;
            for (int i = 0; i < upc; ++i) { const int unit = vcu * upc + i; if (unit >= 1024) break;
                const int qb = unit & 7, vh = (unit >> 3) & 1, j = (unit >> 4) & 15, b = unit >> 8;
                attn_body::attn_unit<8>(b, j, (j >> 1) * 128 + vh * 64, j * 128 + vh * 64, qb, (const attn_body::bf16*)Qb, (const attn_body::bf16*)Kb, (const attn_body::bf16*)Vb, (attn_body::bf16*)OATT, (char*)lds_raw + RING_OFF); }
        } break;
        case 8: {
            post_phase(RW, EA, Gg, OS, OATT, Yb, ap->in[7], ap->in[8], ap->in[15], ap->in[16], ap->in[17], ap->in[18], ap->in[19], ap->in[20], ap->in[21], ap->in[22], ap->in[23], gw, NGW, lane);
        } break;
        case 9: {
            pg8::Gemm g{Yb, (const bf16*)(ws + WS_WA), M, D, 1024, Yb + (size_t)M * 1024, (const bf16*)(ws + WS_WB)}; pg8::BranchOrder S; S.so.init(M, D, G, bx);
            pg8::EpiBranch E{Pb, MERGED, GATES};
            pg8::gemm_phase<pg8::EpiBranch, pg8::BranchOrder, true, true>(lds + RING_OFF, g, S, E);
        } break;
        }
}
__device__ __forceinline__ void ap_out_nan(float* out, int i) { out[i] = __builtin_nanf(""); }
#ifndef USE_XCD_BARRIER
#define USE_XCD_BARRIER 1
#endif
#if USE_XCD_BARRIER
#define GRID_SYNC() xcd_barrier(bar)
#else
#define GRID_SYNC() cooperative_groups::this_grid().sync()
#endif
#ifndef CUT_LIST
#define CUT_LIST {0, 15}
#endif
__global__ void __launch_bounds__(NWAVES * 64, 2) mk_fwd(Args args) {
    extern __shared__ __attribute__((aligned(16))) unsigned char lds_raw[];
    LAS unsigned char* lds = (LAS unsigned char*)lds_raw;
    volatile LAS unsigned* MISC = (volatile LAS unsigned*)(lds + MISC_OFF);
    const int tid = threadIdx.x, lane = tid & 63, wave = __builtin_amdgcn_readfirstlane(tid >> 6);
    const int G = gridDim.x; const int bx = blockIdx.x; const int vcu = (G % 8 == 0) ? (bx % 8) * (G / 8) + bx / 8 : bx;
    unsigned char* ws = args.ws;
    gu32* ctl = (gu32*)(ws + WS_CTL);
    for (int u = tid; u < (LDS_BYTES - LDSCTL_OFF) / 4; u += NWAVES * 64) ((LAS unsigned*)(lds + LDSCTL_OFF))[u] = 0u;
    __syncthreads();
    XcdBarrier bar = xcd_barrier_post((unsigned*)(ctl + CW_BAR) + args.li * XCD_BAR_WORDS, MISC + 8);
    const int ph_lo = args.ph_lo, ph_hi = args.ph_hi;
#ifdef DUMP_SCAN_INPUTS
    if (ph_lo == 7) {
        for (size_t i_ = (size_t)blockIdx.x * 512 + threadIdx.x; i_ < (size_t)M * D; i_ += (size_t)gridDim.x * 512) {
            float s_ = 0.f;
            { const unsigned* W_ = (const unsigned*)(ws + WS_RW); if (i_ < (size_t)48 * MiB / 4) s_ += (float)(W_[i_] & 0xfffffu) + (float)(W_[i_] >> 20); }
            { const unsigned* W_ = (const unsigned*)(ws + WS_F); s_ += (float)(W_[i_] & 0xfffffu) + (float)(W_[i_] >> 20); }
            if (i_ < 3488) s_ += args.in[7][i_] + args.in[8][i_];
            if (i_ < 1024) s_ += args.in[14][i_] + args.in[15][i_];
            args.out[i_] = s_; }
        return; }
    if (ph_lo > 7) return;
#endif
#ifdef DUMP_OS_AT8
    if (ph_lo == 8) {
        for (size_t i_ = (size_t)blockIdx.x * 512 + threadIdx.x; i_ < (size_t)M * D; i_ += (size_t)gridDim.x * 512) {
            float s_ = 0.f;
            if (DUMP_OS_AT8 & 1) { const unsigned* W_ = (const unsigned*)(ws + WS_XN); if (i_ < (size_t)32 * MiB / 4) s_ += (float)(W_[i_] & 0xfffffu) + (float)(W_[i_] >> 20); }
            if (DUMP_OS_AT8 & 4) { const unsigned* W_ = (const unsigned*)(ws + WS_GATES); s_ += (float)(W_[i_] & 0xfffffu) + (float)(W_[i_] >> 20); }
            if (DUMP_OS_AT8 & 8) { const unsigned* W_ = (const unsigned*)(ws + WS_GATES); if (i_ < 256 * 8 * 4 * 64) s_ += (float)(W_[i_] & 0xfffffu) + (float)(W_[i_] >> 20); }
            if (DUMP_OS_AT8 & 2) { const unsigned* W_ = (const unsigned*)(ws + WS_OATT); if (i_ < (size_t)32 * MiB / 4) s_ += (float)(W_[i_] & 0xfffffu) + (float)(W_[i_] >> 20); }
            args.out[i_] = s_; }
        return; }
#endif
    Ctx c{vcu, wave, lane};
#ifdef DUMP_AFTER
#define DUMP_AFTER_7X(n) ((n) == 7 && DUMP_AFTER > 70)
#define DUMPR(off, nbytes) do { const unsigned* W_ = (const unsigned*)(ws + (off)); const size_t n_ = (size_t)(nbytes) / 4; \
        for (size_t i_ = (size_t)blockIdx.x * 512 + threadIdx.x; i_ < (size_t)M * D; i_ += (size_t)gridDim.x * 512) { float s_ = 0.f; for (size_t j_ = i_; j_ < n_; j_ += (size_t)M * D) s_ += (float)(W_[j_] & 0xfffffu); args.out[i_] += s_; } } while (0)
#define DUMPCHK(k) if (DUMP_AFTER == (k)) { for (size_t i_ = (size_t)blockIdx.x * 512 + threadIdx.x; i_ < (size_t)M * D; i_ += (size_t)gridDim.x * 512) args.out[i_] = 0.f; \
        if ((k) == 4) { DUMPR(WS_RW, 48 * MiB); DUMPR(WS_Q, 48 * MiB); DUMPR(WS_GATES, 64 * MiB); } \
        if ((k) == 5) { DUMPR(WS_LA, 8 * MiB); DUMPR(WS_WGU, 66 * MiB); } \
        if ((k) == 6) { DUMPR(WS_F, 64 * MiB); DUMPR(WS_G, 16 * MiB); } \
        if ((k) == 7) { DUMPR(WS_XN, 32 * MiB); DUMPR(WS_OATT, 32 * MiB); } \
        if ((k) == 71) { DUMPR(WS_XN, 32 * MiB); } \
        if ((k) == 72) { DUMPR(WS_OATT, 32 * MiB); } \
        if ((k) == 8) { DUMPR(WS_Y, 32 * MiB); } \
        if ((k) == 9) { DUMPR(WS_XN, 32 * MiB); } \
        if ((k) == 10) { DUMPR(WS_F, 64 * MiB); } \
        return; }
#else
#define DUMPCHK(k)
#define DUMP_AFTER_7X(n) false
#endif
#ifdef HASH_AFTER
#define HASHCHK(n) if ((n) == HASH_AFTER) { unsigned hs_ = 0u; const unsigned* W_ = (const unsigned*)(ws + (size_t)(HASH_LO) * MiB); const size_t n_ = (size_t)((HASH_HI) - (HASH_LO)) * MiB / 4; \
        for (size_t i_ = (size_t)blockIdx.x * 512 + threadIdx.x; i_ < n_; i_ += (size_t)gridDim.x * 512) { const unsigned w_ = W_[i_]; hs_ += w_ * 2654435761u + (w_ >> 15) + (unsigned)i_ * (w_ | 1u); } \
        atomicAdd((unsigned*)(ctl + 100000), hs_); GRID_SYNC(); const unsigned hv_ = xb_ld((unsigned*)(ctl + 100000)); \
        for (size_t i_ = (size_t)blockIdx.x * 512 + threadIdx.x; i_ < (size_t)M * D; i_ += (size_t)gridDim.x * 512) args.out[i_] = (float)((hv_ ^ (unsigned)(i_ * 40503u)) & 0xffffu); \
        return; }
#else
#define HASHCHK(n)
#endif
#ifdef DUP_PHASE
#define DUPRUN(n) if ((n) == DUP_PHASE) { run_phase<n>(c, lds, lds_raw); GRID_SYNC(); }
#else
#define DUPRUN(n)
#endif
#define PH(n) if (ph_lo <= (n) && (n) < ph_hi) { DUPRUN(n) run_phase<n>(c, lds, lds_raw); if ((n) + 1 < ph_hi) { GRID_SYNC(); } HASHCHK(n) }
    PH(0) PH(1) PH(2) PH(3) PH(4) PH(5) PH(6) PH(7) PH(8) PH(9) PH(10) PH(11) PH(12) PH(13)
    PH(14)
    if (ph_hi == 15 && (xb_ld((unsigned*)(ctl + CW_BAR) + XB_TMO) | xb_ld((unsigned*)(ctl + CW_BAR) + XCD_BAR_WORDS + XB_TMO) | xb_ld((unsigned*)(ctl + CW_BAR) + 2 * XCD_BAR_WORDS + XB_TMO)) != 0u) { asm volatile("s_waitcnt vmcnt(0)" ::: "memory"); if (threadIdx.x < 64) ap_out_nan(args.out, blockIdx.x * 64 + threadIdx.x); }
#undef PH
}

extern "C" void kernel_launch(void* const* d_in, const int* in_sizes, int n_in, void* d_out, int out_size, void* d_ws, size_t ws_size, hipStream_t stream) {
    static int grid = 0;
    if (grid == 0) {
        if (n_in != 32 || in_sizes[0] != M * D || out_size != M * D || ws_size < WS_END) { fprintf(stderr, "kernel_launch: unexpected shapes (n_in %d, ws %zu)\n", n_in, ws_size); grid = -1; return; }
        int dev = 0, cus = 0, per_cu = 0;
        if (hipGetDevice(&dev) != hipSuccess || hipDeviceGetAttribute(&cus, hipDeviceAttributeMultiprocessorCount, dev) != hipSuccess) { grid = -1; return; }
        if (hipFuncSetAttribute((const void*)mk_fwd, hipFuncAttributeMaxDynamicSharedMemorySize, LDS_BYTES) != hipSuccess) { fprintf(stderr, "kernel_launch: hipFuncSetAttribute failed\n"); grid = -1; return; }
        if (hipOccupancyMaxActiveBlocksPerMultiprocessor(&per_cu, (const void*)mk_fwd, NWAVES * 64, LDS_BYTES) != hipSuccess || per_cu < 1) { fprintf(stderr, "kernel_launch: occupancy query says %d\n", per_cu); per_cu = 1; }
        (void)hipGetLastError();
        grid = cus;
    }
    if (grid < 0) return;
    if (hipMemsetAsync((char*)d_ws + WS_CTL, 0, CTL_ZERO_BYTES, stream) != hipSuccess) return;
    Args a{};
    for (int i = 0; i < 32; ++i) a.in[i] = (const float*)d_in[i];
    a.out = (float*)d_out; a.ws = (unsigned char*)d_ws;
#if USE_XCD_BARRIER
#ifndef N_CUTS
#define N_CUTS 1
#endif
    static const int cuts[N_CUTS + 1] = CUT_LIST;
    for (int li = 0; li < N_CUTS; ++li) { a.ph_lo = cuts[li]; a.ph_hi = cuts[li + 1]; a.li = li;
        hipLaunchKernelGGL(mk_fwd, dim3(grid), dim3(NWAVES * 64), LDS_BYTES, stream, a); }
#else
    void* kargs[] = {&a};
    hipError_t e = hipLaunchCooperativeKernel((const void*)mk_fwd, dim3(grid), dim3(NWAVES * 64), kargs, LDS_BYTES, stream);
    if (e != hipSuccess) fprintf(stderr, "cooperative launch failed: %s (grid %d)\n", hipGetErrorString(e), grid);
#endif
}
```

```cpp
#include <hip/hip_runtime.h>
#include <hip/hip_cooperative_groups.h>
#include <cstdio>
#include <cstdint>
namespace pg8 {
#define PG8_LAS __attribute__((address_space(3)))
typedef unsigned short bf16_t;
typedef short bf16x8 __attribute__((ext_vector_type(8)));
typedef float f32x4 __attribute__((ext_vector_type(4)));
typedef unsigned u32x4 __attribute__((ext_vector_type(4)));
constexpr int BM = 256, BK = 64, HALF = 128, HTB = HALF * BK * 2  , STAGE_BYTES = 8 * HTB, NXCD = 8, WGM = 8;

__host__ __device__ __forceinline__ int lds_byte(int r, int c) { const int st = (r >> 4) * 2 + (c >> 5), rr = r & 15, cc = c & 31, ob = rr * 64 + cc * 2; return st * 1024 + (ob ^ (((ob >> 9) & 1) << 5)); }
__host__ __device__ __forceinline__ void stage_rc(int b, int& R, int& C) { const int st = b / 1024, sb = b % 1024, swz = sb ^ (((sb >> 9) & 1) << 5); R = (st >> 1) * 16 + swz / 64; C = (st & 1) * 32 + (swz % 64) / 2; }
__host__ __device__ __forceinline__ int perm32(int rho) { const int n = rho >> 4, i = rho & 15; return 8 * (i >> 2) + 4 * n + (i & 3); }

struct Unit { int pm, pn, sel, kbeg, nt; };
struct Gemm { const bf16_t* A; const bf16_t* Bt; int M, N, K; const bf16_t* A2; const bf16_t* Bt2; };

struct StaticOrder {
    int nM, nN, nwg, G, c;
    __host__ __device__ void init(int M, int N, int G_, int c_) { nM = M / BM; nN = N / BM; nwg = nM * nN; G = G_; c = c_; }
    __host__ __device__ bool next(int i, Unit& u) const {
        const long L = (long)i * G + c; if (L >= nwg) return false;
        int wgid = (int)L; { const int q = nwg / NXCD, r = nwg % NXCD, xcd = wgid % NXCD, off = wgid / NXCD; wgid = (xcd < r ? xcd * (q + 1) : r * (q + 1) + (xcd - r) * q) + off; }
        const int nig = WGM * nN, gid = wgid / nig, fm = gid * WGM, gsz = (nM - fm) < WGM ? (nM - fm) : WGM;
        u.pm = fm + ((wgid % nig) % gsz); u.pn = (wgid % nig) / gsz; u.sel = 0; u.kbeg = 0; u.nt = 0; return true;
    }
    __device__ __forceinline__ void a_ready(const Unit&) const {}
    __device__ __forceinline__ void done(const Unit&) const {}
};


typedef float f32x2c_t __attribute__((ext_vector_type(2))); typedef __bf16 bf16x2c_t __attribute__((ext_vector_type(2)));
__device__ __forceinline__ unsigned cvt_pk_bf16(float lo, float hi) { f32x2c_t v = {lo, hi}; bf16x2c_t b = __builtin_convertvector(v, bf16x2c_t); return __builtin_bit_cast(unsigned, b); }
__device__ __forceinline__ float sigm(float x) { return __builtin_amdgcn_rcpf(1.0f + __builtin_amdgcn_exp2f(-1.4426950408889634f * x)); }
__device__ __forceinline__ u32x4 pack8(const f32x4 a, const f32x4 b) { u32x4 w; w.x = cvt_pk_bf16(a[0], a[1]); w.y = cvt_pk_bf16(a[2], a[3]); w.z = cvt_pk_bf16(b[0], b[1]); w.w = cvt_pk_bf16(b[2], b[3]); return w; }
__device__ __forceinline__ f32x4 unpk_lo(const u32x4 w) { return (f32x4){__uint_as_float(w.x << 16), __uint_as_float(w.x & 0xffff0000u), __uint_as_float(w.y << 16), __uint_as_float(w.y & 0xffff0000u)}; }
__device__ __forceinline__ f32x4 unpk_hi(const u32x4 w) { return (f32x4){__uint_as_float(w.z << 16), __uint_as_float(w.z & 0xffff0000u), __uint_as_float(w.w << 16), __uint_as_float(w.w & 0xffff0000u)}; }

template <int ACT>
__device__ __forceinline__ void store_nat_bf16(const f32x4 (&acc)[2][2][4][2], bf16_t* O, int ldc, int row0, int colt, int wc, int fq, const float* bias) {
    const int col0 = colt + wc * 32 + 8 * fq;
    f32x4 bv[2][2];
#pragma unroll
    for (int bj = 0; bj < 2; ++bj)
#pragma unroll
        for (int n = 0; n < 2; ++n) bv[bj][n] = bias ? *(const f32x4*)(bias + col0 + bj * HALF + 4 * n) : (f32x4){0.f, 0.f, 0.f, 0.f};
#pragma unroll
    for (int ai = 0; ai < 2; ++ai)
#pragma unroll
        for (int m = 0; m < 4; ++m) { bf16_t* rowp = O + (size_t)(row0 + ai * HALF + m * 16) * ldc + col0;
#pragma unroll
            for (int bj = 0; bj < 2; ++bj) { f32x4 v0 = acc[ai][bj][m][0] + bv[bj][0], v1 = acc[ai][bj][m][1] + bv[bj][1];
                if (ACT >= 1) {
#pragma unroll
                    for (int e = 0; e < 4; ++e) { v0[e] = sigm(v0[e]); v1[e] = sigm(v1[e]); }
                    if (ACT == 2) { v0 = v0 * 0.6065306597f; v1 = v1 * 0.6065306597f; } }
                *(u32x4*)(rowp + bj * HALF) = pack8(v0, v1); } }
}

struct EpiSwiglu {
    static constexpr bool PERM = true, AFTER_DRAIN = false;
    bf16_t* O; int ldc;
    __device__ __forceinline__ void operator()(const f32x4 (&acc)[2][2][4][2], const Unit& u, int wr, int wc, int fr, int fq) const {
        const int row0 = u.pm * BM + wr * 64 + fr, col0 = u.pn * HALF + wc * 32 + 8 * fq;
#pragma unroll
        for (int ai = 0; ai < 2; ++ai)
#pragma unroll
            for (int m = 0; m < 4; ++m) { bf16_t* rowp = O + (size_t)(row0 + ai * HALF + m * 16) * ldc + col0;
                f32x4 v0, v1;
#pragma unroll
                for (int e = 0; e < 4; ++e) { const float g0 = acc[ai][0][m][0][e], g1 = acc[ai][0][m][1][e];
                    v0[e] = g0 * sigm(g0) * acc[ai][1][m][0][e]; v1[e] = g1 * sigm(g1) * acc[ai][1][m][1][e]; }
                *(u32x4*)rowp = pack8(v0, v1); }
    }
};

struct EpiF32 {
    static constexpr bool PERM = true, AFTER_DRAIN = false;
    float* O; int ldc;
    __device__ __forceinline__ void operator()(const f32x4 (&acc)[2][2][4][2], const Unit& u, int wr, int wc, int fr, int fq) const {
        const int row0 = u.pm * BM + wr * 64 + fr, col0 = u.pn * BM + wc * 32 + 8 * fq;
#pragma unroll
        for (int ai = 0; ai < 2; ++ai)
#pragma unroll
            for (int m = 0; m < 4; ++m) { float* rowp = O + (size_t)(row0 + ai * HALF + m * 16) * ldc + col0;
#pragma unroll
                for (int bj = 0; bj < 2; ++bj) { *(f32x4*)(rowp + bj * HALF) = acc[ai][bj][m][0]; *(f32x4*)(rowp + bj * HALF + 4) = acc[ai][bj][m][1]; } }
    }
};

struct EpiB16 {
    static constexpr bool PERM = true, AFTER_DRAIN = false;
    bf16_t* O; int ldc;
    __device__ __forceinline__ void operator()(const f32x4 (&acc)[2][2][4][2], const Unit& u, int wr, int wc, int fr, int fq) const {
        store_nat_bf16<0>(acc, O, ldc, u.pm * BM + wr * 64 + fr, u.pn * BM, wc, fq, nullptr);
    }
};

struct EpiIn {
    static constexpr bool PERM = true, AFTER_DRAIN = false;
    bf16_t *RW, *Q, *K, *V, *GATES; float* LR; const float* rope; float qscale;
    __device__ __forceinline__ void operator()(const f32x4 (&acc)[2][2][4][2], const Unit& u, int wr, int wc, int fr, int fq) const {
        const int pn = u.pn, row0 = u.pm * BM + wr * 64 + fr;
        if (pn < 12) store_nat_bf16<0>(acc, RW, 3072, row0, pn * 256, wc, fq, nullptr);
        else if (pn < 14) {
            const int col0 = (pn - 12) * 256 + wc * 32 + 8 * fq;
#pragma unroll
            for (int ai = 0; ai < 2; ++ai)
#pragma unroll
                for (int m = 0; m < 4; ++m) { float* rowp = LR + (size_t)(row0 + ai * HALF + m * 16) * 512 + col0;
#pragma unroll
                    for (int bj = 0; bj < 2; ++bj) { *(f32x4*)(rowp + bj * HALF) = acc[ai][bj][m][0]; *(f32x4*)(rowp + bj * HALF + 4) = acc[ai][bj][m][1]; } }
        } else if (pn < 22) {
            const bool isk = pn >= 18; bf16_t* base = isk ? K : Q; const float sc = isk ? 1.0f : qscale;
            const int head = 4 * ((pn - 14) & 3) + wc;
#pragma unroll
            for (int ai = 0; ai < 2; ++ai)
#pragma unroll
                for (int m = 0; m < 4; ++m) { const int row = row0 + ai * HALF + m * 16; const float* cp = rope + (size_t)(row & 2047) * 64 + 8 * fq;
                    const f32x4 c0 = *(const f32x4*)cp, c1 = *(const f32x4*)(cp + 4), s0 = *(const f32x4*)(cp + 32), s1 = *(const f32x4*)(cp + 36);
                    const f32x4 x1a = acc[ai][0][m][0], x1b = acc[ai][0][m][1], x2a = acc[ai][1][m][0], x2b = acc[ai][1][m][1];
                    const f32x4 o1a = (x1a * c0 - x2a * s0) * sc, o1b = (x1b * c1 - x2b * s1) * sc, o2a = (x2a * c0 + x1a * s0) * sc, o2b = (x2b * c1 + x1b * s1) * sc;
                    bf16_t* rowp = base + (size_t)row * 1024 + head * 64 + 8 * fq;
                    *(u32x4*)rowp = pack8(o1a, o1b); *(u32x4*)(rowp + 32) = pack8(o2a, o2b); }
        } else if (pn < 26) store_nat_bf16<0>(acc, V, 1024, row0, (pn - 22) * 256, wc, fq, nullptr);
        else store_nat_bf16<1>(acc, GATES, 4096, row0, (pn - 26) * 256, wc, fq, nullptr);
    }
};

struct EpiLora {
    static constexpr bool PERM = true, AFTER_DRAIN = false;
    bf16_t* EAG; bf16_t* GG; const float* w0; const float* a0;
    __device__ __forceinline__ void operator()(const f32x4 (&acc)[2][2][4][2], const Unit& u, int wr, int wc, int fr, int fq) const {
        const int ob = u.pn >> 2, colt = (u.pn & 3) * 256, row0 = u.pm * BM + wr * 64 + fr;
        bf16_t* O = EAG + (size_t)ob * 8192 * 1024;
        if (ob < 2) store_nat_bf16<2>(acc, O, 1024, row0, colt, wc, fq, w0 + ob * 1024);
        else if (ob < 4) store_nat_bf16<1>(acc, O, 1024, row0, colt, wc, fq, a0 + (ob - 2) * 1024);
        else store_nat_bf16<0>(acc, GG, 1024, row0, colt, wc, fq, nullptr);
    }
};

struct EpiBranch {
    static constexpr bool PERM = true, AFTER_DRAIN = false;
    float* P; bf16_t* MERGED; const bf16_t* GATES;
    __device__ __forceinline__ void operator()(const f32x4 (&acc)[2][2][4][2], const Unit& u, int wr, int wc, int fr, int fq) const {
        const int row0 = u.pm * BM + wr * 64 + fr, col0 = u.pn * BM + wc * 32 + 8 * fq;
#pragma unroll
        for (int ai = 0; ai < 2; ++ai)
#pragma unroll
            for (int m = 0; m < 4; ++m) { const size_t row = (size_t)(row0 + ai * HALF + m * 16);
#pragma unroll
                for (int bj = 0; bj < 2; ++bj) { const int col = col0 + bj * HALF;
                    const u32x4 gw = *(const u32x4*)(GATES + row * 4096 + u.sel * 2048 + col);
                    const f32x4 v0 = acc[ai][bj][m][0] * unpk_lo(gw), v1 = acc[ai][bj][m][1] * unpk_hi(gw);
                    float* pp = P + row * 2048 + col;
                    if (u.sel == 0) { *(f32x4*)pp = v0; *(f32x4*)(pp + 4) = v1; }
                    else { const f32x4 p0 = *(const f32x4*)pp, p1 = *(const f32x4*)(pp + 4); *(u32x4*)(MERGED + row * 2048 + col) = pack8(p0 + v0, p1 + v1); } } }
    }
};
struct LoraOrder {
    StaticOrder so;
    __host__ __device__ bool next(int i, Unit& u) const { if (!so.next(i, u)) return false; const int ob = u.pn >> 2; u.kbeg = ob < 2 ? 0 : (ob < 4 ? 128 : 256); u.nt = ob < 4 ? 2 : 4; return true; }
    __device__ __forceinline__ void a_ready(const Unit&) const {}
    __device__ __forceinline__ void done(const Unit&) const {}
};
struct BranchOrder {
    StaticOrder so;
    __host__ __device__ bool next(int i, Unit& u) const { if (!so.next(i >> 1, u)) return false; u.sel = i & 1; return true; }
    __device__ __forceinline__ void a_ready(const Unit&) const {}
    __device__ __forceinline__ void done(const Unit&) const {}
};
template <class Epi, class Sched, bool ALIGN_EPI = false, bool SP2 = false>
__device__ __forceinline__ void gemm_phase(PG8_LAS unsigned char* lds, const Gemm g, const Sched& S, const Epi& E) {
    int tid = threadIdx.x; asm volatile("" : "+v"(tid));
    const int wid = __builtin_amdgcn_readfirstlane(tid >> 6), lane = tid & 63, wr = wid >> 2, wc = wid & 3, fr = lane & 15, fq = lane >> 4;
    const int K = g.K, nt = K / BK;
    unsigned voffA[2], voffB[2];
#pragma unroll
    for (int i = 0; i < 2; ++i) { int R, C; stage_rc(tid * 16 + i * 8192, R, C); const int Rb = Epi::PERM ? ((R & ~31) + perm32(R & 31)) : R;
        voffA[i] = (unsigned)(R * K + C) * 2u; voffB[i] = (unsigned)(Rb * K + C) * 2u; }
    const size_t kstep = (size_t)(BK * 2);
    const size_t hstep = (size_t)HALF * K * 2;
    const size_t tstep = 2 * hstep;
    const unsigned ldsw = (unsigned)wid * 1024u;
    const int aoff = lds_byte(wr * 64 + fr, fq * 8), boff = lds_byte(wc * 32 + fr, fq * 8);
#define PG8_SA(b, h) (((b) * 2 + (h)) * HTB)
#define PG8_SB(b, h) ((4 + (b) * 2 + (h)) * HTB)
#define PG8_STAGE(bufoff, gbase, voff) do { _Pragma("unroll") for (int _i = 0; _i < 2; ++_i) \
        __builtin_amdgcn_global_load_lds((const unsigned*)((const char*)(gbase) + (voff)[_i]), (PG8_LAS unsigned*)(lds + (bufoff) + ldsw + _i * 8192), 16, 0, 0); } while (0)
#define PG8_LDA(dst, b, h) do { _Pragma("unroll") for (int m = 0; m < 4; ++m) _Pragma("unroll") for (int k = 0; k < 2; ++k) dst[m][k] = *(const PG8_LAS bf16x8*)(lds + PG8_SA(b, h) + aoff + m * 2048 + k * 1024); } while (0)
#define PG8_LDB(dst, b, h) do { _Pragma("unroll") for (int n = 0; n < 2; ++n) _Pragma("unroll") for (int k = 0; k < 2; ++k) dst[n][k] = *(const PG8_LAS bf16x8*)(lds + PG8_SB(b, h) + boff + n * 2048 + k * 1024); } while (0)
#define PG8_MMA(ai, bj, At, Bt) do { __builtin_amdgcn_s_setprio(1); _Pragma("unroll") for (int m = 0; m < 4; ++m) _Pragma("unroll") for (int n = 0; n < 2; ++n) _Pragma("unroll") for (int k = 0; k < 2; ++k) \
        acc[ai][bj][m][n] = __builtin_amdgcn_mfma_f32_16x16x32_bf16(Bt[n][k], At[m][k], acc[ai][bj][m][n], 0, 0, 0); __builtin_amdgcn_s_setprio(0); } while (0)
#define PG8_WAIT_V(n) asm volatile("s_waitcnt vmcnt(" #n ")" ::: "memory")
#define PG8_WAIT_L(n) asm volatile("s_waitcnt lgkmcnt(" #n ")" ::: "memory")
#define PG8_BAR __builtin_amdgcn_s_barrier()
#define PG8_SCHED __builtin_amdgcn_sched_barrier(0)
    Unit cur, nxt; int ui = 0;
    if (!S.next(0, cur)) return;
    f32x4 acc[2][2][4][2];
#pragma unroll
    for (int a = 0; a < 2; ++a)
#pragma unroll
        for (int b = 0; b < 2; ++b)
#pragma unroll
            for (int m = 0; m < 4; ++m)
#pragma unroll
                for (int n = 0; n < 2; ++n) acc[a][b][m][n] = (f32x4){0.f, 0.f, 0.f, 0.f};
    bf16x8 At[4][2], B0[2][2], B1[2][2];
    const char* cA = (const char*)(cur.sel ? g.A2 : g.A) + (size_t)cur.pm * tstep + (size_t)cur.kbeg * 2; const char* cB = (const char*)(cur.sel ? g.Bt2 : g.Bt) + (size_t)cur.pn * tstep + (size_t)cur.kbeg * 2;
    int nt_cur = cur.nt ? cur.nt : nt;
    S.a_ready(cur);
    if constexpr (SP2) {
        PG8_STAGE(PG8_SB(0, 0), cB, voffB); PG8_STAGE(PG8_SB(0, 1), cB + hstep, voffB); PG8_STAGE(PG8_SA(0, 0), cA, voffA); PG8_STAGE(PG8_SA(0, 1), cA + hstep, voffA);
        if (wr == 1) PG8_BAR;
        PG8_WAIT_V(2); PG8_BAR;
        PG8_STAGE(PG8_SB(1, 0), cB + kstep, voffB); PG8_STAGE(PG8_SA(1, 0), cA + kstep, voffA); PG8_STAGE(PG8_SB(1, 1), cB + hstep + kstep, voffB);
        PG8_WAIT_V(6); PG8_BAR;
    } else {
        PG8_STAGE(PG8_SB(0, 0), cB, voffB); PG8_STAGE(PG8_SA(0, 0), cA, voffA); PG8_STAGE(PG8_SB(0, 1), cB + hstep, voffB); PG8_STAGE(PG8_SA(0, 1), cA + hstep, voffA);
        if (wr == 1) PG8_BAR;
        PG8_WAIT_V(4); PG8_BAR;
        PG8_STAGE(PG8_SB(1, 0), cB + kstep, voffB); PG8_STAGE(PG8_SA(1, 0), cA + kstep, voffA); PG8_STAGE(PG8_SB(1, 1), cB + hstep + kstep, voffB);
        PG8_WAIT_V(6); PG8_BAR;
    }
    for (;;) {
        const bool has_next = S.next(ui + 1, nxt);
        const char* nA = has_next ? (const char*)(nxt.sel ? g.A2 : g.A) + (size_t)nxt.pm * tstep + (size_t)nxt.kbeg * 2 : cA; const char* nB = has_next ? (const char*)(nxt.sel ? g.Bt2 : g.Bt) + (size_t)nxt.pn * tstep + (size_t)nxt.kbeg * 2 : cB;
        for (int t = 0; t < nt_cur; t += 2) {
            const bool last = (t == nt_cur - 2);
            const char* a1 = cA + (size_t)(t + 1) * kstep;
            const char* a2 = last ? nA : cA + (size_t)(t + 2) * kstep; const char* b2 = last ? nB : cB + (size_t)(t + 2) * kstep;
            const char* a3 = a2 + kstep; const char* b3 = b2 + kstep;
            if (last && has_next) S.a_ready(nxt);
            if constexpr (SP2) {
            PG8_LDB(B0, 0, 0); PG8_LDB(B1, 0, 1); PG8_SCHED; PG8_LDA(At, 0, 0); PG8_STAGE(PG8_SA(1, 1), a1 + hstep, voffA);
            PG8_WAIT_V(8); PG8_WAIT_L(0); PG8_BAR; PG8_MMA(0, 0, At, B0); PG8_MMA(0, 1, At, B1); PG8_BAR; PG8_SCHED;
            PG8_LDA(At, 0, 1); PG8_STAGE(PG8_SB(0, 0), b2, voffB); PG8_STAGE(PG8_SB(0, 1), b2 + hstep, voffB); PG8_STAGE(PG8_SA(0, 0), a2, voffA);
            PG8_WAIT_V(8); PG8_WAIT_L(0); PG8_BAR; PG8_MMA(1, 0, At, B0); PG8_MMA(1, 1, At, B1); PG8_BAR; PG8_SCHED;
            PG8_LDB(B0, 1, 0); PG8_LDB(B1, 1, 1); PG8_SCHED; PG8_LDA(At, 1, 0); PG8_STAGE(PG8_SA(0, 1), a2 + hstep, voffA);
            PG8_WAIT_V(8); PG8_WAIT_L(0); PG8_BAR; PG8_MMA(0, 0, At, B0); PG8_MMA(0, 1, At, B1); PG8_BAR; PG8_SCHED;
            PG8_LDA(At, 1, 1); PG8_STAGE(PG8_SB(1, 0), b3, voffB); PG8_STAGE(PG8_SB(1, 1), b3 + hstep, voffB); PG8_STAGE(PG8_SA(1, 0), a3, voffA);
            PG8_WAIT_V(8); PG8_WAIT_L(0); PG8_BAR; PG8_MMA(1, 0, At, B0); PG8_MMA(1, 1, At, B1); PG8_BAR; PG8_SCHED;
            } else {
            PG8_LDB(B0, 0, 0); PG8_SCHED; PG8_LDA(At, 0, 0); PG8_STAGE(PG8_SA(1, 1), a1 + hstep, voffA);
            PG8_WAIT_L(8); PG8_BAR; PG8_WAIT_L(0); PG8_MMA(0, 0, At, B0); PG8_BAR; PG8_SCHED;
            PG8_LDB(B1, 0, 1); PG8_STAGE(PG8_SB(0, 0), b2, voffB);
            PG8_BAR; PG8_WAIT_L(0); PG8_MMA(0, 1, At, B1); PG8_BAR;
            PG8_LDA(At, 0, 1); PG8_STAGE(PG8_SA(0, 0), a2, voffA);
            PG8_BAR; PG8_WAIT_L(0); PG8_MMA(1, 0, At, B0); PG8_BAR; PG8_SCHED;
            PG8_STAGE(PG8_SB(0, 1), b2 + hstep, voffB);
            PG8_WAIT_V(6); PG8_BAR; PG8_MMA(1, 1, At, B1); PG8_BAR;
            PG8_LDB(B0, 1, 0); PG8_SCHED; PG8_LDA(At, 1, 0); PG8_STAGE(PG8_SA(0, 1), a2 + hstep, voffA);
            PG8_WAIT_L(8); PG8_BAR; PG8_WAIT_L(0); PG8_MMA(0, 0, At, B0); PG8_BAR; PG8_SCHED;
            PG8_LDB(B1, 1, 1); PG8_STAGE(PG8_SB(1, 0), b3, voffB);
            PG8_BAR; PG8_WAIT_L(0); PG8_MMA(0, 1, At, B1); PG8_BAR;
            PG8_LDA(At, 1, 1); PG8_STAGE(PG8_SA(1, 0), a3, voffA);
            PG8_BAR; PG8_WAIT_L(0); PG8_MMA(1, 0, At, B0); PG8_BAR; PG8_SCHED;
            PG8_STAGE(PG8_SB(1, 1), b3 + hstep, voffB);
            PG8_WAIT_V(6); PG8_BAR; PG8_MMA(1, 1, At, B1); PG8_BAR;
            }
        }
        if constexpr (ALIGN_EPI) { if (wr == 0) PG8_BAR; }
        if constexpr (!Epi::AFTER_DRAIN) { E(acc, cur, wr, wc, fr, fq); S.done(cur); }
        if (!has_next) break;
#pragma unroll
        for (int a = 0; a < 2; ++a)
#pragma unroll
            for (int b = 0; b < 2; ++b)
#pragma unroll
                for (int m = 0; m < 4; ++m)
#pragma unroll
                    for (int n = 0; n < 2; ++n) acc[a][b][m][n] = (f32x4){0.f, 0.f, 0.f, 0.f};
        cur = nxt; cA = nA; cB = nB; ++ui; nt_cur = cur.nt ? cur.nt : nt;
        if constexpr (ALIGN_EPI) { if (wr == 1) PG8_BAR; }
    }
    PG8_WAIT_V(0);
    if constexpr (!ALIGN_EPI) { if (wr == 0) PG8_BAR; }
    PG8_BAR;
    if constexpr (Epi::AFTER_DRAIN) { E.fused(acc, cur, wr, wc, fr, fq, lds, wid, lane); S.done(cur); }
#undef PG8_SA
#undef PG8_SB
#undef PG8_STAGE
#undef PG8_LDA
#undef PG8_LDB
#undef PG8_MMA
#undef PG8_WAIT_V
#undef PG8_WAIT_L
#undef PG8_BAR
#undef PG8_SCHED
}
}

#include <hip/hip_bf16.h>
#include <cmath>
namespace attn_body {
using bf16=__hip_bfloat16;
using bf16x8=__attribute__((ext_vector_type(8)))short;
using s16x4=__attribute__((ext_vector_type(4)))short;
using f32x16=__attribute__((ext_vector_type(16)))float;
using u32x4=__attribute__((ext_vector_type(4)))unsigned;
constexpr int BATCH=4,NHEAD=16,SEQ=2048,D=64,DM=NHEAD*D,OPITCH=2048;
constexpr int NW=8,QBLK=32,QB=QBLK*NW,KVBLK=64,NQB=SEQ/QB;
constexpr int ATTN_PITCH=DM, ATTN_UNIT_ROWS=QB;
__device__ __forceinline__ int crow(int r,int hi){return (r&3)+8*(r>>2)+4*hi;}
#define SBAR() __builtin_amdgcn_sched_barrier(0)
__device__ __forceinline__ void cmask(f32x16&p0,f32x16&p1,int jb,int qrel,int hi){
  const float NEG=-INFINITY; int kb=64*jb+4*hi;
  #pragma unroll
  for(int r=0;r<16;++r){int kv=kb+(r&3)+8*(r>>2); if(kv>qrel)p0[r]=NEG; if(kv+32>qrel)p1[r]=NEG;}
}

constexpr int NSLOT=3, SLOTB=8192;
constexpr int LDS_K=0, LDS_V=NSLOT*SLOTB, LDS_WS=2*NSLOT*SLOTB, LDS_OST=LDS_WS+NW*64*4, LDS_BYTES=LDS_OST+NW*4096;
constexpr float C2=0.125f*1.4426950408889634f;
__device__ __forceinline__ void glds16(const void*gsrc,unsigned lds_dst){unsigned keep;
  asm volatile("s_mov_b32 %0, m0\n\ts_mov_b32 m0, %2\n\ts_nop 0\n\tglobal_load_lds_dwordx4 %1, off\n\ts_mov_b32 m0, %0":"=&s"(keep):"v"(gsrc),"s"(lds_dst):"memory");}
__device__ __forceinline__ float max3f(float a,float b,float c){float r;asm("v_max3_f32 %0, %1, %2, %3":"=v"(r):"v"(a),"v"(b),"v"(c));return r;}
__device__ __forceinline__ float max2f(float a,float b){float r;asm("v_max_f32_e32 %0, %1, %2":"=v"(r):"v"(a),"v"(b));return r;}
__device__ __forceinline__ float fadd_s(float a,float b){float r;asm("v_add_f32_e32 %0, %1, %2":"=v"(r):"v"(a),"v"(b));return r;}
__device__ __forceinline__ float fsub_s(float a,float b){float r;asm("v_sub_f32_e32 %0, %1, %2":"=v"(r):"v"(a),"v"(b));return r;}
typedef float f32x2_t __attribute__((ext_vector_type(2))); typedef __bf16 bf16x2_t __attribute__((ext_vector_type(2)));
__device__ __forceinline__ unsigned cvtpk_s(float lo,float hi){f32x2_t v={lo,hi};bf16x2_t b=__builtin_convertvector(v,bf16x2_t);return __builtin_bit_cast(unsigned,b);}
#define WAIT_BAR(N) asm volatile("s_waitcnt vmcnt(" #N ") lgkmcnt(0)\n\ts_barrier":::"memory")

__device__ __forceinline__ void qkt(f32x16&p0,f32x16&p1,const char*Kslot,const bf16x8*qr,const f32x16&negm,int r32,int hi){
  const char*kb=Kslot+hi*1024+r32*16;
  #pragma unroll
  for(int d0=0;d0<4;++d0){
    const bf16x8 b0=*reinterpret_cast<const bf16x8*>(kb+d0*2048);
    const bf16x8 b1=*reinterpret_cast<const bf16x8*>(kb+d0*2048+512);
    if(d0==0){p0=__builtin_amdgcn_mfma_f32_32x32x16_bf16(b0,qr[0],negm,0,0,0);p1=__builtin_amdgcn_mfma_f32_32x32x16_bf16(b1,qr[0],negm,0,0,0);}
    else{p0=__builtin_amdgcn_mfma_f32_32x32x16_bf16(b0,qr[d0],p0,0,0,0);p1=__builtin_amdgcn_mfma_f32_32x32x16_bf16(b1,qr[d0],p1,0,0,0);}}
}
typedef __attribute__((address_space(3))) const char* lds_cptr;
typedef short v4i16_t __attribute__((ext_vector_type(4)));
__device__ __forceinline__ void kload8(bf16x8*kf,lds_cptr kp){
  kf[0]=*(const __attribute__((address_space(3))) bf16x8*)(kp);      kf[1]=*(const __attribute__((address_space(3))) bf16x8*)(kp+512);
  kf[2]=*(const __attribute__((address_space(3))) bf16x8*)(kp+2048); kf[3]=*(const __attribute__((address_space(3))) bf16x8*)(kp+2560);
  kf[4]=*(const __attribute__((address_space(3))) bf16x8*)(kp+4096); kf[5]=*(const __attribute__((address_space(3))) bf16x8*)(kp+4608);
  kf[6]=*(const __attribute__((address_space(3))) bf16x8*)(kp+6144); kf[7]=*(const __attribute__((address_space(3))) bf16x8*)(kp+6656);
}
__device__ __forceinline__ void kload2(bf16x8*kf,lds_cptr kp,int j){ kf[2*j]=*(const __attribute__((address_space(3))) bf16x8*)(kp+j*2048); kf[2*j+1]=*(const __attribute__((address_space(3))) bf16x8*)(kp+j*2048+512); }
__device__ __forceinline__ s16x4 vtr(lds_cptr p){ return __builtin_bit_cast(s16x4,__builtin_amdgcn_ds_read_tr16_b64_v4i16((__attribute__((address_space(3))) v4i16_t*)p)); }
__device__ __forceinline__ float rowmax(const f32x16&p0,const f32x16&p1){
  float a=max3f(p0[0],p0[1],p1[0]),b=max3f(p0[2],p0[3],p1[1]);a=max3f(a,p1[2],p1[3]);
  #pragma unroll
  for(int r=4;r<16;r+=4){a=max3f(a,p0[r],p0[r+1]);b=max3f(b,p0[r+2],p0[r+3]);a=max3f(a,p1[r],p1[r+1]);b=max3f(b,p1[r+2],p1[r+3]);}
  const float m=max2f(a,b);
  auto rr=__builtin_amdgcn_permlane32_swap(__float_as_uint(m),__float_as_uint(m),false,false);
  return max2f(__uint_as_float(rr[0]),__uint_as_float(rr[1]));
}
__device__ __forceinline__ void pv(f32x16*o,int vb,bf16x8 pa0,bf16x8 pa1,bf16x8 pa2,bf16x8 pa3){
  #pragma unroll
  for(int d0=0;d0<2;++d0){s16x4 lo[4],hi[4];
    #pragma unroll
    for(int ks=0;ks<4;++ks){
      asm volatile("ds_read_b64_tr_b16 %0,%1 offset:%c2":"=&v"(lo[ks]):"v"(vb),"i"(d0*4096+ks*1024):"memory");
      asm volatile("ds_read_b64_tr_b16 %0,%1 offset:%c2":"=&v"(hi[ks]):"v"(vb),"i"(d0*4096+ks*1024+512):"memory");}
    asm volatile("s_waitcnt lgkmcnt(0)":::"memory");SBAR();
    #define PK(k) (bf16x8){lo[k][0],lo[k][1],lo[k][2],lo[k][3],hi[k][0],hi[k][1],hi[k][2],hi[k][3]}
    o[d0]=__builtin_amdgcn_mfma_f32_32x32x16_bf16(pa0,PK(0),o[d0],0,0,0);
    o[d0]=__builtin_amdgcn_mfma_f32_32x32x16_bf16(pa1,PK(1),o[d0],0,0,0);
    o[d0]=__builtin_amdgcn_mfma_f32_32x32x16_bf16(pa2,PK(2),o[d0],0,0,0);
    o[d0]=__builtin_amdgcn_mfma_f32_32x32x16_bf16(pa3,PK(3),o[d0],0,0,0);
    #undef PK
  }
}

#ifndef ATTN_STORE16
#define ATTN_STORE16(p,v) (*(u32x4*)(p)=(v))
#endif
template<int THRL> __device__ __forceinline__ void attn_unit(int b,int h,int vcol,int ocol,int qb,const bf16*Q,const bf16*__restrict__ K,const bf16*__restrict__ V,bf16*O,char*shm){
  int tid=threadIdx.x; asm volatile("":"+v"(tid)); const int lane=tid&63,r32=lane&31,hi=lane>>5; const int wid=__builtin_amdgcn_readfirstlane(tid>>6);
  const long rowbase=(long)b*SEQ; const int q0=qb*QB;
  const bf16*Qw=Q+(rowbase+q0+wid*QBLK)*DM+h*D;
  const bf16*Kh=K+rowbase*DM+h*D,*Vh=V+rowbase*DM+vcol;
  const unsigned lds0=(unsigned)(uintptr_t)shm;
  float*wsf=(float*)(shm+LDS_WS)+wid*64;
  const bf16*ksrc=Kh+(long)lane*DM+wid*8;
  const bf16*vsrc=Vh+(long)(16*(wid&3)+(lane>>2))*DM+(wid>>2)*32+(lane&3)*8;
  const unsigned kdst=lds0+LDS_K+wid*1024, vdst=lds0+LDS_V+wid*1024;
  #define DMA_K(t,slot) glds16(ksrc+(long)(t)*KVBLK*DM,(unsigned)__builtin_amdgcn_readfirstlane(kdst+(slot)))
  #define DMA_V(t,slot) glds16(vsrc+(long)(t)*KVBLK*DM,(unsigned)__builtin_amdgcn_readfirstlane(vdst+(slot)))
  const int vb0=(int)(lds0+LDS_V)+((lane>>4)&1)*32+(lane&3)*8+(4*hi+((lane&15)>>2))*64;
  const char*Kbase=shm+LDS_K; bf16x8 kf[8];
  const lds_cptr shm3=(lds_cptr)shm; const lds_cptr kp0=shm3+LDS_K+hi*1024+r32*16; const lds_cptr vp0=shm3+LDS_V+((lane>>4)&1)*32+(lane&3)*8+(4*hi+((lane&15)>>2))*64;
  const int NT=SEQ/KVBLK;
  DMA_K(0,0);DMA_V(0,0);DMA_K(1,SLOTB);
  bf16x8 qr[4];
  #pragma unroll
  for(int d0=0;d0<4;++d0)qr[d0]=*reinterpret_cast<const bf16x8*>(&Qw[(long)r32*DM+d0*16+hi*8]);
  float mhat=0.f,l_reg=0.f;f32x16 o[2];o[0]=f32x16{};o[1]=f32x16{};f32x16 negm=f32x16{};asm volatile("":"+v"(negm));
  const int qrel=wid*QBLK+r32;
  #define CMASK(P0,P1,t) do{}while(0)
  bool resc=false;
  #define START(P0,P1) do{ const float rm=rowmax(P0,P1); resc=false; \
    { const float dl=rm; mhat=fadd_s(mhat,dl); \
      _Pragma("unroll") for(int r=0;r<16;++r){P0[r]=fsub_s(P0[r],dl);P1[r]=fsub_s(P1[r],dl);} \
      _Pragma("unroll") for(int r=0;r<16;++r)negm[r]=-mhat; asm volatile("":"+v"(negm)); } \
    _Pragma("unroll") for(int r=0;r<16;++r)P0[r]=__builtin_amdgcn_exp2f(P0[r]); }while(0)
  #define RESC() do{ if(resc){ asm volatile("s_waitcnt lgkmcnt(0)":::"memory"); \
      _Pragma("unroll") for(int d_=0;d_<2;++d_) _Pragma("unroll") for(int r=0;r<16;++r)o[d_][r]*=wsf[crow(r,hi)]; } }while(0)
  f32x16 pA0,pA1,pB0,pB1;
  int sl_prev=0,sl_cur=0,sl_next=SLOTB;
  #define ROT() do{sl_prev=sl_cur;sl_cur=sl_next;sl_next=(sl_next==(NSLOT-1)*SLOTB)?0:sl_next+SLOTB;}while(0)
  DMA_K(2,2*SLOTB);
  WAIT_BAR(3);
  qkt(pA0,pA1,Kbase,qr,negm,r32,hi);asm volatile("s_nop 15\n\ts_nop 7":"+v"(pA0),"+v"(pA1));CMASK(pA0,pA1,0);
  START(pA0,pA1);
  _Pragma("unroll") for(int r=0;r<16;++r)pA1[r]=__builtin_amdgcn_exp2f(pA1[r]);
  WAIT_BAR(0);
  DMA_K(3,0);DMA_V(1,SLOTB);
  ROT();
  kload8(kf,kp0+sl_cur);
  WAIT_BAR(2);
  s16x4 vlo[8],vhi[8]; u32x4 pw0,pw1,pw2,pw3;
  #define PKW(P,B) cvtpk_s(P[B],P[B+1])
  #define PAF(k) __builtin_bit_cast(bf16x8,pw##k)
  #define VFR(i) (bf16x8){vlo[i][0],vlo[i][1],vlo[i][2],vlo[i][3],vhi[i][0],vhi[i][1],vhi[i][2],vhi[i][3]}
  #define PIN(x) asm volatile("":"+v"(x))
  #define MX3(a,b,c) __builtin_fmaxf(__builtin_fmaxf((a),(b)),(c))
  #define GAPA(MF,A0,A1,A2,A3,W0,W1,PW) do{ MF; sacc+=A0; sacc+=A1; sacc+=A2; sacc+=A3; PIN(sacc); W0; W1; PIN(PW); SBAR(); }while(0)
  #define EX(v) __builtin_amdgcn_exp2f(v)
  #define GAPB(MF,X,B) do{ MF; X[B]=EX(X[B]); X[B+1]=EX(X[B+1]); X[B+2]=EX(X[B+2]); X[B+3]=EX(X[B+3]); PIN(X); SBAR(); }while(0)
  #define VRD(i) do{ vlo[i]=vtr(vp_+(((i)>>2)*4096+((i)&3)*1024)); vhi[i]=vtr(vp_+(((i)>>2)*4096+((i)&3)*1024+512)); }while(0)
  #define KRD(G,j) do{ if(G){ kload2(kf,kp0+sl_next,j); SBAR(); } }while(0)
  #define STEP(C0,C1,P0,P1,t,GK,GV,GL) do{ SBAR(); \
    const lds_cptr vp_=vp0+sl_prev; \
    VRD(0); SBAR(); float sacc=(P0[0]+P0[1]); \
    GAPA(C0=__builtin_amdgcn_mfma_f32_32x32x16_bf16(kf[0],qr[0],negm,0,0,0), P0[2],P0[3],P0[4],P0[5],     pw0[0]=PKW(P0,0), pw0[1]=PKW(P0,2), pw0); \
    VRD(4); SBAR(); GAPA(C1=__builtin_amdgcn_mfma_f32_32x32x16_bf16(kf[1],qr[0],negm,0,0,0), P0[6],P0[7],P0[8],P0[9],     pw0[2]=PKW(P0,4), pw0[3]=PKW(P0,6), pw0); \
    VRD(1); SBAR(); GAPA(C0=__builtin_amdgcn_mfma_f32_32x32x16_bf16(kf[2],qr[1],C0,0,0,0),   P0[10],P0[11],P0[12],P0[13], pw1[0]=PKW(P0,8), pw1[1]=PKW(P0,10), pw1); \
    VRD(5); SBAR(); GAPA(C1=__builtin_amdgcn_mfma_f32_32x32x16_bf16(kf[3],qr[1],C1,0,0,0),   P0[14],P0[15],P1[0],P1[1],   pw1[2]=PKW(P0,12),pw1[3]=PKW(P0,14), pw1); \
    VRD(2); SBAR(); GAPA(C0=__builtin_amdgcn_mfma_f32_32x32x16_bf16(kf[4],qr[2],C0,0,0,0),   P1[2],P1[3],P1[4],P1[5],     pw2[0]=PKW(P1,0), pw2[1]=PKW(P1,2), pw2); \
    VRD(6); SBAR(); GAPA(C1=__builtin_amdgcn_mfma_f32_32x32x16_bf16(kf[5],qr[2],C1,0,0,0),   P1[6],P1[7],P1[8],P1[9],     pw2[2]=PKW(P1,4), pw2[3]=PKW(P1,6), pw2); \
    VRD(3); SBAR(); GAPA(C0=__builtin_amdgcn_mfma_f32_32x32x16_bf16(kf[6],qr[3],C0,0,0,0),   P1[10],P1[11],P1[12],P1[13], pw3[0]=PKW(P1,8), pw3[1]=PKW(P1,10), pw3); \
    VRD(7); SBAR(); GAPA(C1=__builtin_amdgcn_mfma_f32_32x32x16_bf16(kf[7],qr[3],C1,0,0,0),   P1[14],P1[15],0.f,0.f,       pw3[2]=PKW(P1,12),pw3[3]=PKW(P1,14), pw3); \
    l_reg+=sacc; \
    if(GK){DMA_K((t)+3,sl_cur);} if(GV){DMA_V((t)+1,sl_next);} \
    CMASK(C0,C1,t); \
    { float a=MX3(C0[0],C0[1],C1[0]),b=MX3(C0[2],C0[3],C1[1]); a=MX3(a,C1[2],C1[3]); \
      _Pragma("unroll") for(int r=4;r<16;r+=4){a=MX3(a,C0[r],C0[r+1]);b=MX3(b,C0[r+2],C0[r+3]);a=MX3(a,C1[r],C1[r+1]);b=MX3(b,C1[r+2],C1[r+3]);} \
      float rm=__builtin_fmaxf(a,b); { auto rr=__builtin_amdgcn_permlane32_swap(__float_as_uint(rm),__float_as_uint(rm),false,false); rm=__builtin_fmaxf(__uint_as_float(rr[0]),__uint_as_float(rr[1])); } \
      resc=false; \
      if(__builtin_expect(__any(rm>(float)THRL),0)){ const float dl=__builtin_fmaxf(rm,0.f); mhat+=dl; \
        _Pragma("unroll") for(int r=0;r<16;++r){C0[r]-=dl;C1[r]-=dl;} \
        _Pragma("unroll") for(int r=0;r<16;++r)negm[r]=-mhat; asm volatile("":"+v"(negm)); \
        const float f=__builtin_amdgcn_exp2f(-dl); l_reg*=f; if(hi==0)wsf[r32]=f; resc=true; } } \
    SBAR(); \
    GAPB(o[0]=__builtin_amdgcn_mfma_f32_32x32x16_bf16(PAF(0),VFR(0),o[0],0,0,0), C0,0); \
    GAPB(o[1]=__builtin_amdgcn_mfma_f32_32x32x16_bf16(PAF(0),VFR(4),o[1],0,0,0), C0,4); \
    KRD(GL,0); GAPB(o[0]=__builtin_amdgcn_mfma_f32_32x32x16_bf16(PAF(1),VFR(1),o[0],0,0,0), C0,8); \
    KRD(GL,1); GAPB(o[1]=__builtin_amdgcn_mfma_f32_32x32x16_bf16(PAF(1),VFR(5),o[1],0,0,0), C0,12); \
    KRD(GL,2); GAPB(o[0]=__builtin_amdgcn_mfma_f32_32x32x16_bf16(PAF(2),VFR(2),o[0],0,0,0), C1,0); \
    KRD(GL,3); GAPB(o[1]=__builtin_amdgcn_mfma_f32_32x32x16_bf16(PAF(2),VFR(6),o[1],0,0,0), C1,4); \
    GAPB(o[0]=__builtin_amdgcn_mfma_f32_32x32x16_bf16(PAF(3),VFR(3),o[0],0,0,0), C1,8); \
    GAPB(o[1]=__builtin_amdgcn_mfma_f32_32x32x16_bf16(PAF(3),VFR(7),o[1],0,0,0), C1,12); \
    }while(0)
  int t=1;
  #undef CMASK
  #define CMASK(P0,P1,t) do{}while(0)
  for(;t+5<NT;t+=2){
    STEP(pB0,pB1,pA0,pA1,t,true,true,true);     WAIT_BAR(2); RESC(); ROT();
    STEP(pA0,pA1,pB0,pB1,t+1,true,true,true);   WAIT_BAR(2); RESC(); ROT();
  }
  #undef CMASK
  #define CMASK(P0,P1,t) do{}while(0)
  #define ENDW(tt) do{ if((tt)+3<NT){WAIT_BAR(2);} else if((tt)+2<NT){WAIT_BAR(1);} else {WAIT_BAR(0);} }while(0)
  for(;t+1<NT;t+=2){
    STEP(pB0,pB1,pA0,pA1,t,(t+3<NT),(t+1<NT),(t+1<NT));       ENDW(t);   RESC(); ROT();
    STEP(pA0,pA1,pB0,pB1,t+1,(t+4<NT),(t+2<NT),(t+2<NT));     ENDW(t+1); RESC(); ROT();
  }
  STEP(pB0,pB1,pA0,pA1,NT-1,false,false,false); RESC();
  { float sacc=pB0[0]+pB0[1]; _Pragma("unroll") for(int r=2;r<16;++r)sacc+=pB0[r]; _Pragma("unroll") for(int r=0;r<16;++r)sacc+=pB1[r]; l_reg+=sacc;
    pw0=(u32x4){PKW(pB0,0),PKW(pB0,2),PKW(pB0,4),PKW(pB0,6)};pw1=(u32x4){PKW(pB0,8),PKW(pB0,10),PKW(pB0,12),PKW(pB0,14)};pw2=(u32x4){PKW(pB1,0),PKW(pB1,2),PKW(pB1,4),PKW(pB1,6)};pw3=(u32x4){PKW(pB1,8),PKW(pB1,10),PKW(pB1,12),PKW(pB1,14)};
    SBAR(); pv(o,vb0+sl_cur,PAF(0),PAF(1),PAF(2),PAF(3)); }
  #undef PKW
  #undef PAF
  #undef VFR
  #undef PIN
  #undef MX3
  #undef GAPA
  #undef GAPB
  #undef EX
  #undef VRD
  #undef KRD
  #undef STEP
  #undef ENDW
  {auto rr=__builtin_amdgcn_permlane32_swap(__float_as_uint(l_reg),__float_as_uint(l_reg),false,false);l_reg=__uint_as_float(rr[0])+__uint_as_float(rr[1]);}
  if(hi==0)wsf[32+r32]=l_reg;asm volatile("s_waitcnt lgkmcnt(0)":::"memory");
  float rli[16];
  #pragma unroll
  for(int r=0;r<16;++r)rli[r]=__builtin_amdgcn_rcpf(wsf[32+crow(r,hi)]);
  bf16*Ow=O+(rowbase+q0+wid*QBLK)*OPITCH+ocol;
  { bf16*stg=(bf16*)(shm+LDS_OST)+wid*2048;
    #pragma unroll
    for(int r=0;r<16;++r){const int orow=crow(r,hi);
      #pragma unroll
      for(int d0=0;d0<2;++d0)stg[orow*64+d0*32+r32]=__float2bfloat16(o[d0][r]*rli[r]);}
    asm volatile("s_waitcnt lgkmcnt(0)":::"memory");
    #pragma unroll
    for(int i=0;i<4;++i){const int row=i*8+(lane>>3),ch=lane&7; const u32x4 v=*(const u32x4*)(stg+row*64+ch*8); ATTN_STORE16(Ow+(long)row*OPITCH+ch*8,v);} }
  asm volatile("s_waitcnt lgkmcnt(0)\n\ts_barrier":::"memory");
  #undef DMA_K
  #undef DMA_V
  #undef CMASK
  #undef START
  #undef RESC
  #undef ROT
}
constexpr int ATTN_LDS_BYTES=LDS_BYTES;
#undef SBAR
#undef WAIT_BAR
}

#define GAS __attribute__((address_space(1)))
#define LAS __attribute__((address_space(3)))
typedef unsigned short bf16;
typedef unsigned v4u __attribute__((ext_vector_type(4)));
typedef float f32x4 __attribute__((ext_vector_type(4)));
typedef short bf16x8 __attribute__((ext_vector_type(8)));
typedef GAS unsigned gu32;
typedef GAS unsigned long long gu64;
#define RLX_AGENT __ATOMIC_RELAXED, __HIP_MEMORY_SCOPE_AGENT
#define LDS_WAIT() asm volatile("s_waitcnt lgkmcnt(0)" ::: "memory")
#define VM_WAIT() asm volatile("s_waitcnt vmcnt(0)" ::: "memory")
__device__ __forceinline__ unsigned long long rt() { return __builtin_amdgcn_s_memrealtime(); }
__device__ __forceinline__ unsigned f2bf(float f) { unsigned u = __builtin_bit_cast(unsigned, f); return (u + 0x7fffu + ((u >> 16) & 1u)) >> 16; }
__device__ __forceinline__ unsigned pk2(float lo, float hi) { return f2bf(lo) | (f2bf(hi) << 16); }

#define XB_TMO      128
#define XB_XCNT(j)  (256  + 64 * (j))
#define XB_XSUB(j)  (1280 + 64 * (j))
#define XB_XGEN(j)  (2304 + 64 * (j))
#define XB_TOP      3328
#define XB_TOPGEN   3392
#define XCD_BAR_WORDS 3456
#define XB_SPIN_CAP (1u << 18)

__device__ __forceinline__ unsigned xb_ld(unsigned* p)              { return __hip_atomic_load(p, __ATOMIC_RELAXED, __HIP_MEMORY_SCOPE_AGENT); }
__device__ __forceinline__ unsigned xb_add(unsigned* p, unsigned v) { return __hip_atomic_fetch_add(p, v, __ATOMIC_RELAXED, __HIP_MEMORY_SCOPE_AGENT); }
__device__ __forceinline__ unsigned xb_xcc_id() { return (unsigned)__builtin_amdgcn_s_getreg((3 << 11) | 20) & 0xFu; }
#define XB_SPIN(cond, bar) do { unsigned _sp = 0; while (cond) { __builtin_amdgcn_s_sleep(1); \
    if ((++_sp & 255u) == 0u) { if (xb_ld(&(bar)[XB_TMO])) break; if (_sp > XB_SPIN_CAP) { atomicAdd(&(bar)[XB_TMO], 1u); break; } } } } while (0)

struct XcdBarrier {
    unsigned* bar; unsigned x;
    volatile LAS unsigned* st;
};

__device__ __forceinline__ XcdBarrier xcd_barrier_post(unsigned* bar, volatile LAS unsigned* st) {
    XcdBarrier b; b.bar = bar; b.x = xb_xcc_id(); b.st = st;
    if (threadIdx.x == 0) (void)xb_add(&bar[XB_XCNT(b.x)], 1u);
    return b;
}
__device__ __forceinline__ void xcd_barrier_complete(unsigned* bar, unsigned x, unsigned& nloc, unsigned& nx) {
    const unsigned G = gridDim.x * gridDim.y * gridDim.z;
    unsigned sum, cnt, mine, sp = 0u;
    for (;;) {
        sum = 0u; cnt = 0u; mine = 0u;
#pragma unroll
        for (unsigned j = 0; j < 16; ++j) { const unsigned c = xb_ld(&bar[XB_XCNT(j)]); sum += c; cnt += (c > 0u) ? 1u : 0u; mine = (j == x) ? c : mine; }
        if (sum == G) break;
        __builtin_amdgcn_s_sleep(1);
        if ((++sp & 255u) == 0u) { if (xb_ld(&bar[XB_TMO])) break; if (sp > XB_SPIN_CAP) { atomicAdd(&bar[XB_TMO], 1u); break; } }
    }
    nloc = mine > 0u ? mine : 1u; nx = cnt > 0u ? cnt : 1u;
}

__device__ __forceinline__ void xcd_barrier(const XcdBarrier& b) {
    asm volatile("s_waitcnt vmcnt(0)" ::: "memory");
    __syncthreads();
    if (threadIdx.x == 0) {
        unsigned* bar = b.bar;
        __builtin_amdgcn_s_waitcnt(0);
        unsigned nloc = b.st[0], nx = b.st[1];
        if (nloc == 0u) { xcd_barrier_complete(bar, b.x, nloc, nx); b.st[0] = nloc; b.st[1] = nx; }
        const unsigned old = xb_add(&bar[XB_XSUB(b.x)], 1u);
        const unsigned gen = old / nloc;
        if (old + 1u == (gen + 1u) * nloc) {
            __builtin_amdgcn_fence(__ATOMIC_RELEASE, "agent");
            asm volatile("s_waitcnt vmcnt(0)" ::: "memory");
            const unsigned og = xb_add(&bar[XB_TOP], 1u);
            const unsigned tg = og / nx;
            if (og + 1u == (tg + 1u) * nx) xb_add(&bar[XB_TOPGEN], 1u);
            else XB_SPIN(xb_ld(&bar[XB_TOPGEN]) == tg, bar);
            __builtin_amdgcn_fence(__ATOMIC_ACQUIRE, "agent");
            xb_add(&bar[XB_XGEN(b.x)], 1u);
            asm volatile("s_waitcnt vmcnt(0)" ::: "memory");
        } else {
            XB_SPIN(xb_ld(&bar[XB_XGEN(b.x)]) == gen, bar);
            __builtin_amdgcn_fence(__ATOMIC_ACQUIRE, "agent");
            asm volatile("s_waitcnt vmcnt(0)" ::: "memory");
        }
    }
    __syncthreads();
}


#ifndef NO_HIDE_CONV
#define HIDE_CONV 1
#endif
constexpr int NWAVES = 8;
constexpr int BATCH = 4, T = 2048, D = 2048, M = BATCH * T, FF = 5632, NGU = 2 * FF;
constexpr int RWC = 3072, IN_COLS = 10656, IN_PAD = 10752, NLORA = 5120, KLORA = 512;
constexpr float NORM_EPS = 1e-6f, GN_EPS = 64e-5f, SUBLN_EPS = 1e-5f, LAM_INIT = 0.2f;
constexpr float QSCALE = 0.125f * 1.4426950408889634f;

constexpr size_t MiB = 1u << 20;
constexpr size_t WS_CTL = 0, CTL_ZERO_BYTES = 1 * MiB;
constexpr size_t WS_ROPE = 1 * MiB;
constexpr size_t WS_WGU = 2 * MiB;
constexpr size_t WS_WDN = 46 * MiB;
constexpr size_t WS_WIN = 68 * MiB;
constexpr size_t WS_WA = 110 * MiB, WS_WB = 114 * MiB;
constexpr size_t WS_WOUT = 118 * MiB;
constexpr size_t WS_WLORA = 126 * MiB;
constexpr size_t WS_XN = 131 * MiB;
constexpr size_t WS_F = 163 * MiB;
constexpr size_t WS_ACT = 227 * MiB;
constexpr size_t WS_RW = 227 * MiB;
constexpr size_t WS_Q = 275 * MiB, WS_K = 291 * MiB, WS_V = 307 * MiB;
constexpr size_t WS_Y = 275 * MiB;
constexpr size_t WS_GATES = 323 * MiB;
constexpr size_t WS_LR = 387 * MiB;
constexpr size_t WS_G = 387 * MiB;
constexpr size_t WS_LA = 403 * MiB;
constexpr size_t WS_OATT = 411 * MiB;
constexpr size_t WS_END = 443 * MiB;
constexpr int CW_BAR = 4096;

constexpr int RING_OFF = 0, RING_BYTES = 131072;
constexpr int LDSCTL_OFF = RING_BYTES, MISC_OFF = LDSCTL_OFF + 320;
constexpr int LDS_BYTES = 147456;

struct Args { const float* in[32]; float* out; unsigned char* ws; int ph_lo, ph_hi, li, pad; };

__device__ __forceinline__ float wave_sum(float v) {
#pragma unroll
    for (int o = 1; o < 64; o <<= 1) v += __shfl_xor(v, o);
    return v;
}
template <int CTRL> __device__ __forceinline__ float dppf(float x) { return __builtin_bit_cast(float, __builtin_amdgcn_mov_dpp(__builtin_bit_cast(int, x), CTRL, 0xf, 0xf, true)); }
__device__ __forceinline__ float red8(float x) { x += dppf<0xB1>(x); x += dppf<0x4E>(x); x += dppf<0x141>(x); return x; }
__device__ __forceinline__ float red16(float x) { x = red8(x); x += dppf<0x128>(x); return x; }
__device__ __forceinline__ float bf2f(unsigned short h) { return __uint_as_float((unsigned)h << 16); }
__device__ __forceinline__ float bfsel(unsigned w, int lane) { return __uint_as_float((lane & 1) ? (w & 0xffff0000u) : (w << 16)); }
__device__ __forceinline__ float sigm_(float x) { return __builtin_amdgcn_rcpf(1.0f + __builtin_amdgcn_exp2f(-1.4426950408889634f * x)); }
typedef unsigned u32x2 __attribute__((ext_vector_type(2)));
__device__ __forceinline__ f32x4 unpk4(const u32x2 w) { return (f32x4){__uint_as_float(w.x << 16), __uint_as_float(w.x & 0xffff0000u), __uint_as_float(w.y << 16), __uint_as_float(w.y & 0xffff0000u)}; }

__device__ __forceinline__ void transpose_item(const float* W, int K, int N, bf16* WT, int k0, int n0, int drow0, LAS float* scr, int lane) {
#pragma unroll 8
    for (int i = 0; i < 32; ++i) { const int kk = 2 * i + (lane >> 5); scr[kk * 33 + (lane & 31)] = __builtin_nontemporal_load(&W[(size_t)(k0 + kk) * N + n0 + (lane & 31)]); }
    LDS_WAIT(); asm volatile("" ::: "memory");
    const int c = lane & 7;
#pragma unroll
    for (int j = 0; j < 4; ++j) { const int n = (lane >> 3) + 8 * j; const LAS float* s = scr + (8 * c) * 33 + n;
        v4u o; o.x = pk2(s[0 * 33], s[1 * 33]); o.y = pk2(s[2 * 33], s[3 * 33]); o.z = pk2(s[4 * 33], s[5 * 33]); o.w = pk2(s[6 * 33], s[7 * 33]);
        *(GAS v4u*)(WT + (size_t)(drow0 + n) * K + k0 + 8 * c) = o; }
    LDS_WAIT(); asm volatile("" ::: "memory");
}
__device__ __forceinline__ int map_gu(int n0) { const int which = n0 / FF, cc = n0 % FF; return 256 * (cc / 128) + 128 * which + (cc % 128); }
__device__ __forceinline__ int map_in(int n0) {
    if (n0 < 3488) return n0;
    if (n0 < 5536) { const int seg = n0 - 3488, l = seg & 255, hd = l >> 6, half = (l >> 5) & 1; return 3584 + (seg & ~255) + 128 * half + 32 * hd; }
    if (n0 < 6560) return 5632 + (n0 - 5536);
    return 6656 + (n0 - 6560);
}
__device__ __forceinline__ void conv_ffn_weights(const float* wgu, const float* wdn, unsigned char* ws, LAS float* scr, int gw, int NGW, int lane, int which = 3) {
    constexpr int I_GU = (D / 64) * (NGU / 32), I_DN = (FF / 64) * (D / 32);
    for (int it = ((which & 1) ? 0 : I_GU) + gw; it < ((which & 2) ? I_GU + I_DN : I_GU); it += NGW) {
        if (it < I_GU) { const int nb = it % (NGU / 32), kb = it / (NGU / 32); transpose_item(wgu, D, NGU, (bf16*)(ws + WS_WGU), kb * 64, nb * 32, map_gu(nb * 32), scr, lane); }
        else { const int r = it - I_GU, nb = r % (D / 32), kb = r / (D / 32); transpose_item(wdn, FF, D, (bf16*)(ws + WS_WDN), kb * 64, nb * 32, nb * 32, scr, lane); }
    }
}
__device__ __forceinline__ void rms_row_to_bf16(const float* xrow, const float* g, bf16* orow, int lane) {
    const f32x4* xr = (const f32x4*)xrow + lane; const f32x4* gr = (const f32x4*)g + lane;
    f32x4 v[8]; float s = 0.f;
#pragma unroll
    for (int j = 0; j < 8; ++j) { v[j] = __builtin_nontemporal_load(&xr[64 * j]); s += (v[j].x * v[j].x + v[j].y * v[j].y) + (v[j].z * v[j].z + v[j].w * v[j].w); }
    const float rs = 1.0f / sqrtf(wave_sum(s) * (1.f / D) + NORM_EPS);
    u32x2* o8 = (u32x2*)orow + lane;
#pragma unroll
    for (int j = 0; j < 8; ++j) { const f32x4 gg = gr[64 * j]; const f32x4 y = v[j] * rs * gg; u32x2 w; w.x = pk2(y.x, y.y); w.y = pk2(y.z, y.w); o8[64 * j] = w; }
}
__device__ __forceinline__ void norm_phase(const float* Fb_, const float* Hin, float* Hout, const float* gpost, float coef, const float* gpre, bf16* XN, int gw, int NGW, int lane) {
    for (int m = gw; m < M; m += NGW) {
        const u32x2* fr = (const u32x2*)((const bf16*)Fb_ + (size_t)m * D) + lane; const f32x4* hr = (const f32x4*)(Hin + (size_t)m * D) + lane; f32x4* ho = (f32x4*)(Hout + (size_t)m * D) + lane;
        f32x4 f[8], h[8]; float s = 0.f;
#pragma unroll
        for (int j = 0; j < 8; ++j) { f[j] = unpk4(__builtin_nontemporal_load(&fr[64 * j])); h[j] = __builtin_nontemporal_load(&hr[64 * j]); }
#pragma unroll
        for (int j = 0; j < 8; ++j) s += (f[j].x * f[j].x + f[j].y * f[j].y) + (f[j].z * f[j].z + f[j].w * f[j].w);
        const float rs = coef / sqrtf(wave_sum(s) * (1.f / D) + NORM_EPS);
        float s2 = 0.f;
#pragma unroll
        for (int j = 0; j < 8; ++j) { const f32x4 gg = ((const f32x4*)gpost)[lane + 64 * j]; h[j] = h[j] + f[j] * rs * gg; __builtin_nontemporal_store(h[j], &ho[64 * j]);
            s2 += (h[j].x * h[j].x + h[j].y * h[j].y) + (h[j].z * h[j].z + h[j].w * h[j].w); }
        if (XN) {
            const float rs2 = 1.0f / sqrtf(wave_sum(s2) * (1.f / D) + NORM_EPS);
            u32x2* o8 = (u32x2*)(XN + (size_t)m * D) + lane;
#pragma unroll
            for (int j = 0; j < 8; ++j) { const f32x4 gg = ((const f32x4*)gpre)[lane + 64 * j]; const f32x4 y = h[j] * rs2 * gg; u32x2 w; w.x = pk2(y.x, y.y); w.y = pk2(y.z, y.w); o8[64 * j] = w; }
        }
    }
}

typedef float f32x2s __attribute__((ext_vector_type(2)));
#define SLO(x) __builtin_shufflevector(x, x, 0, 1)
#define SHI(x) __builtin_shufflevector(x, x, 2, 3)
constexpr int SC_TC = 32, SC_STEP_F = 352, SC_BUF_F = SC_TC * SC_STEP_F, SC_NCH = T / SC_TC;
template <int DIR>
__device__ __forceinline__ void scan_load_chunk(bf16* dbg, LAS float* wb, const bf16* RWb, const bf16* Eb, const bf16* Ab, int t0, int rh, int lane,
                                                float mpr, float mnr, float mpk, float mnk, float mpv, float mnv, float kkc, float kac) {
    constexpr int ts = DIR ? -1 : 1;
    float rr[10], kr[10], vr[10], ee[8], aa[8];
#pragma unroll
    for (int p = 0; p < 10; ++p) { const int t = t0 + (p - 1) * ts; const bool ok = (t >= 0) && (t < T); const unsigned* rp = (const unsigned*)(RWb + (size_t)(ok ? t : 0) * RWC);
        const float a0 = bfsel(rp[0], lane), a1 = bfsel(rp[512], lane), a2 = bfsel(rp[1024], lane); rr[p] = ok ? a0 : 0.f; kr[p] = ok ? a1 : 0.f; vr[p] = ok ? a2 : 0.f; }
#pragma unroll
    for (int q = 0; q < 8; ++q) { const size_t m = (size_t)(t0 + q * ts); ee[q] = bfsel(*(const unsigned*)(Eb + m * 1024), lane); aa[q] = bfsel(*(const unsigned*)(Ab + m * 1024), lane); }
#pragma unroll
    for (int q = 0; q < 8; ++q) {
        constexpr int dummy = 0; (void)dummy;
        const int pc = q + 1, pp = DIR ? q + 2 : q, pn = DIR ? q : q + 2;
        const float r = rr[pc] + mpr * (rr[pp] - rr[pc]) + mnr * (rr[pn] - rr[pc]);
        const float k = kr[pc] + mpk * (kr[pp] - kr[pc]) + mnk * (kr[pn] - kr[pc]);
        const float v = vr[pc] + mpv * (vr[pp] - vr[pc]) + mnv * (vr[pn] - vr[pc]);
        const float a = aa[q], w = __builtin_amdgcn_exp2f(-1.4426950408889634f * ee[q]);
        const float kq = k * kkc; const float n2 = wave_sum(kq * kq); const float kk = kq * (1.0f / sqrtf(fmaxf(n2, 1e-24f)));
        const float kd = k * (1.0f + (a - 1.0f) * kac);
        LAS float* o = wb + q * SC_STEP_F;
        o[lane] = kk; o[64 + lane] = w; o[128 + lane] = kk * a; o[192 + lane] = kd; o[256 + lane] = r;
        if ((lane >> 5) == rh) o[320 + (lane & 31)] = v;
#ifdef SCAN_DBG_LOADER
        if (dbg && (q & 1) == 0) dbg[(size_t)(q >> 1) * 64 + lane] = (bf16)f2bf(kk + w + kk * a + kd + r + v);
#endif
    }
}
__device__ __forceinline__ float wsum64(float x) {
    x += dppf<0xB1>(x); x += dppf<0x4E>(x); x += dppf<0x141>(x); x += dppf<0x128>(x);
    x += __shfl_xor(x, 16); x += __shfl_xor(x, 32); return x;
}
struct ScanRaw { unsigned rr[10], kr[10], vr[10], ee[8], aa[8]; };
template <int DIR>
__device__ __forceinline__ void scan_fetch(ScanRaw& R, const bf16* RWb, const bf16* Eb, const bf16* Ab, int t0) {
    constexpr int ts = DIR ? -1 : 1;
#pragma unroll
    for (int p = 0; p < 10; ++p) { const int t = t0 + (p - 1) * ts; const bool ok = (t >= 0) && (t < T); const bf16* rp = RWb + (size_t)(ok ? t : 0) * RWC;
        R.rr[p] = rp[0]; R.kr[p] = rp[1024]; R.vr[p] = rp[2048]; }
#pragma unroll
    for (int q = 0; q < 8; ++q) { const size_t m = (size_t)(t0 + q * ts); R.ee[q] = Eb[m * 1024]; R.aa[q] = Ab[m * 1024]; }
}
template <int DIR>
__device__ __forceinline__ void scan_prep_store(const ScanRaw& R, LAS float* wb, int t0, int rh, int lane,
                                                float mpr, float mnr, float mpk, float mnk, float mpv, float mnv, float kkc, float kac) {
    constexpr int ts = DIR ? -1 : 1;
    float rr[10], kr[10], vr[10];
#pragma unroll
    for (int p = 0; p < 10; ++p) { const int t = t0 + (p - 1) * ts; const bool ok = (t >= 0) && (t < T);
        rr[p] = ok ? __uint_as_float(R.rr[p] << 16) : 0.f; kr[p] = ok ? __uint_as_float(R.kr[p] << 16) : 0.f; vr[p] = ok ? __uint_as_float(R.vr[p] << 16) : 0.f; }
#pragma unroll
    for (int q = 0; q < 8; ++q) {
        const int pc = q + 1, pp = DIR ? q + 2 : q, pn = DIR ? q : q + 2;
        const float r = rr[pc] + mpr * (rr[pp] - rr[pc]) + mnr * (rr[pn] - rr[pc]);
        const float k = kr[pc] + mpk * (kr[pp] - kr[pc]) + mnk * (kr[pn] - kr[pc]);
        const float v = vr[pc] + mpv * (vr[pp] - vr[pc]) + mnv * (vr[pn] - vr[pc]);
        const float a = __uint_as_float(R.aa[q] << 16), w = __builtin_amdgcn_exp2f(-1.4426950408889634f * __uint_as_float(R.ee[q] << 16));
        const float kq = k * kkc; const float n2 = wsum64(kq * kq); const float kk = kq * __builtin_amdgcn_rsqf(fmaxf(n2, 1e-24f));
        const float kd = k * (1.0f + (a - 1.0f) * kac);
        LAS float* o = wb + q * SC_STEP_F;
        o[lane] = kk; o[64 + lane] = w; o[128 + lane] = kk * a; o[192 + lane] = kd; o[256 + lane] = r;
        if ((lane >> 5) == rh) o[320 + (lane & 31)] = v;
    }
}
#define SCAN_FLUSH(fc) do { const int fs_ = (fc) * SC_TC + lw * 8 + (lane >> 3); const int ft_ = d ? (T - 1 - fs_) : fs_; \
        const f32x4 ov_ = *(const LAS f32x4*)(obuf + ((fc) & 1) * (SC_TC * 32) + (lw * 8 + (lane >> 3)) * 32 + (lane & 7) * 4); \
        u32x2 ow_; ow_.x = pk2(ov_.x, ov_.y); ow_.y = pk2(ov_.z, ov_.w); *(u32x2*)(Od + (size_t)ft_ * 32 + (lane & 7) * 4) = ow_; } while (0)
__device__ __forceinline__ void scan_phase(LAS unsigned char* lds, const bf16* RW, const bf16* EA, bf16* OS, const float* mu_prev, const float* mu_next, const float* k_k, const float* k_a,
                                           int vcu, int G, int wave, int lane) {
    LAS float* buf = (LAS float*)(lds + 16384);
    LAS float* obuf = buf + 2 * SC_BUF_F;
    const bool is_loader = wave < 4;
    for (int wg = vcu; wg < 256; wg += G) {
        const int ch = wg >> 1, rh = wg & 1, d = ch >> 6, b = (ch >> 4) & 3, h = ch & 15;
        const size_t mb = (size_t)b * T;
        const int lw = wave & 3, c_ = h * 64 + lane;
        const float mpr = mu_prev[c_], mnr = mu_next[c_], mpk = mu_prev[1024 + c_], mnk = mu_next[1024 + c_], mpv = mu_prev[2048 + c_], mnv = mu_next[2048 + c_];
        const float kkc = k_k[c_], kac = k_a[c_];
        const int ce = c_ & ~1;
        const bf16* RWb = RW + mb * RWC + c_; const bf16* Eb = EA + ((size_t)d * M + mb) * 1024 + c_; const bf16* Ab = EA + ((size_t)(2 + d) * M + mb) * 1024 + c_; (void)ce;
        const int rowl = lane >> 3, jg = lane & 7, row_local = (wave & 3) * 8 + rowl;
        f32x2s S2[4];
#pragma unroll
        for (int e = 0; e < 4; ++e) S2[e] = (f32x2s){0.f, 0.f};
        bf16* Od = OS + ((size_t)((((d * 4 + b) * 16 + h) * 2 + rh)) * T) * 32;
        ScanRaw R;
        if (is_loader) { const int s0 = lw * 8; if (d == 0) scan_fetch<0>(R, RWb, Eb, Ab, s0); else scan_fetch<1>(R, RWb, Eb, Ab, T - 1 - s0); }
        for (int c = 0; c <= SC_NCH; ++c) {
            if (is_loader) {
                if (c >= 2) SCAN_FLUSH(c - 2);
                if (c < SC_NCH) {
                    const int s0 = c * SC_TC + lw * 8; LAS float* wb = buf + (c & 1) * SC_BUF_F + (lw * 8) * SC_STEP_F;
                    if (d == 0) scan_prep_store<0>(R, wb, s0, rh, lane, mpr, mnr, mpk, mnk, mpv, mnv, kkc, kac);
                    else scan_prep_store<1>(R, wb, T - 1 - s0, rh, lane, mpr, mnr, mpk, mnk, mpv, mnv, kkc, kac);
                    if (c + 1 < SC_NCH) { const int s1 = s0 + SC_TC; if (d == 0) scan_fetch<0>(R, RWb, Eb, Ab, s1); else scan_fetch<1>(R, RWb, Eb, Ab, T - 1 - s1); }
                }
            }
#ifdef SCAN_SYNC
            __syncthreads();
#endif
            if (!is_loader && c > 0) {
                __builtin_amdgcn_s_setprio(3);
                const int cc = c - 1;
                LAS float* obc = obuf + (cc & 1) * (SC_TC * 32);
                const LAS float* bc = buf + (cc & 1) * SC_BUF_F;
                const LAS float* p = bc + jg * 8;
                f32x4 kk0 = *(const LAS f32x4*)(p), kk1 = *(const LAS f32x4*)(p + 4), w0 = *(const LAS f32x4*)(p + 64), w1 = *(const LAS f32x4*)(p + 68), b0 = *(const LAS f32x4*)(p + 128), b1 = *(const LAS f32x4*)(p + 132),
                      k0 = *(const LAS f32x4*)(p + 192), k1 = *(const LAS f32x4*)(p + 196), r0 = *(const LAS f32x4*)(p + 256), r1 = *(const LAS f32x4*)(p + 260);
                float v = bc[320 + row_local];
#pragma unroll 8
                for (int s = 0; s < SC_TC; ++s) {
                    const int sn = (s + 1 < SC_TC) ? s + 1 : s;
                    const LAS float* pn = bc + sn * SC_STEP_F + jg * 8;
                    const f32x4 nkk0 = *(const LAS f32x4*)(pn), nkk1 = *(const LAS f32x4*)(pn + 4), nw0 = *(const LAS f32x4*)(pn + 64), nw1 = *(const LAS f32x4*)(pn + 68), nb0 = *(const LAS f32x4*)(pn + 128), nb1 = *(const LAS f32x4*)(pn + 132),
                                nk0 = *(const LAS f32x4*)(pn + 192), nk1 = *(const LAS f32x4*)(pn + 196), nr0 = *(const LAS f32x4*)(pn + 256), nr1 = *(const LAS f32x4*)(pn + 260);
                    const float nv = bc[sn * SC_STEP_F + 320 + row_local];
                    const f32x2s pa_ = S2[1] * SHI(kk0) + S2[0] * SLO(kk0), pb_ = S2[3] * SHI(kk1) + S2[2] * SLO(kk1); const f32x2s p_ = pa_ + pb_;
                    const f32x2s t0_ = S2[0] * SLO(w0), t1_ = S2[1] * SHI(w0), t2_ = S2[2] * SLO(w1), t3_ = S2[3] * SHI(w1);
                    const float nsa = -red8(p_.x + p_.y);
                    const f32x2s ns2 = (f32x2s){nsa, nsa}, v2 = (f32x2s){v, v};
                    S2[0] = ns2 * SLO(b0) + (v2 * SLO(k0) + t0_); S2[1] = ns2 * SHI(b0) + (v2 * SHI(k0) + t1_);
                    S2[2] = ns2 * SLO(b1) + (v2 * SLO(k1) + t2_); S2[3] = ns2 * SHI(b1) + (v2 * SHI(k1) + t3_);
                    const f32x2s qa_ = S2[1] * SHI(r0) + S2[0] * SLO(r0), qb_ = S2[3] * SHI(r1) + S2[2] * SLO(r1); const f32x2s q_ = qa_ + qb_;
#ifdef SCAN_TRIVIAL
                    const float o = v;
#else
                    const float o = red8(q_.x + q_.y);
#endif
                    if (jg == 0) obc[s * 32 + row_local] = o;
                    kk0 = nkk0; kk1 = nkk1; w0 = nw0; w1 = nw1; b0 = nb0; b1 = nb1; k0 = nk0; k1 = nk1; r0 = nr0; r1 = nr1; v = nv;
                }
                __builtin_amdgcn_s_setprio(0);
            }
            __syncthreads();
        }
        if (is_loader) SCAN_FLUSH(SC_NCH - 1);
        __syncthreads();
    }
}

__device__ __forceinline__ void post_phase(const bf16* __restrict__ RW, const bf16* __restrict__ EAG, const bf16* __restrict__ GG, const bf16* __restrict__ OS, const bf16* __restrict__ OATT, bf16* __restrict__ Y, const float* __restrict__ mu_prev, const float* __restrict__ mu_next, const float* __restrict__ k_a, const float* __restrict__ r_k,
                                           const float* gn_w, const float* gn_b, const float* lq1, const float* lk1, const float* lq2, const float* lk2, const float* subln_g, int gw, int NGW, int lane) {
#pragma unroll 2
    for (int it = gw; it < M * 4; it += NGW) {
        const int m = it >> 2, hq = it & 3, c0 = hq * 256 + 4 * lane, t = m & (T - 1);
        const bool hasp = t > 0, hasn = t < T - 1;
        const int hh = hq * 4 + (lane >> 4), i0 = (lane & 15) * 4, bb = m >> 11;
        const size_t oso = ((size_t)((((bb * 16 + hh) * 2 + (i0 >> 5))) * T) + t) * 32 + (i0 & 31);
        const f32x4 o = unpk4(*(const u32x2*)(OS + oso)) + unpk4(*(const u32x2*)(OS + (size_t)4 * 16 * 2 * T * 32 + oso));
        const bf16* rp = RW + (size_t)m * RWC + c0;
        f32x4 x[3], xp[3], xn[3];
#pragma unroll
        for (int q = 0; q < 3; ++q) { x[q] = unpk4(*(const u32x2*)(rp + q * 1024));
            xp[q] = unpk4(*(const u32x2*)(rp + q * 1024 - (hasp ? RWC : 0))); xn[q] = unpk4(*(const u32x2*)(rp + q * 1024 + (hasn ? RWC : 0)));
            if (!hasp) xp[q] = (f32x4){0.f, 0.f, 0.f, 0.f}; if (!hasn) xn[q] = (f32x4){0.f, 0.f, 0.f, 0.f};
            const f32x4 mp = *(const f32x4*)(mu_prev + q * 1024 + c0), mn = *(const f32x4*)(mu_next + q * 1024 + c0);
            x[q] = x[q] + mp * (xp[q] - x[q]) + mn * (xn[q] - x[q]); }
        const f32x4 a0 = unpk4(*(const u32x2*)(EAG + (size_t)(2 * M + m) * 1024 + c0)), a1 = unpk4(*(const u32x2*)(EAG + (size_t)(3 * M + m) * 1024 + c0));
        const f32x4 g = unpk4(*(const u32x2*)(GG + (size_t)m * 1024 + c0));
        const f32x4 ka = *(const f32x4*)(k_a + c0), rk = *(const f32x4*)(r_k + c0), gw4 = *(const f32x4*)(gn_w + c0), gb4 = *(const f32x4*)(gn_b + c0);
        const float mean = red16((o.x + o.y) + (o.z + o.w)) * (1.f / 64.f);
        const f32x4 dv = o - mean;
        const float var = red16((dv.x * dv.x + dv.y * dv.y) + (dv.z * dv.z + dv.w * dv.w)) * (1.f / 64.f);
        const float rstd = 1.0f / sqrtf(var + GN_EPS);
        const f32x4 ksum = x[1] * (2.0f + (a0 + a1 - 2.0f) * ka);
        const f32x4 bt = x[0] * ksum * rk;
        const float bs = red16((bt.x + bt.y) + (bt.z + bt.w));
        const f32x4 y = (dv * rstd * gw4 + gb4 + x[2] * bs) * g;
        u32x2 w; w.x = pk2(y.x, y.y); w.y = pk2(y.z, y.w);
        *(u32x2*)(Y + (size_t)m * 1024 + c0) = w;
    }
    const float lam = __expf(wave_sum(lq1[lane] * lk1[lane])) - __expf(wave_sum(lq2[lane] * lk2[lane])) + LAM_INIT;
#pragma unroll 2
    for (int m = gw; m < M; m += NGW) {
        const int hv = lane >> 3, d0 = 16 * (lane & 7);
        const bf16* p1 = OATT + (size_t)m * 2048 + (2 * hv) * 128 + d0; const bf16* p2 = p1 + 128;
        const v4u a0 = *(const v4u*)p1, a1 = *(const v4u*)(p1 + 8), b0 = *(const v4u*)p2, b1 = *(const v4u*)(p2 + 8);
        f32x4 df[4];
        df[0] = pg8::unpk_lo(a0) - lam * pg8::unpk_lo(b0); df[1] = pg8::unpk_hi(a0) - lam * pg8::unpk_hi(b0); df[2] = pg8::unpk_lo(a1) - lam * pg8::unpk_lo(b1); df[3] = pg8::unpk_hi(a1) - lam * pg8::unpk_hi(b1);
        float ss = 0.f;
#pragma unroll
        for (int q = 0; q < 4; ++q) ss += (df[q].x * df[q].x + df[q].y * df[q].y) + (df[q].z * df[q].z + df[q].w * df[q].w);
        const float rs = (1.0f - LAM_INIT) / sqrtf(red8(ss) * (1.f / 128.f) + SUBLN_EPS);
#pragma unroll
        for (int q = 0; q < 4; ++q) df[q] = df[q] * rs * *(const f32x4*)(subln_g + d0 + 4 * q);
        bf16* yo = Y + (size_t)(M + m) * 1024 + hv * 128 + d0;
        *(v4u*)yo = pg8::pack8(df[0], df[1]); *(v4u*)(yo + 8) = pg8::pack8(df[2], df[3]);
    }
}


struct Ctx { int vcu, wave, lane; };
typedef const __attribute__((address_space(4))) Args* ArgsP;
template <int ph> __device__ __forceinline__ void run_phase(const Ctx& c, LAS unsigned char* lds, unsigned char* lds_raw) {
    ArgsP ap = (ArgsP)__builtin_amdgcn_kernarg_segment_ptr(); asm volatile("" : "+s"(ap));
    unsigned char* ws = ap->ws; const float* x = ap->in[0]; float* out = ap->out;
    int tid = threadIdx.x; asm volatile("" : "+v"(tid));
    const int G = gridDim.x, bx = blockIdx.x, vcu = (G % 8 == 0) ? (bx % 8) * (G / 8) + bx / 8 : bx, wave = __builtin_amdgcn_readfirstlane(tid >> 6), lane = tid & 63; (void)c;
    const int gw = vcu * NWAVES + wave, NGW = G * NWAVES, gt = vcu * (NWAVES * 64) + tid, NGT = G * NWAVES * 64;
    bf16* XN = (bf16*)(ws + WS_XN); float* Fb = (float*)(ws + WS_F); bf16* ACT = (bf16*)(ws + WS_ACT);
    bf16* RW = (bf16*)(ws + WS_RW); bf16* Qb = (bf16*)(ws + WS_Q); bf16* Kb = (bf16*)(ws + WS_K); bf16* Vb = (bf16*)(ws + WS_V); bf16* Yb = (bf16*)(ws + WS_Y);
    bf16* GATES = (bf16*)(ws + WS_GATES); float* LR = (float*)(ws + WS_LR); bf16* LA = (bf16*)(ws + WS_LA); bf16* OATT = (bf16*)(ws + WS_OATT);
    bf16* EA = (bf16*)(ws + WS_F);
    bf16* Gg = (bf16*)(ws + WS_G);
#ifdef OS_IN_GATES
    bf16* OS = (bf16*)(ws + WS_GATES);
#else
    bf16* OS = (bf16*)(ws + WS_XN);
#endif
    bf16* MERGED = (bf16*)(ws + WS_XN); float* Pb = (float*)(ws + WS_F);
    float* ROPE = (float*)(ws + WS_ROPE);
    (void)XN; (void)Fb; (void)ACT; (void)RW; (void)Qb; (void)Kb; (void)Vb; (void)Yb; (void)GATES; (void)LR; (void)LA; (void)OATT; (void)EA; (void)Gg; (void)OS; (void)MERGED; (void)Pb; (void)ROPE; (void)gw; (void)NGW; (void)gt; (void)NGT; (void)bx;
    (void)tid; (void)x; (void)out; (void)ws;
#ifdef ONLY_PH
    if (ph != ONLY_PH) return;
#endif
#ifdef STOP_AFTER
    if (ph > STOP_AFTER) return;
#endif
#ifdef SKIP_MASK
    if ((SKIP_MASK >> ph) & 1) return;
#endif
        switch (ph) {
        case 0: {
            LAS float* scr = (LAS float*)(lds + RING_OFF + wave * 16384);
#ifdef HIDE_CONV
            conv_ffn_weights(ap->in[2], ap->in[3], ws, scr, gw, NGW, lane, 1);
#else
            conv_ffn_weights(ap->in[2], ap->in[3], ws, scr, gw, NGW, lane);
#endif
#ifndef HIDE_CONV
            constexpr int I_IN = (D / 64) * (IN_COLS / 32), I_BR = (1024 / 64) * (D / 32), I_OUT = (D / 64) * (D / 32);
            for (int it = gw; it < I_IN + 2 * I_BR + I_OUT; it += NGW) {
                int r = it;
                if (r < I_IN) { const int nb = r % (IN_COLS / 32), kb = r / (IN_COLS / 32); transpose_item(ap->in[6], D, IN_COLS, (bf16*)(ws + WS_WIN), kb * 64, nb * 32, map_in(nb * 32), scr, lane); continue; } r -= I_IN;
                if (r < I_BR) { const int nb = r % (D / 32), kb = r / (D / 32); transpose_item(ap->in[24], 1024, D, (bf16*)(ws + WS_WA), kb * 64, nb * 32, nb * 32, scr, lane); continue; } r -= I_BR;
                if (r < I_BR) { const int nb = r % (D / 32), kb = r / (D / 32); transpose_item(ap->in[25], 1024, D, (bf16*)(ws + WS_WB), kb * 64, nb * 32, nb * 32, scr, lane); continue; } r -= I_BR;
                { const int nb = r % (D / 32), kb = r / (D / 32); transpose_item(ap->in[26], D, D, (bf16*)(ws + WS_WOUT), kb * 64, nb * 32, nb * 32, scr, lane); }
            }
#endif
#ifndef HIDE_CONV
            { const float* w_up = ap->in[10]; const float* a_up = ap->in[12]; const float* g_up = ap->in[13]; bf16* WL = (bf16*)(ws + WS_WLORA);
              for (int i = gt; i < NLORA * (KLORA / 8); i += NGT) { const int n = i >> 6, k0 = (i & 63) * 8, ob = n >> 10, c = n & 1023; float v[8];
#pragma unroll
                  for (int e = 0; e < 8; ++e) { const int kk = k0 + e; float val = 0.f;
                      if (ob < 2) { if ((kk >> 6) == ob) val = w_up[(size_t)kk * 1024 + c]; }
                      else if (ob < 4) { if ((kk >> 6) == ob) val = a_up[(size_t)(kk - 128) * 1024 + c]; }
                      else { if (kk >= 256 && kk < 416) val = g_up[(size_t)(kk - 256) * 1024 + c]; }
                      v[e] = val; }
                  v4u o; o.x = pk2(v[0], v[1]); o.y = pk2(v[2], v[3]); o.z = pk2(v[4], v[5]); o.w = pk2(v[6], v[7]);
                  *(v4u*)(WL + (size_t)n * KLORA + k0) = o; } }
#endif
            for (int i = gt; i < T * 32; i += NGT) { const int t = i >> 5, k = i & 31;
                const float inv = __builtin_amdgcn_exp2f(-(float)k * (13.287712379549449f / 32.0f)); const float ang = (float)t * inv;
                const double rev = (double)ang * 0.15915494309189535; const float fr = (float)(rev - floor(rev));
                ROPE[t * 64 + k] = __builtin_amdgcn_cosf(fr); ROPE[t * 64 + 32 + k] = __builtin_amdgcn_sinf(fr); }
            for (int m = gw; m < M; m += NGW) rms_row_to_bf16(x + (size_t)m * D, ap->in[1], XN + (size_t)m * D, lane);
        } break;
        case 1: case 12: {
            pg8::Gemm g{XN, (const bf16*)(ws + WS_WGU), M, NGU, D, nullptr, nullptr}; pg8::StaticOrder S; S.init(M, NGU, G, bx);
            pg8::EpiSwiglu E{ACT, FF};
            pg8::gemm_phase<pg8::EpiSwiglu, pg8::StaticOrder, true, true>(lds + RING_OFF, g, S, E);
#ifdef HIDE_CONV
            if (ph == 1 && G == 256 ? bx >= 128 : ph == 1) { LAS float* scr = (LAS float*)(lds + RING_OFF + wave * 16384);
                const int gw2 = (G == 256) ? (bx - 128) * NWAVES + wave : gw, NGW2 = (G == 256) ? 128 * NWAVES : NGW;
                constexpr int I_IN = (D / 64) * (IN_COLS / 32);
                for (int r = gw2; r < I_IN; r += NGW2) { const int nb = r % (IN_COLS / 32), kb = r / (IN_COLS / 32); transpose_item(ap->in[6], D, IN_COLS, (bf16*)(ws + WS_WIN), kb * 64, nb * 32, map_in(nb * 32), scr, lane); }
                conv_ffn_weights(ap->in[2], ap->in[3], ws, scr, gw2, NGW2, lane, 2);
            }
#endif
        } break;
        case 2: case 10: case 13: {
            const bool isout = (ph == 10);
            pg8::Gemm g{isout ? MERGED : ACT, (const bf16*)(ws + (isout ? WS_WOUT : WS_WDN)), M, D, isout ? D : FF, nullptr, nullptr}; pg8::StaticOrder S; S.init(M, D, G, bx);
            pg8::EpiB16 E{(bf16*)Fb, D};
            pg8::gemm_phase<pg8::EpiB16, pg8::StaticOrder, true, true>(lds + RING_OFF, g, S, E);
        } break;
        case 3: case 11: case 14: {
            const float* gpost = ap->in[ph == 3 ? 4 : (ph == 11 ? 27 : 31)]; const float* gpre = ap->in[ph == 3 ? 5 : 28];
            norm_phase(Fb, ph == 3 ? x : out, out, gpost, ph == 11 ? 1.0f : 0.5f, gpre, ph == 14 ? (bf16*)nullptr : XN, gw, NGW, lane);
        } break;
        case 4: {
            pg8::Gemm g{XN, (const bf16*)(ws + WS_WIN), M, IN_PAD, D, nullptr, nullptr}; pg8::StaticOrder S; S.init(M, IN_PAD, G, bx);
            pg8::EpiIn E{RW, Qb, Kb, Vb, GATES, LR, ROPE, QSCALE};
            pg8::gemm_phase<pg8::EpiIn, pg8::StaticOrder, true, true>(lds + RING_OFF, g, S, E);
#ifdef HIDE_CONV
            if (G == 256 ? bx >= 64 : true) { LAS float* scr = (LAS float*)(lds + RING_OFF + wave * 16384);
                const int gw2 = (G == 256) ? (bx - 64) * NWAVES + wave : gw, NGW2 = (G == 256) ? 192 * NWAVES : NGW;
                conv_ffn_weights(ap->in[29], ap->in[30], ws, scr, gw2, NGW2, lane);
                constexpr int I_BR = (1024 / 64) * (D / 32), I_OUT = (D / 64) * (D / 32);
                for (int it = gw2; it < 2 * I_BR + I_OUT; it += NGW2) { int r = it;
                    if (r < I_BR) { const int nb = r % (D / 32), kb = r / (D / 32); transpose_item(ap->in[24], 1024, D, (bf16*)(ws + WS_WA), kb * 64, nb * 32, nb * 32, scr, lane); continue; } r -= I_BR;
                    if (r < I_BR) { const int nb = r % (D / 32), kb = r / (D / 32); transpose_item(ap->in[25], 1024, D, (bf16*)(ws + WS_WB), kb * 64, nb * 32, nb * 32, scr, lane); continue; } r -= I_BR;
                    { const int nb = r % (D / 32), kb = r / (D / 32); transpose_item(ap->in[26], D, D, (bf16*)(ws + WS_WOUT), kb * 64, nb * 32, nb * 32, scr, lane); } }
                const int gt2 = (G == 256) ? (bx - 64) * (NWAVES * 64) + tid : gt, NGT2 = (G == 256) ? 192 * NWAVES * 64 : NGT;
            { const float* w_up = ap->in[10]; const float* a_up = ap->in[12]; const float* g_up = ap->in[13]; bf16* WL = (bf16*)(ws + WS_WLORA);
              for (int i = gt2; i < NLORA * (KLORA / 8); i += NGT2) { const int n = i >> 6, k0 = (i & 63) * 8, ob = n >> 10, c = n & 1023; float v[8];
#pragma unroll
                  for (int e = 0; e < 8; ++e) { const int kk = k0 + e; float val = 0.f;
                      if (ob < 2) { if ((kk >> 6) == ob) val = w_up[(size_t)kk * 1024 + c]; }
                      else if (ob < 4) { if ((kk >> 6) == ob) val = a_up[(size_t)(kk - 128) * 1024 + c]; }
                      else { if (kk >= 256 && kk < 416) val = g_up[(size_t)(kk - 256) * 1024 + c]; }
                      v[e] = val; }
                  v4u o; o.x = pk2(v[0], v[1]); o.y = pk2(v[2], v[3]); o.z = pk2(v[4], v[5]); o.w = pk2(v[6], v[7]);
                  *(v4u*)(WL + (size_t)n * KLORA + k0) = o; } }
            }
#endif
        } break;
        case 5: {
            const float* mu_prev = ap->in[7]; const float* mu_next = ap->in[8];
            for (int i = gt; i < M * 64; i += NGT) { const int m = i >> 6, grp = i & 63, c0 = grp * 8, t = m & (T - 1);
                f32x4 y0 = (f32x4){0.f, 0.f, 0.f, 0.f}, y1 = y0;
                if (grp < 52) {
                    const float* cp = LR + (size_t)m * 512 + c0; const f32x4 z = (f32x4){0.f, 0.f, 0.f, 0.f};
                    const f32x4 c_0 = *(const f32x4*)cp, c_1 = *(const f32x4*)(cp + 4);
                    const f32x4 p_0 = t > 0 ? *(const f32x4*)(cp - 512) : z, p_1 = t > 0 ? *(const f32x4*)(cp - 508) : z;
                    const f32x4 n_0 = t < T - 1 ? *(const f32x4*)(cp + 512) : z, n_1 = t < T - 1 ? *(const f32x4*)(cp + 516) : z;
                    const f32x4 mp0 = *(const f32x4*)(mu_prev + 3072 + c0), mp1 = *(const f32x4*)(mu_prev + 3076 + c0), mn0 = *(const f32x4*)(mu_next + 3072 + c0), mn1 = *(const f32x4*)(mu_next + 3076 + c0);
                    y0 = c_0 + mp0 * (p_0 - c_0) + mn0 * (n_0 - c_0); y1 = c_1 + mp1 * (p_1 - c_1) + mn1 * (n_1 - c_1);
                    if (c0 < 128) {
#pragma unroll
                        for (int e = 0; e < 4; ++e) { y0[e] = 2.0f * sigm_(2.0f * y0[e]) - 1.0f; y1[e] = 2.0f * sigm_(2.0f * y1[e]) - 1.0f; } }
                    else if (c0 >= 256) {
#pragma unroll
                        for (int e = 0; e < 4; ++e) { y0[e] = sigm_(y0[e]); y1[e] = sigm_(y1[e]); } }
                }
                *(v4u*)(LA + (size_t)m * 512 + c0) = pg8::pack8(y0, y1); }
#ifndef HIDE_CONV
            LAS float* scr = (LAS float*)(lds + RING_OFF + wave * 16384);
            conv_ffn_weights(ap->in[29], ap->in[30], ws, scr, gw, NGW, lane);
#endif
        } break;
        case 6: {
            pg8::Gemm g{LA, (const bf16*)(ws + WS_WLORA), M, NLORA, KLORA, nullptr, nullptr}; pg8::LoraOrder S; S.so.init(M, NLORA, G, bx);
            pg8::EpiLora E{EA, Gg, ap->in[9], ap->in[11]};
            pg8::gemm_phase<pg8::EpiLora, pg8::LoraOrder, true, true>(lds + RING_OFF, g, S, E);
        } break;
        case 7: {
            scan_phase(lds + RING_OFF, RW, EA, OS, ap->in[7], ap->in[8], ap->in[14], ap->in[15], vcu, G, wave, lane);
            __syncthreads();
#ifdef SKIP_ATTN
            if (true) break;
#endif
            const int upc = (1024 + G - 1) / G;
            for (int i = 0; i < upc; ++i) { const int unit = vcu * upc + i; if (unit >= 1024) break;
                const int qb = unit & 7, vh = (unit >> 3) & 1, j = (unit >> 4) & 15, b = unit >> 8;
                attn_body::attn_unit<8>(b, j, (j >> 1) * 128 + vh * 64, j * 128 + vh * 64, qb, (const attn_body::bf16*)Qb, (const attn_body::bf16*)Kb, (const attn_body::bf16*)Vb, (attn_body::bf16*)OATT, (char*)lds_raw + RING_OFF); }
        } break;
        case 8: {
            post_phase(RW, EA, Gg, OS, OATT, Yb, ap->in[7], ap->in[8], ap->in[15], ap->in[16], ap->in[17], ap->in[18], ap->in[19], ap->in[20], ap->in[21], ap->in[22], ap->in[23], gw, NGW, lane);
        } break;
        case 9: {
            pg8::Gemm g{Yb, (const bf16*)(ws + WS_WA), M, D, 1024, Yb + (size_t)M * 1024, (const bf16*)(ws + WS_WB)}; pg8::BranchOrder S; S.so.init(M, D, G, bx);
            pg8::EpiBranch E{Pb, MERGED, GATES};
            pg8::gemm_phase<pg8::EpiBranch, pg8::BranchOrder, true, true>(lds + RING_OFF, g, S, E);
        } break;
        }
}
__device__ __forceinline__ void ap_out_nan(float* out, int i) { out[i] = __builtin_nanf(""); }
#ifndef USE_XCD_BARRIER
#define USE_XCD_BARRIER 1
#endif
#if USE_XCD_BARRIER
#define GRID_SYNC() xcd_barrier(bar)
#else
#define GRID_SYNC() cooperative_groups::this_grid().sync()
#endif
#ifndef CUT_LIST
#define CUT_LIST {0, 15}
#endif
__global__ void __launch_bounds__(NWAVES * 64, 2) mk_fwd(Args args) {
    extern __shared__ __attribute__((aligned(16))) unsigned char lds_raw[];
    LAS unsigned char* lds = (LAS unsigned char*)lds_raw;
    volatile LAS unsigned* MISC = (volatile LAS unsigned*)(lds + MISC_OFF);
    const int tid = threadIdx.x, lane = tid & 63, wave = __builtin_amdgcn_readfirstlane(tid >> 6);
    const int G = gridDim.x; const int bx = blockIdx.x; const int vcu = (G % 8 == 0) ? (bx % 8) * (G / 8) + bx / 8 : bx;
    unsigned char* ws = args.ws;
    gu32* ctl = (gu32*)(ws + WS_CTL);
    for (int u = tid; u < (LDS_BYTES - LDSCTL_OFF) / 4; u += NWAVES * 64) ((LAS unsigned*)(lds + LDSCTL_OFF))[u] = 0u;
    __syncthreads();
    XcdBarrier bar = xcd_barrier_post((unsigned*)(ctl + CW_BAR) + args.li * XCD_BAR_WORDS, MISC + 8);
    const int ph_lo = args.ph_lo, ph_hi = args.ph_hi;
#ifdef DUMP_SCAN_INPUTS
    if (ph_lo == 7) {
        for (size_t i_ = (size_t)blockIdx.x * 512 + threadIdx.x; i_ < (size_t)M * D; i_ += (size_t)gridDim.x * 512) {
            float s_ = 0.f;
            { const unsigned* W_ = (const unsigned*)(ws + WS_RW); if (i_ < (size_t)48 * MiB / 4) s_ += (float)(W_[i_] & 0xfffffu) + (float)(W_[i_] >> 20); }
            { const unsigned* W_ = (const unsigned*)(ws + WS_F); s_ += (float)(W_[i_] & 0xfffffu) + (float)(W_[i_] >> 20); }
            if (i_ < 3488) s_ += args.in[7][i_] + args.in[8][i_];
            if (i_ < 1024) s_ += args.in[14][i_] + args.in[15][i_];
            args.out[i_] = s_; }
        return; }
    if (ph_lo > 7) return;
#endif
#ifdef DUMP_OS_AT8
    if (ph_lo == 8) {
        for (size_t i_ = (size_t)blockIdx.x * 512 + threadIdx.x; i_ < (size_t)M * D; i_ += (size_t)gridDim.x * 512) {
            float s_ = 0.f;
            if (DUMP_OS_AT8 & 1) { const unsigned* W_ = (const unsigned*)(ws + WS_XN); if (i_ < (size_t)32 * MiB / 4) s_ += (float)(W_[i_] & 0xfffffu) + (float)(W_[i_] >> 20); }
            if (DUMP_OS_AT8 & 4) { const unsigned* W_ = (const unsigned*)(ws + WS_GATES); s_ += (float)(W_[i_] & 0xfffffu) + (float)(W_[i_] >> 20); }
            if (DUMP_OS_AT8 & 8) { const unsigned* W_ = (const unsigned*)(ws + WS_GATES); if (i_ < 256 * 8 * 4 * 64) s_ += (float)(W_[i_] & 0xfffffu) + (float)(W_[i_] >> 20); }
            if (DUMP_OS_AT8 & 2) { const unsigned* W_ = (const unsigned*)(ws + WS_OATT); if (i_ < (size_t)32 * MiB / 4) s_ += (float)(W_[i_] & 0xfffffu) + (float)(W_[i_] >> 20); }
            args.out[i_] = s_; }
        return; }
#endif
    Ctx c{vcu, wave, lane};
#ifdef DUMP_AFTER
#define DUMP_AFTER_7X(n) ((n) == 7 && DUMP_AFTER > 70)
#define DUMPR(off, nbytes) do { const unsigned* W_ = (const unsigned*)(ws + (off)); const size_t n_ = (size_t)(nbytes) / 4; \
        for (size_t i_ = (size_t)blockIdx.x * 512 + threadIdx.x; i_ < (size_t)M * D; i_ += (size_t)gridDim.x * 512) { float s_ = 0.f; for (size_t j_ = i_; j_ < n_; j_ += (size_t)M * D) s_ += (float)(W_[j_] & 0xfffffu); args.out[i_] += s_; } } while (0)
#define DUMPCHK(k) if (DUMP_AFTER == (k)) { for (size_t i_ = (size_t)blockIdx.x * 512 + threadIdx.x; i_ < (size_t)M * D; i_ += (size_t)gridDim.x * 512) args.out[i_] = 0.f; \
        if ((k) == 4) { DUMPR(WS_RW, 48 * MiB); DUMPR(WS_Q, 48 * MiB); DUMPR(WS_GATES, 64 * MiB); } \
        if ((k) == 5) { DUMPR(WS_LA, 8 * MiB); DUMPR(WS_WGU, 66 * MiB); } \
        if ((k) == 6) { DUMPR(WS_F, 64 * MiB); DUMPR(WS_G, 16 * MiB); } \
        if ((k) == 7) { DUMPR(WS_XN, 32 * MiB); DUMPR(WS_OATT, 32 * MiB); } \
        if ((k) == 71) { DUMPR(WS_XN, 32 * MiB); } \
        if ((k) == 72) { DUMPR(WS_OATT, 32 * MiB); } \
        if ((k) == 8) { DUMPR(WS_Y, 32 * MiB); } \
        if ((k) == 9) { DUMPR(WS_XN, 32 * MiB); } \
        if ((k) == 10) { DUMPR(WS_F, 64 * MiB); } \
        return; }
#else
#define DUMPCHK(k)
#define DUMP_AFTER_7X(n) false
#endif
#ifdef HASH_AFTER
#define HASHCHK(n) if ((n) == HASH_AFTER) { unsigned hs_ = 0u; const unsigned* W_ = (const unsigned*)(ws + (size_t)(HASH_LO) * MiB); const size_t n_ = (size_t)((HASH_HI) - (HASH_LO)) * MiB / 4; \
        for (size_t i_ = (size_t)blockIdx.x * 512 + threadIdx.x; i_ < n_; i_ += (size_t)gridDim.x * 512) { const unsigned w_ = W_[i_]; hs_ += w_ * 2654435761u + (w_ >> 15) + (unsigned)i_ * (w_ | 1u); } \
        atomicAdd((unsigned*)(ctl + 100000), hs_); GRID_SYNC(); const unsigned hv_ = xb_ld((unsigned*)(ctl + 100000)); \
        for (size_t i_ = (size_t)blockIdx.x * 512 + threadIdx.x; i_ < (size_t)M * D; i_ += (size_t)gridDim.x * 512) args.out[i_] = (float)((hv_ ^ (unsigned)(i_ * 40503u)) & 0xffffu); \
        return; }
#else
#define HASHCHK(n)
#endif
#ifdef DUP_PHASE
#define DUPRUN(n) if ((n) == DUP_PHASE) { run_phase<n>(c, lds, lds_raw); GRID_SYNC(); }
#else
#define DUPRUN(n)
#endif
#define PH(n) if (ph_lo <= (n) && (n) < ph_hi) { DUPRUN(n) run_phase<n>(c, lds, lds_raw); if ((n) + 1 < ph_hi) { GRID_SYNC(); } HASHCHK(n) }
    PH(0) PH(1) PH(2) PH(3) PH(4) PH(5) PH(6) PH(7) PH(8) PH(9) PH(10) PH(11) PH(12) PH(13)
    PH(14)
    if (ph_hi == 15 && (xb_ld((unsigned*)(ctl + CW_BAR) + XB_TMO) | xb_ld((unsigned*)(ctl + CW_BAR) + XCD_BAR_WORDS + XB_TMO) | xb_ld((unsigned*)(ctl + CW_BAR) + 2 * XCD_BAR_WORDS + XB_TMO)) != 0u) { asm volatile("s_waitcnt vmcnt(0)" ::: "memory"); if (threadIdx.x < 64) ap_out_nan(args.out, blockIdx.x * 64 + threadIdx.x); }
#undef PH
}

extern "C" void kernel_launch(void* const* d_in, const int* in_sizes, int n_in, void* d_out, int out_size, void* d_ws, size_t ws_size, hipStream_t stream) {
    static int grid = 0;
    if (grid == 0) {
        if (n_in != 32 || in_sizes[0] != M * D || out_size != M * D || ws_size < WS_END) { fprintf(stderr, "kernel_launch: unexpected shapes (n_in %d, ws %zu)\n", n_in, ws_size); grid = -1; return; }
        int dev = 0, cus = 0, per_cu = 0;
        if (hipGetDevice(&dev) != hipSuccess || hipDeviceGetAttribute(&cus, hipDeviceAttributeMultiprocessorCount, dev) != hipSuccess) { grid = -1; return; }
        if (hipFuncSetAttribute((const void*)mk_fwd, hipFuncAttributeMaxDynamicSharedMemorySize, LDS_BYTES) != hipSuccess) { fprintf(stderr, "kernel_launch: hipFuncSetAttribute failed\n"); grid = -1; return; }
        if (hipOccupancyMaxActiveBlocksPerMultiprocessor(&per_cu, (const void*)mk_fwd, NWAVES * 64, LDS_BYTES) != hipSuccess || per_cu < 1) { fprintf(stderr, "kernel_launch: occupancy query says %d\n", per_cu); per_cu = 1; }
        (void)hipGetLastError();
        grid = cus;
    }
    if (grid < 0) return;
    if (hipMemsetAsync((char*)d_ws + WS_CTL, 0, CTL_ZERO_BYTES, stream) != hipSuccess) return;
    Args a{};
    for (int i = 0; i < 32; ++i) a.in[i] = (const float*)d_in[i];
    a.out = (float*)d_out; a.ws = (unsigned char*)d_ws;
#if USE_XCD_BARRIER
#ifndef N_CUTS
#define N_CUTS 1
#endif
    static const int cuts[N_CUTS + 1] = CUT_LIST;
    for (int li = 0; li < N_CUTS; ++li) { a.ph_lo = cuts[li]; a.ph_hi = cuts[li + 1]; a.li = li;
        hipLaunchKernelGGL(mk_fwd, dim3(grid), dim3(NWAVES * 64), LDS_BYTES, stream, a); }
#else
    void* kargs[] = {&a};
    hipError_t e = hipLaunchCooperativeKernel((const void*)mk_fwd, dim3(grid), dim3(NWAVES * 64), kargs, LDS_BYTES, stream);
    if (e != hipSuccess) fprintf(stderr, "cooperative launch failed: %s (grid %d)\n", hipGetErrorString(e), grid);
#endif
}
```

```cpp
#include <hip/hip_runtime.h>
#include <hip/hip_cooperative_groups.h>
#include <cstdio>
#include <cstdint>
namespace pg8 {
#define PG8_LAS __attribute__((address_space(3)))
typedef unsigned short bf16_t;
typedef short bf16x8 __attribute__((ext_vector_type(8)));
typedef float f32x4 __attribute__((ext_vector_type(4)));
typedef unsigned u32x4 __attribute__((ext_vector_type(4)));
constexpr int BM = 256, BK = 64, HALF = 128, HTB = HALF * BK * 2  , STAGE_BYTES = 8 * HTB, NXCD = 8, WGM = 8;

__host__ __device__ __forceinline__ int lds_byte(int r, int c) { const int st = (r >> 4) * 2 + (c >> 5), rr = r & 15, cc = c & 31, ob = rr * 64 + cc * 2; return st * 1024 + (ob ^ (((ob >> 9) & 1) << 5)); }
__host__ __device__ __forceinline__ void stage_rc(int b, int& R, int& C) { const int st = b / 1024, sb = b % 1024, swz = sb ^ (((sb >> 9) & 1) << 5); R = (st >> 1) * 16 + swz / 64; C = (st & 1) * 32 + (swz % 64) / 2; }
__host__ __device__ __forceinline__ int perm32(int rho) { const int n = rho >> 4, i = rho & 15; return 8 * (i >> 2) + 4 * n + (i & 3); }

struct Unit { int pm, pn, sel, kbeg, nt; };
struct Gemm { const bf16_t* A; const bf16_t* Bt; int M, N, K; const bf16_t* A2; const bf16_t* Bt2; };

struct StaticOrder {
    int nM, nN, nwg, G, c;
    __host__ __device__ void init(int M, int N, int G_, int c_) { nM = M / BM; nN = N / BM; nwg = nM * nN; G = G_; c = c_; }
    __host__ __device__ bool next(int i, Unit& u) const {
        const long L = (long)i * G + c; if (L >= nwg) return false;
        int wgid = (int)L; { const int q = nwg / NXCD, r = nwg % NXCD, xcd = wgid % NXCD, off = wgid / NXCD; wgid = (xcd < r ? xcd * (q + 1) : r * (q + 1) + (xcd - r) * q) + off; }
        const int nig = WGM * nN, gid = wgid / nig, fm = gid * WGM, gsz = (nM - fm) < WGM ? (nM - fm) : WGM;
        u.pm = fm + ((wgid % nig) % gsz); u.pn = (wgid % nig) / gsz; u.sel = 0; u.kbeg = 0; u.nt = 0; return true;
    }
    __device__ __forceinline__ void a_ready(const Unit&) const {}
    __device__ __forceinline__ void done(const Unit&) const {}
};


typedef float f32x2c_t __attribute__((ext_vector_type(2))); typedef __bf16 bf16x2c_t __attribute__((ext_vector_type(2)));
__device__ __forceinline__ unsigned cvt_pk_bf16(float lo, float hi) { f32x2c_t v = {lo, hi}; bf16x2c_t b = __builtin_convertvector(v, bf16x2c_t); return __builtin_bit_cast(unsigned, b); }
__device__ __forceinline__ float sigm(float x) { return __builtin_amdgcn_rcpf(1.0f + __builtin_amdgcn_exp2f(-1.4426950408889634f * x)); }
__device__ __forceinline__ u32x4 pack8(const f32x4 a, const f32x4 b) { u32x4 w; w.x = cvt_pk_bf16(a[0], a[1]); w.y = cvt_pk_bf16(a[2], a[3]); w.z = cvt_pk_bf16(b[0], b[1]); w.w = cvt_pk_bf16(b[2], b[3]); return w; }
__device__ __forceinline__ f32x4 unpk_lo(const u32x4 w) { return (f32x4){__uint_as_float(w.x << 16), __uint_as_float(w.x & 0xffff0000u), __uint_as_float(w.y << 16), __uint_as_float(w.y & 0xffff0000u)}; }
__device__ __forceinline__ f32x4 unpk_hi(const u32x4 w) { return (f32x4){__uint_as_float(w.z << 16), __uint_as_float(w.z & 0xffff0000u), __uint_as_float(w.w << 16), __uint_as_float(w.w & 0xffff0000u)}; }

template <int ACT, bool NT = false>
__device__ __forceinline__ void store_nat_bf16(const f32x4 (&acc)[2][2][4][2], bf16_t* O, int ldc, int row0, int colt, int wc, int fq, const float* bias) {
    const int col0 = colt + wc * 32 + 8 * fq;
    f32x4 bv[2][2];
#pragma unroll
    for (int bj = 0; bj < 2; ++bj)
#pragma unroll
        for (int n = 0; n < 2; ++n) bv[bj][n] = bias ? *(const f32x4*)(bias + col0 + bj * HALF + 4 * n) : (f32x4){0.f, 0.f, 0.f, 0.f};
#pragma unroll
    for (int ai = 0; ai < 2; ++ai)
#pragma unroll
        for (int m = 0; m < 4; ++m) { bf16_t* rowp = O + (size_t)(row0 + ai * HALF + m * 16) * ldc + col0;
#pragma unroll
            for (int bj = 0; bj < 2; ++bj) { f32x4 v0 = acc[ai][bj][m][0] + bv[bj][0], v1 = acc[ai][bj][m][1] + bv[bj][1];
                if (ACT >= 1) {
#pragma unroll
                    for (int e = 0; e < 4; ++e) { v0[e] = sigm(v0[e]); v1[e] = sigm(v1[e]); }
                    if (ACT == 2) { v0 = v0 * 0.6065306597f; v1 = v1 * 0.6065306597f; } }
                if (NT) __builtin_nontemporal_store(pack8(v0, v1), (u32x4*)(rowp + bj * HALF)); else *(u32x4*)(rowp + bj * HALF) = pack8(v0, v1); } }
}

struct EpiSwiglu {
    static constexpr bool PERM = true, AFTER_DRAIN = false;
    bf16_t* O; int ldc;
    __device__ __forceinline__ void operator()(const f32x4 (&acc)[2][2][4][2], const Unit& u, int wr, int wc, int fr, int fq) const {
        const int row0 = u.pm * BM + wr * 64 + fr, col0 = u.pn * HALF + wc * 32 + 8 * fq;
#pragma unroll
        for (int ai = 0; ai < 2; ++ai)
#pragma unroll
            for (int m = 0; m < 4; ++m) { bf16_t* rowp = O + (size_t)(row0 + ai * HALF + m * 16) * ldc + col0;
                f32x4 v0, v1;
#pragma unroll
                for (int e = 0; e < 4; ++e) { const float g0 = acc[ai][0][m][0][e], g1 = acc[ai][0][m][1][e];
                    v0[e] = g0 * sigm(g0) * acc[ai][1][m][0][e]; v1[e] = g1 * sigm(g1) * acc[ai][1][m][1][e]; }
                *(u32x4*)rowp = pack8(v0, v1); }
    }
};

struct EpiF32 {
    static constexpr bool PERM = true, AFTER_DRAIN = false;
    float* O; int ldc;
    __device__ __forceinline__ void operator()(const f32x4 (&acc)[2][2][4][2], const Unit& u, int wr, int wc, int fr, int fq) const {
        const int row0 = u.pm * BM + wr * 64 + fr, col0 = u.pn * BM + wc * 32 + 8 * fq;
#pragma unroll
        for (int ai = 0; ai < 2; ++ai)
#pragma unroll
            for (int m = 0; m < 4; ++m) { float* rowp = O + (size_t)(row0 + ai * HALF + m * 16) * ldc + col0;
#pragma unroll
                for (int bj = 0; bj < 2; ++bj) { *(f32x4*)(rowp + bj * HALF) = acc[ai][bj][m][0]; *(f32x4*)(rowp + bj * HALF + 4) = acc[ai][bj][m][1]; } }
    }
};

struct EpiB16 {
    static constexpr bool PERM = true, AFTER_DRAIN = false;
    bf16_t* O; int ldc;
    __device__ __forceinline__ void operator()(const f32x4 (&acc)[2][2][4][2], const Unit& u, int wr, int wc, int fr, int fq) const {
        store_nat_bf16<0>(acc, O, ldc, u.pm * BM + wr * 64 + fr, u.pn * BM, wc, fq, nullptr);
    }
};

struct EpiIn {
    static constexpr bool PERM = true, AFTER_DRAIN = false;
    bf16_t *RW, *Q, *K, *V, *GATES; float* LR; const float* rope; float qscale;
    __device__ __forceinline__ void operator()(const f32x4 (&acc)[2][2][4][2], const Unit& u, int wr, int wc, int fr, int fq) const {
        const int pn = u.pn, row0 = u.pm * BM + wr * 64 + fr;
        if (pn < 12) store_nat_bf16<0>(acc, RW, 3072, row0, pn * 256, wc, fq, nullptr);
        else if (pn < 14) {
            const int col0 = (pn - 12) * 256 + wc * 32 + 8 * fq;
#pragma unroll
            for (int ai = 0; ai < 2; ++ai)
#pragma unroll
                for (int m = 0; m < 4; ++m) { float* rowp = LR + (size_t)(row0 + ai * HALF + m * 16) * 512 + col0;
#pragma unroll
                    for (int bj = 0; bj < 2; ++bj) { *(f32x4*)(rowp + bj * HALF) = acc[ai][bj][m][0]; *(f32x4*)(rowp + bj * HALF + 4) = acc[ai][bj][m][1]; } }
        } else if (pn < 22) {
            const bool isk = pn >= 18; bf16_t* base = isk ? K : Q; const float sc = isk ? 1.0f : qscale;
            const int head = 4 * ((pn - 14) & 3) + wc;
#pragma unroll
            for (int ai = 0; ai < 2; ++ai)
#pragma unroll
                for (int m = 0; m < 4; ++m) { const int row = row0 + ai * HALF + m * 16; const float* cp = rope + (size_t)(row & 2047) * 64 + 8 * fq;
                    const f32x4 c0 = *(const f32x4*)cp, c1 = *(const f32x4*)(cp + 4), s0 = *(const f32x4*)(cp + 32), s1 = *(const f32x4*)(cp + 36);
                    const f32x4 x1a = acc[ai][0][m][0], x1b = acc[ai][0][m][1], x2a = acc[ai][1][m][0], x2b = acc[ai][1][m][1];
                    const f32x4 o1a = (x1a * c0 - x2a * s0) * sc, o1b = (x1b * c1 - x2b * s1) * sc, o2a = (x2a * c0 + x1a * s0) * sc, o2b = (x2b * c1 + x1b * s1) * sc;
                    bf16_t* rowp = base + (size_t)row * 1024 + head * 64 + 8 * fq;
                    *(u32x4*)rowp = pack8(o1a, o1b); *(u32x4*)(rowp + 32) = pack8(o2a, o2b); }
        } else if (pn < 26) store_nat_bf16<0>(acc, V, 1024, row0, (pn - 22) * 256, wc, fq, nullptr);
        else store_nat_bf16<1, true>(acc, GATES, 4096, row0, (pn - 26) * 256, wc, fq, nullptr);
    }
};

struct EpiLora {
    static constexpr bool PERM = true, AFTER_DRAIN = false;
    bf16_t* EAG; bf16_t* GG; const float* w0; const float* a0;
    __device__ __forceinline__ void operator()(const f32x4 (&acc)[2][2][4][2], const Unit& u, int wr, int wc, int fr, int fq) const {
        const int ob = u.pn >> 2, colt = (u.pn & 3) * 256, row0 = u.pm * BM + wr * 64 + fr;
        bf16_t* O = EAG + (size_t)ob * 8192 * 1024;
        if (ob < 2) store_nat_bf16<2>(acc, O, 1024, row0, colt, wc, fq, w0 + ob * 1024);
        else if (ob < 4) store_nat_bf16<1>(acc, O, 1024, row0, colt, wc, fq, a0 + (ob - 2) * 1024);
        else store_nat_bf16<0>(acc, GG, 1024, row0, colt, wc, fq, nullptr);
    }
};

struct EpiBranch {
    static constexpr bool PERM = true, AFTER_DRAIN = false;
    float* P; bf16_t* MERGED; const bf16_t* GATES;
    __device__ __forceinline__ void operator()(const f32x4 (&acc)[2][2][4][2], const Unit& u, int wr, int wc, int fr, int fq) const {
        const int row0 = u.pm * BM + wr * 64 + fr, col0 = u.pn * BM + wc * 32 + 8 * fq;
#pragma unroll
        for (int ai = 0; ai < 2; ++ai)
#pragma unroll
            for (int m = 0; m < 4; ++m) { const size_t row = (size_t)(row0 + ai * HALF + m * 16);
#pragma unroll
                for (int bj = 0; bj < 2; ++bj) { const int col = col0 + bj * HALF;
                    const u32x4 gw = *(const u32x4*)(GATES + row * 4096 + u.sel * 2048 + col);
                    const f32x4 v0 = acc[ai][bj][m][0] * unpk_lo(gw), v1 = acc[ai][bj][m][1] * unpk_hi(gw);
                    float* pp = P + row * 2048 + col;
                    if (u.sel == 0) { *(f32x4*)pp = v0; *(f32x4*)(pp + 4) = v1; }
                    else { const f32x4 p0 = *(const f32x4*)pp, p1 = *(const f32x4*)(pp + 4); *(u32x4*)(MERGED + row * 2048 + col) = pack8(p0 + v0, p1 + v1); } } }
    }
};
struct LoraOrder {
    StaticOrder so;
    __host__ __device__ bool next(int i, Unit& u) const { if (!so.next(i, u)) return false; const int ob = u.pn >> 2; u.kbeg = ob < 2 ? 0 : (ob < 4 ? 128 : 256); u.nt = ob < 4 ? 2 : 4; return true; }
    __device__ __forceinline__ void a_ready(const Unit&) const {}
    __device__ __forceinline__ void done(const Unit&) const {}
};
struct BranchOrder {
    StaticOrder so;
    __host__ __device__ bool next(int i, Unit& u) const { if (!so.next(i >> 1, u)) return false; u.sel = i & 1; return true; }
    __device__ __forceinline__ void a_ready(const Unit&) const {}
    __device__ __forceinline__ void done(const Unit&) const {}
};
template <class Epi, class Sched, bool ALIGN_EPI = false, bool SP2 = false>
__device__ __forceinline__ void gemm_phase(PG8_LAS unsigned char* lds, const Gemm g, const Sched& S, const Epi& E) {
    int tid = threadIdx.x; asm volatile("" : "+v"(tid));
    const int wid = __builtin_amdgcn_readfirstlane(tid >> 6), lane = tid & 63, wr = wid >> 2, wc = wid & 3, fr = lane & 15, fq = lane >> 4;
    const int K = g.K, nt = K / BK;
    unsigned voffA[2], voffB[2];
#pragma unroll
    for (int i = 0; i < 2; ++i) { int R, C; stage_rc(tid * 16 + i * 8192, R, C); const int Rb = Epi::PERM ? ((R & ~31) + perm32(R & 31)) : R;
        voffA[i] = (unsigned)(R * K + C) * 2u; voffB[i] = (unsigned)(Rb * K + C) * 2u; }
    const size_t kstep = (size_t)(BK * 2);
    const size_t hstep = (size_t)HALF * K * 2;
    const size_t tstep = 2 * hstep;
    const unsigned ldsw = (unsigned)wid * 1024u;
    const int aoff = lds_byte(wr * 64 + fr, fq * 8), boff = lds_byte(wc * 32 + fr, fq * 8);
#define PG8_SA(b, h) (((b) * 2 + (h)) * HTB)
#define PG8_SB(b, h) ((4 + (b) * 2 + (h)) * HTB)
#define PG8_STAGE(bufoff, gbase, voff) do { _Pragma("unroll") for (int _i = 0; _i < 2; ++_i) \
        __builtin_amdgcn_global_load_lds((const unsigned*)((const char*)(gbase) + (voff)[_i]), (PG8_LAS unsigned*)(lds + (bufoff) + ldsw + _i * 8192), 16, 0, 0); } while (0)
#define PG8_LDA(dst, b, h) do { _Pragma("unroll") for (int m = 0; m < 4; ++m) _Pragma("unroll") for (int k = 0; k < 2; ++k) dst[m][k] = *(const PG8_LAS bf16x8*)(lds + PG8_SA(b, h) + aoff + m * 2048 + k * 1024); } while (0)
#define PG8_LDB(dst, b, h) do { _Pragma("unroll") for (int n = 0; n < 2; ++n) _Pragma("unroll") for (int k = 0; k < 2; ++k) dst[n][k] = *(const PG8_LAS bf16x8*)(lds + PG8_SB(b, h) + boff + n * 2048 + k * 1024); } while (0)
#define PG8_MMA(ai, bj, At, Bt) do { __builtin_amdgcn_s_setprio(1); _Pragma("unroll") for (int m = 0; m < 4; ++m) _Pragma("unroll") for (int n = 0; n < 2; ++n) _Pragma("unroll") for (int k = 0; k < 2; ++k) \
        acc[ai][bj][m][n] = __builtin_amdgcn_mfma_f32_16x16x32_bf16(Bt[n][k], At[m][k], acc[ai][bj][m][n], 0, 0, 0); __builtin_amdgcn_s_setprio(0); } while (0)
#define PG8_WAIT_V(n) asm volatile("s_waitcnt vmcnt(" #n ")" ::: "memory")
#define PG8_WAIT_L(n) asm volatile("s_waitcnt lgkmcnt(" #n ")" ::: "memory")
#define PG8_BAR __builtin_amdgcn_s_barrier()
#define PG8_SCHED __builtin_amdgcn_sched_barrier(0)
    Unit cur, nxt; int ui = 0;
    if (!S.next(0, cur)) return;
    f32x4 acc[2][2][4][2];
#pragma unroll
    for (int a = 0; a < 2; ++a)
#pragma unroll
        for (int b = 0; b < 2; ++b)
#pragma unroll
            for (int m = 0; m < 4; ++m)
#pragma unroll
                for (int n = 0; n < 2; ++n) acc[a][b][m][n] = (f32x4){0.f, 0.f, 0.f, 0.f};
    bf16x8 At[4][2], B0[2][2], B1[2][2];
    const char* cA = (const char*)(cur.sel ? g.A2 : g.A) + (size_t)cur.pm * tstep + (size_t)cur.kbeg * 2; const char* cB = (const char*)(cur.sel ? g.Bt2 : g.Bt) + (size_t)cur.pn * tstep + (size_t)cur.kbeg * 2;
    int nt_cur = cur.nt ? cur.nt : nt;
    S.a_ready(cur);
    if constexpr (SP2) {
        PG8_STAGE(PG8_SB(0, 0), cB, voffB); PG8_STAGE(PG8_SB(0, 1), cB + hstep, voffB); PG8_STAGE(PG8_SA(0, 0), cA, voffA); PG8_STAGE(PG8_SA(0, 1), cA + hstep, voffA);
        if (wr == 1) PG8_BAR;
        PG8_WAIT_V(2); PG8_BAR;
        PG8_STAGE(PG8_SB(1, 0), cB + kstep, voffB); PG8_STAGE(PG8_SA(1, 0), cA + kstep, voffA); PG8_STAGE(PG8_SB(1, 1), cB + hstep + kstep, voffB);
        PG8_WAIT_V(6); PG8_BAR;
    } else {
        PG8_STAGE(PG8_SB(0, 0), cB, voffB); PG8_STAGE(PG8_SA(0, 0), cA, voffA); PG8_STAGE(PG8_SB(0, 1), cB + hstep, voffB); PG8_STAGE(PG8_SA(0, 1), cA + hstep, voffA);
        if (wr == 1) PG8_BAR;
        PG8_WAIT_V(4); PG8_BAR;
        PG8_STAGE(PG8_SB(1, 0), cB + kstep, voffB); PG8_STAGE(PG8_SA(1, 0), cA + kstep, voffA); PG8_STAGE(PG8_SB(1, 1), cB + hstep + kstep, voffB);
        PG8_WAIT_V(6); PG8_BAR;
    }
    for (;;) {
        const bool has_next = S.next(ui + 1, nxt);
        const char* nA = has_next ? (const char*)(nxt.sel ? g.A2 : g.A) + (size_t)nxt.pm * tstep + (size_t)nxt.kbeg * 2 : cA; const char* nB = has_next ? (const char*)(nxt.sel ? g.Bt2 : g.Bt) + (size_t)nxt.pn * tstep + (size_t)nxt.kbeg * 2 : cB;
        for (int t = 0; t < nt_cur; t += 2) {
            const bool last = (t == nt_cur - 2);
            const char* a1 = cA + (size_t)(t + 1) * kstep;
            const char* a2 = last ? nA : cA + (size_t)(t + 2) * kstep; const char* b2 = last ? nB : cB + (size_t)(t + 2) * kstep;
            const char* a3 = a2 + kstep; const char* b3 = b2 + kstep;
            if (last && has_next) S.a_ready(nxt);
            if constexpr (SP2) {
            PG8_LDB(B0, 0, 0); PG8_LDB(B1, 0, 1); PG8_SCHED; PG8_LDA(At, 0, 0); PG8_STAGE(PG8_SA(1, 1), a1 + hstep, voffA);
            PG8_WAIT_V(8); PG8_WAIT_L(0); PG8_BAR; PG8_MMA(0, 0, At, B0); PG8_MMA(0, 1, At, B1); PG8_BAR; PG8_SCHED;
            PG8_LDA(At, 0, 1); PG8_STAGE(PG8_SB(0, 0), b2, voffB); PG8_STAGE(PG8_SB(0, 1), b2 + hstep, voffB); PG8_STAGE(PG8_SA(0, 0), a2, voffA);
            PG8_WAIT_V(8); PG8_WAIT_L(0); PG8_BAR; PG8_MMA(1, 0, At, B0); PG8_MMA(1, 1, At, B1); PG8_BAR; PG8_SCHED;
            PG8_LDB(B0, 1, 0); PG8_LDB(B1, 1, 1); PG8_SCHED; PG8_LDA(At, 1, 0); PG8_STAGE(PG8_SA(0, 1), a2 + hstep, voffA);
            PG8_WAIT_V(8); PG8_WAIT_L(0); PG8_BAR; PG8_MMA(0, 0, At, B0); PG8_MMA(0, 1, At, B1); PG8_BAR; PG8_SCHED;
            PG8_LDA(At, 1, 1); PG8_STAGE(PG8_SB(1, 0), b3, voffB); PG8_STAGE(PG8_SB(1, 1), b3 + hstep, voffB); PG8_STAGE(PG8_SA(1, 0), a3, voffA);
            PG8_WAIT_V(8); PG8_WAIT_L(0); PG8_BAR; PG8_MMA(1, 0, At, B0); PG8_MMA(1, 1, At, B1); PG8_BAR; PG8_SCHED;
            } else {
            PG8_LDB(B0, 0, 0); PG8_SCHED; PG8_LDA(At, 0, 0); PG8_STAGE(PG8_SA(1, 1), a1 + hstep, voffA);
            PG8_WAIT_L(8); PG8_BAR; PG8_WAIT_L(0); PG8_MMA(0, 0, At, B0); PG8_BAR; PG8_SCHED;
            PG8_LDB(B1, 0, 1); PG8_STAGE(PG8_SB(0, 0), b2, voffB);
            PG8_BAR; PG8_WAIT_L(0); PG8_MMA(0, 1, At, B1); PG8_BAR;
            PG8_LDA(At, 0, 1); PG8_STAGE(PG8_SA(0, 0), a2, voffA);
            PG8_BAR; PG8_WAIT_L(0); PG8_MMA(1, 0, At, B0); PG8_BAR; PG8_SCHED;
            PG8_STAGE(PG8_SB(0, 1), b2 + hstep, voffB);
            PG8_WAIT_V(6); PG8_BAR; PG8_MMA(1, 1, At, B1); PG8_BAR;
            PG8_LDB(B0, 1, 0); PG8_SCHED; PG8_LDA(At, 1, 0); PG8_STAGE(PG8_SA(0, 1), a2 + hstep, voffA);
            PG8_WAIT_L(8); PG8_BAR; PG8_WAIT_L(0); PG8_MMA(0, 0, At, B0); PG8_BAR; PG8_SCHED;
            PG8_LDB(B1, 1, 1); PG8_STAGE(PG8_SB(1, 0), b3, voffB);
            PG8_BAR; PG8_WAIT_L(0); PG8_MMA(0, 1, At, B1); PG8_BAR;
            PG8_LDA(At, 1, 1); PG8_STAGE(PG8_SA(1, 0), a3, voffA);
            PG8_BAR; PG8_WAIT_L(0); PG8_MMA(1, 0, At, B0); PG8_BAR; PG8_SCHED;
            PG8_STAGE(PG8_SB(1, 1), b3 + hstep, voffB);
            PG8_WAIT_V(6); PG8_BAR; PG8_MMA(1, 1, At, B1); PG8_BAR;
            }
        }
        if constexpr (ALIGN_EPI) { if (wr == 0) PG8_BAR; }
        if constexpr (!Epi::AFTER_DRAIN) { E(acc, cur, wr, wc, fr, fq); S.done(cur); }
        if (!has_next) break;
#pragma unroll
        for (int a = 0; a < 2; ++a)
#pragma unroll
            for (int b = 0; b < 2; ++b)
#pragma unroll
                for (int m = 0; m < 4; ++m)
#pragma unroll
                    for (int n = 0; n < 2; ++n) acc[a][b][m][n] = (f32x4){0.f, 0.f, 0.f, 0.f};
        cur = nxt; cA = nA; cB = nB; ++ui; nt_cur = cur.nt ? cur.nt : nt;
        if constexpr (ALIGN_EPI) { if (wr == 1) PG8_BAR; }
    }
    PG8_WAIT_V(0);
    if constexpr (!ALIGN_EPI) { if (wr == 0) PG8_BAR; }
    PG8_BAR;
    if constexpr (Epi::AFTER_DRAIN) { E.fused(acc, cur, wr, wc, fr, fq, lds, wid, lane); S.done(cur); }
#undef PG8_SA
#undef PG8_SB
#undef PG8_STAGE
#undef PG8_LDA
#undef PG8_LDB
#undef PG8_MMA
#undef PG8_WAIT_V
#undef PG8_WAIT_L
#undef PG8_BAR
#undef PG8_SCHED
}
}

#include <hip/hip_bf16.h>
#include <cmath>
namespace attn_body {
using bf16=__hip_bfloat16;
using bf16x8=__attribute__((ext_vector_type(8)))short;
using s16x4=__attribute__((ext_vector_type(4)))short;
using f32x16=__attribute__((ext_vector_type(16)))float;
using u32x4=__attribute__((ext_vector_type(4)))unsigned;
constexpr int BATCH=4,NHEAD=16,SEQ=2048,D=64,DM=NHEAD*D,OPITCH=2048;
constexpr int NW=8,QBLK=32,QB=QBLK*NW,KVBLK=64,NQB=SEQ/QB;
constexpr int ATTN_PITCH=DM, ATTN_UNIT_ROWS=QB;
__device__ __forceinline__ int crow(int r,int hi){return (r&3)+8*(r>>2)+4*hi;}
#define SBAR() __builtin_amdgcn_sched_barrier(0)
__device__ __forceinline__ void cmask(f32x16&p0,f32x16&p1,int jb,int qrel,int hi){
  const float NEG=-INFINITY; int kb=64*jb+4*hi;
  #pragma unroll
  for(int r=0;r<16;++r){int kv=kb+(r&3)+8*(r>>2); if(kv>qrel)p0[r]=NEG; if(kv+32>qrel)p1[r]=NEG;}
}

constexpr int NSLOT=3, SLOTB=8192;
constexpr int LDS_K=0, LDS_V=NSLOT*SLOTB, LDS_WS=2*NSLOT*SLOTB, LDS_OST=LDS_WS+NW*64*4, LDS_BYTES=LDS_OST+NW*4096;
constexpr float C2=0.125f*1.4426950408889634f;
__device__ __forceinline__ void glds16(const void*gsrc,unsigned lds_dst){unsigned keep;
  asm volatile("s_mov_b32 %0, m0\n\ts_mov_b32 m0, %2\n\ts_nop 0\n\tglobal_load_lds_dwordx4 %1, off\n\ts_mov_b32 m0, %0":"=&s"(keep):"v"(gsrc),"s"(lds_dst):"memory");}
__device__ __forceinline__ float max3f(float a,float b,float c){float r;asm("v_max3_f32 %0, %1, %2, %3":"=v"(r):"v"(a),"v"(b),"v"(c));return r;}
__device__ __forceinline__ float max2f(float a,float b){float r;asm("v_max_f32_e32 %0, %1, %2":"=v"(r):"v"(a),"v"(b));return r;}
__device__ __forceinline__ float fadd_s(float a,float b){float r;asm("v_add_f32_e32 %0, %1, %2":"=v"(r):"v"(a),"v"(b));return r;}
__device__ __forceinline__ float fsub_s(float a,float b){float r;asm("v_sub_f32_e32 %0, %1, %2":"=v"(r):"v"(a),"v"(b));return r;}
typedef float f32x2_t __attribute__((ext_vector_type(2))); typedef __bf16 bf16x2_t __attribute__((ext_vector_type(2)));
__device__ __forceinline__ unsigned cvtpk_s(float lo,float hi){f32x2_t v={lo,hi};bf16x2_t b=__builtin_convertvector(v,bf16x2_t);return __builtin_bit_cast(unsigned,b);}
#define WAIT_BAR(N) asm volatile("s_waitcnt vmcnt(" #N ") lgkmcnt(0)\n\ts_barrier":::"memory")

__device__ __forceinline__ void qkt(f32x16&p0,f32x16&p1,const char*Kslot,const bf16x8*qr,const f32x16&negm,int r32,int hi){
  const char*kb=Kslot+hi*1024+r32*16;
  #pragma unroll
  for(int d0=0;d0<4;++d0){
    const bf16x8 b0=*reinterpret_cast<const bf16x8*>(kb+d0*2048);
    const bf16x8 b1=*reinterpret_cast<const bf16x8*>(kb+d0*2048+512);
    if(d0==0){p0=__builtin_amdgcn_mfma_f32_32x32x16_bf16(b0,qr[0],negm,0,0,0);p1=__builtin_amdgcn_mfma_f32_32x32x16_bf16(b1,qr[0],negm,0,0,0);}
    else{p0=__builtin_amdgcn_mfma_f32_32x32x16_bf16(b0,qr[d0],p0,0,0,0);p1=__builtin_amdgcn_mfma_f32_32x32x16_bf16(b1,qr[d0],p1,0,0,0);}}
}
typedef __attribute__((address_space(3))) const char* lds_cptr;
typedef short v4i16_t __attribute__((ext_vector_type(4)));
__device__ __forceinline__ void kload8(bf16x8*kf,lds_cptr kp){
  kf[0]=*(const __attribute__((address_space(3))) bf16x8*)(kp);      kf[1]=*(const __attribute__((address_space(3))) bf16x8*)(kp+512);
  kf[2]=*(const __attribute__((address_space(3))) bf16x8*)(kp+2048); kf[3]=*(const __attribute__((address_space(3))) bf16x8*)(kp+2560);
  kf[4]=*(const __attribute__((address_space(3))) bf16x8*)(kp+4096); kf[5]=*(const __attribute__((address_space(3))) bf16x8*)(kp+4608);
  kf[6]=*(const __attribute__((address_space(3))) bf16x8*)(kp+6144); kf[7]=*(const __attribute__((address_space(3))) bf16x8*)(kp+6656);
}
__device__ __forceinline__ void kload2(bf16x8*kf,lds_cptr kp,int j){ kf[2*j]=*(const __attribute__((address_space(3))) bf16x8*)(kp+j*2048); kf[2*j+1]=*(const __attribute__((address_space(3))) bf16x8*)(kp+j*2048+512); }
__device__ __forceinline__ s16x4 vtr(lds_cptr p){ return __builtin_bit_cast(s16x4,__builtin_amdgcn_ds_read_tr16_b64_v4i16((__attribute__((address_space(3))) v4i16_t*)p)); }
__device__ __forceinline__ float rowmax(const f32x16&p0,const f32x16&p1){
  float a=max3f(p0[0],p0[1],p1[0]),b=max3f(p0[2],p0[3],p1[1]);a=max3f(a,p1[2],p1[3]);
  #pragma unroll
  for(int r=4;r<16;r+=4){a=max3f(a,p0[r],p0[r+1]);b=max3f(b,p0[r+2],p0[r+3]);a=max3f(a,p1[r],p1[r+1]);b=max3f(b,p1[r+2],p1[r+3]);}
  const float m=max2f(a,b);
  auto rr=__builtin_amdgcn_permlane32_swap(__float_as_uint(m),__float_as_uint(m),false,false);
  return max2f(__uint_as_float(rr[0]),__uint_as_float(rr[1]));
}
__device__ __forceinline__ void pv(f32x16*o,int vb,bf16x8 pa0,bf16x8 pa1,bf16x8 pa2,bf16x8 pa3){
  #pragma unroll
  for(int d0=0;d0<2;++d0){s16x4 lo[4],hi[4];
    #pragma unroll
    for(int ks=0;ks<4;++ks){
      asm volatile("ds_read_b64_tr_b16 %0,%1 offset:%c2":"=&v"(lo[ks]):"v"(vb),"i"(d0*4096+ks*1024):"memory");
      asm volatile("ds_read_b64_tr_b16 %0,%1 offset:%c2":"=&v"(hi[ks]):"v"(vb),"i"(d0*4096+ks*1024+512):"memory");}
    asm volatile("s_waitcnt lgkmcnt(0)":::"memory");SBAR();
    #define PK(k) (bf16x8){lo[k][0],lo[k][1],lo[k][2],lo[k][3],hi[k][0],hi[k][1],hi[k][2],hi[k][3]}
    o[d0]=__builtin_amdgcn_mfma_f32_32x32x16_bf16(pa0,PK(0),o[d0],0,0,0);
    o[d0]=__builtin_amdgcn_mfma_f32_32x32x16_bf16(pa1,PK(1),o[d0],0,0,0);
    o[d0]=__builtin_amdgcn_mfma_f32_32x32x16_bf16(pa2,PK(2),o[d0],0,0,0);
    o[d0]=__builtin_amdgcn_mfma_f32_32x32x16_bf16(pa3,PK(3),o[d0],0,0,0);
    #undef PK
  }
}

#ifndef ATTN_STORE16
#define ATTN_STORE16(p,v) (*(u32x4*)(p)=(v))
#endif
template<int THRL> __device__ __forceinline__ void attn_unit(int b,int h,int vcol,int ocol,int qb,const bf16*Q,const bf16*__restrict__ K,const bf16*__restrict__ V,bf16*O,char*shm){
  int tid=threadIdx.x; asm volatile("":"+v"(tid)); const int lane=tid&63,r32=lane&31,hi=lane>>5; const int wid=__builtin_amdgcn_readfirstlane(tid>>6);
  const long rowbase=(long)b*SEQ; const int q0=qb*QB;
  const bf16*Qw=Q+(rowbase+q0+wid*QBLK)*DM+h*D;
  const bf16*Kh=K+rowbase*DM+h*D,*Vh=V+rowbase*DM+vcol;
  const unsigned lds0=(unsigned)(uintptr_t)shm;
  float*wsf=(float*)(shm+LDS_WS)+wid*64;
  const bf16*ksrc=Kh+(long)lane*DM+wid*8;
  const bf16*vsrc=Vh+(long)(16*(wid&3)+(lane>>2))*DM+(wid>>2)*32+(lane&3)*8;
  const unsigned kdst=lds0+LDS_K+wid*1024, vdst=lds0+LDS_V+wid*1024;
  #define DMA_K(t,slot) glds16(ksrc+(long)(t)*KVBLK*DM,(unsigned)__builtin_amdgcn_readfirstlane(kdst+(slot)))
  #define DMA_V(t,slot) glds16(vsrc+(long)(t)*KVBLK*DM,(unsigned)__builtin_amdgcn_readfirstlane(vdst+(slot)))
  const int vb0=(int)(lds0+LDS_V)+((lane>>4)&1)*32+(lane&3)*8+(4*hi+((lane&15)>>2))*64;
  const char*Kbase=shm+LDS_K; bf16x8 kf[8];
  const lds_cptr shm3=(lds_cptr)shm; const lds_cptr kp0=shm3+LDS_K+hi*1024+r32*16; const lds_cptr vp0=shm3+LDS_V+((lane>>4)&1)*32+(lane&3)*8+(4*hi+((lane&15)>>2))*64;
  const int NT=SEQ/KVBLK;
  DMA_K(0,0);DMA_V(0,0);DMA_K(1,SLOTB);
  bf16x8 qr[4];
  #pragma unroll
  for(int d0=0;d0<4;++d0)qr[d0]=*reinterpret_cast<const bf16x8*>(&Qw[(long)r32*DM+d0*16+hi*8]);
  float mhat=0.f,l_reg=0.f;f32x16 o[2];o[0]=f32x16{};o[1]=f32x16{};f32x16 negm=f32x16{};asm volatile("":"+v"(negm));
  const int qrel=wid*QBLK+r32;
  #define CMASK(P0,P1,t) do{}while(0)
  bool resc=false;
  #define START(P0,P1) do{ const float rm=rowmax(P0,P1); resc=false; \
    { const float dl=rm; mhat=fadd_s(mhat,dl); \
      _Pragma("unroll") for(int r=0;r<16;++r){P0[r]=fsub_s(P0[r],dl);P1[r]=fsub_s(P1[r],dl);} \
      _Pragma("unroll") for(int r=0;r<16;++r)negm[r]=-mhat; asm volatile("":"+v"(negm)); } \
    _Pragma("unroll") for(int r=0;r<16;++r)P0[r]=__builtin_amdgcn_exp2f(P0[r]); }while(0)
  #define RESC() do{ if(resc){ asm volatile("s_waitcnt lgkmcnt(0)":::"memory"); \
      _Pragma("unroll") for(int d_=0;d_<2;++d_) _Pragma("unroll") for(int r=0;r<16;++r)o[d_][r]*=wsf[crow(r,hi)]; } }while(0)
  f32x16 pA0,pA1,pB0,pB1;
  int sl_prev=0,sl_cur=0,sl_next=SLOTB;
  #define ROT() do{sl_prev=sl_cur;sl_cur=sl_next;sl_next=(sl_next==(NSLOT-1)*SLOTB)?0:sl_next+SLOTB;}while(0)
  DMA_K(2,2*SLOTB);
  WAIT_BAR(3);
  qkt(pA0,pA1,Kbase,qr,negm,r32,hi);asm volatile("s_nop 15\n\ts_nop 7":"+v"(pA0),"+v"(pA1));CMASK(pA0,pA1,0);
  START(pA0,pA1);
  _Pragma("unroll") for(int r=0;r<16;++r)pA1[r]=__builtin_amdgcn_exp2f(pA1[r]);
  WAIT_BAR(0);
  DMA_K(3,0);DMA_V(1,SLOTB);
  ROT();
  kload8(kf,kp0+sl_cur);
  WAIT_BAR(2);
  s16x4 vlo[8],vhi[8]; u32x4 pw0,pw1,pw2,pw3;
  #define PKW(P,B) cvtpk_s(P[B],P[B+1])
  #define PAF(k) __builtin_bit_cast(bf16x8,pw##k)
  #define VFR(i) (bf16x8){vlo[i][0],vlo[i][1],vlo[i][2],vlo[i][3],vhi[i][0],vhi[i][1],vhi[i][2],vhi[i][3]}
  #define PIN(x) asm volatile("":"+v"(x))
  #define MX3(a,b,c) __builtin_fmaxf(__builtin_fmaxf((a),(b)),(c))
  #define GAPA(MF,A0,A1,A2,A3,W0,W1,PW) do{ MF; sacc+=A0; sacc+=A1; sacc+=A2; sacc+=A3; PIN(sacc); W0; W1; PIN(PW); SBAR(); }while(0)
  #define EX(v) __builtin_amdgcn_exp2f(v)
  #define GAPB(MF,X,B) do{ MF; X[B]=EX(X[B]); X[B+1]=EX(X[B+1]); X[B+2]=EX(X[B+2]); X[B+3]=EX(X[B+3]); PIN(X); SBAR(); }while(0)
  #define VRD(i) do{ vlo[i]=vtr(vp_+(((i)>>2)*4096+((i)&3)*1024)); vhi[i]=vtr(vp_+(((i)>>2)*4096+((i)&3)*1024+512)); }while(0)
  #define KRD(G,j) do{ if(G){ kload2(kf,kp0+sl_next,j); SBAR(); } }while(0)
  #define STEP(C0,C1,P0,P1,t,GK,GV,GL) do{ SBAR(); \
    const lds_cptr vp_=vp0+sl_prev; \
    VRD(0); SBAR(); float sacc=(P0[0]+P0[1]); \
    GAPA(C0=__builtin_amdgcn_mfma_f32_32x32x16_bf16(kf[0],qr[0],negm,0,0,0), P0[2],P0[3],P0[4],P0[5],     pw0[0]=PKW(P0,0), pw0[1]=PKW(P0,2), pw0); \
    VRD(4); SBAR(); GAPA(C1=__builtin_amdgcn_mfma_f32_32x32x16_bf16(kf[1],qr[0],negm,0,0,0), P0[6],P0[7],P0[8],P0[9],     pw0[2]=PKW(P0,4), pw0[3]=PKW(P0,6), pw0); \
    VRD(1); SBAR(); GAPA(C0=__builtin_amdgcn_mfma_f32_32x32x16_bf16(kf[2],qr[1],C0,0,0,0),   P0[10],P0[11],P0[12],P0[13], pw1[0]=PKW(P0,8), pw1[1]=PKW(P0,10), pw1); \
    VRD(5); SBAR(); GAPA(C1=__builtin_amdgcn_mfma_f32_32x32x16_bf16(kf[3],qr[1],C1,0,0,0),   P0[14],P0[15],P1[0],P1[1],   pw1[2]=PKW(P0,12),pw1[3]=PKW(P0,14), pw1); \
    VRD(2); SBAR(); GAPA(C0=__builtin_amdgcn_mfma_f32_32x32x16_bf16(kf[4],qr[2],C0,0,0,0),   P1[2],P1[3],P1[4],P1[5],     pw2[0]=PKW(P1,0), pw2[1]=PKW(P1,2), pw2); \
    VRD(6); SBAR(); GAPA(C1=__builtin_amdgcn_mfma_f32_32x32x16_bf16(kf[5],qr[2],C1,0,0,0),   P1[6],P1[7],P1[8],P1[9],     pw2[2]=PKW(P1,4), pw2[3]=PKW(P1,6), pw2); \
    VRD(3); SBAR(); GAPA(C0=__builtin_amdgcn_mfma_f32_32x32x16_bf16(kf[6],qr[3],C0,0,0,0),   P1[10],P1[11],P1[12],P1[13], pw3[0]=PKW(P1,8), pw3[1]=PKW(P1,10), pw3); \
    VRD(7); SBAR(); GAPA(C1=__builtin_amdgcn_mfma_f32_32x32x16_bf16(kf[7],qr[3],C1,0,0,0),   P1[14],P1[15],0.f,0.f,       pw3[2]=PKW(P1,12),pw3[3]=PKW(P1,14), pw3); \
    l_reg+=sacc; \
    if(GK){DMA_K((t)+3,sl_cur);} if(GV){DMA_V((t)+1,sl_next);} \
    CMASK(C0,C1,t); \
    { float a=MX3(C0[0],C0[1],C1[0]),b=MX3(C0[2],C0[3],C1[1]); a=MX3(a,C1[2],C1[3]); \
      _Pragma("unroll") for(int r=4;r<16;r+=4){a=MX3(a,C0[r],C0[r+1]);b=MX3(b,C0[r+2],C0[r+3]);a=MX3(a,C1[r],C1[r+1]);b=MX3(b,C1[r+2],C1[r+3]);} \
      float rm=__builtin_fmaxf(a,b); { auto rr=__builtin_amdgcn_permlane32_swap(__float_as_uint(rm),__float_as_uint(rm),false,false); rm=__builtin_fmaxf(__uint_as_float(rr[0]),__uint_as_float(rr[1])); } \
      resc=false; \
      if(__builtin_expect(__any(rm>(float)THRL),0)){ const float dl=__builtin_fmaxf(rm,0.f); mhat+=dl; \
        _Pragma("unroll") for(int r=0;r<16;++r){C0[r]-=dl;C1[r]-=dl;} \
        _Pragma("unroll") for(int r=0;r<16;++r)negm[r]=-mhat; asm volatile("":"+v"(negm)); \
        const float f=__builtin_amdgcn_exp2f(-dl); l_reg*=f; if(hi==0)wsf[r32]=f; resc=true; } } \
    SBAR(); \
    GAPB(o[0]=__builtin_amdgcn_mfma_f32_32x32x16_bf16(PAF(0),VFR(0),o[0],0,0,0), C0,0); \
    GAPB(o[1]=__builtin_amdgcn_mfma_f32_32x32x16_bf16(PAF(0),VFR(4),o[1],0,0,0), C0,4); \
    KRD(GL,0); GAPB(o[0]=__builtin_amdgcn_mfma_f32_32x32x16_bf16(PAF(1),VFR(1),o[0],0,0,0), C0,8); \
    KRD(GL,1); GAPB(o[1]=__builtin_amdgcn_mfma_f32_32x32x16_bf16(PAF(1),VFR(5),o[1],0,0,0), C0,12); \
    KRD(GL,2); GAPB(o[0]=__builtin_amdgcn_mfma_f32_32x32x16_bf16(PAF(2),VFR(2),o[0],0,0,0), C1,0); \
    KRD(GL,3); GAPB(o[1]=__builtin_amdgcn_mfma_f32_32x32x16_bf16(PAF(2),VFR(6),o[1],0,0,0), C1,4); \
    GAPB(o[0]=__builtin_amdgcn_mfma_f32_32x32x16_bf16(PAF(3),VFR(3),o[0],0,0,0), C1,8); \
    GAPB(o[1]=__builtin_amdgcn_mfma_f32_32x32x16_bf16(PAF(3),VFR(7),o[1],0,0,0), C1,12); \
    }while(0)
  int t=1;
  #undef CMASK
  #define CMASK(P0,P1,t) do{}while(0)
  for(;t+5<NT;t+=2){
    STEP(pB0,pB1,pA0,pA1,t,true,true,true);     WAIT_BAR(2); RESC(); ROT();
    STEP(pA0,pA1,pB0,pB1,t+1,true,true,true);   WAIT_BAR(2); RESC(); ROT();
  }
  #undef CMASK
  #define CMASK(P0,P1,t) do{}while(0)
  #define ENDW(tt) do{ if((tt)+3<NT){WAIT_BAR(2);} else if((tt)+2<NT){WAIT_BAR(1);} else {WAIT_BAR(0);} }while(0)
  for(;t+1<NT;t+=2){
    STEP(pB0,pB1,pA0,pA1,t,(t+3<NT),(t+1<NT),(t+1<NT));       ENDW(t);   RESC(); ROT();
    STEP(pA0,pA1,pB0,pB1,t+1,(t+4<NT),(t+2<NT),(t+2<NT));     ENDW(t+1); RESC(); ROT();
  }
  STEP(pB0,pB1,pA0,pA1,NT-1,false,false,false); RESC();
  { float sacc=pB0[0]+pB0[1]; _Pragma("unroll") for(int r=2;r<16;++r)sacc+=pB0[r]; _Pragma("unroll") for(int r=0;r<16;++r)sacc+=pB1[r]; l_reg+=sacc;
    pw0=(u32x4){PKW(pB0,0),PKW(pB0,2),PKW(pB0,4),PKW(pB0,6)};pw1=(u32x4){PKW(pB0,8),PKW(pB0,10),PKW(pB0,12),PKW(pB0,14)};pw2=(u32x4){PKW(pB1,0),PKW(pB1,2),PKW(pB1,4),PKW(pB1,6)};pw3=(u32x4){PKW(pB1,8),PKW(pB1,10),PKW(pB1,12),PKW(pB1,14)};
    SBAR(); pv(o,vb0+sl_cur,PAF(0),PAF(1),PAF(2),PAF(3)); }
  #undef PKW
  #undef PAF
  #undef VFR
  #undef PIN
  #undef MX3
  #undef GAPA
  #undef GAPB
  #undef EX
  #undef VRD
  #undef KRD
  #undef STEP
  #undef ENDW
  {auto rr=__builtin_amdgcn_permlane32_swap(__float_as_uint(l_reg),__float_as_uint(l_reg),false,false);l_reg=__uint_as_float(rr[0])+__uint_as_float(rr[1]);}
  if(hi==0)wsf[32+r32]=l_reg;asm volatile("s_waitcnt lgkmcnt(0)":::"memory");
  float rli[16];
  #pragma unroll
  for(int r=0;r<16;++r)rli[r]=__builtin_amdgcn_rcpf(wsf[32+crow(r,hi)]);
  bf16*Ow=O+(rowbase+q0+wid*QBLK)*OPITCH+ocol;
  { bf16*stg=(bf16*)(shm+LDS_OST)+wid*2048;
    #pragma unroll
    for(int r=0;r<16;++r){const int orow=crow(r,hi);
      #pragma unroll
      for(int d0=0;d0<2;++d0)stg[orow*64+d0*32+r32]=__float2bfloat16(o[d0][r]*rli[r]);}
    asm volatile("s_waitcnt lgkmcnt(0)":::"memory");
    #pragma unroll
    for(int i=0;i<4;++i){const int row=i*8+(lane>>3),ch=lane&7; const u32x4 v=*(const u32x4*)(stg+row*64+ch*8); ATTN_STORE16(Ow+(long)row*OPITCH+ch*8,v);} }
  asm volatile("s_waitcnt lgkmcnt(0)\n\ts_barrier":::"memory");
  #undef DMA_K
  #undef DMA_V
  #undef CMASK
  #undef START
  #undef RESC
  #undef ROT
}
constexpr int ATTN_LDS_BYTES=LDS_BYTES;
#undef SBAR
#undef WAIT_BAR
}

#define GAS __attribute__((address_space(1)))
#define LAS __attribute__((address_space(3)))
typedef unsigned short bf16;
typedef unsigned v4u __attribute__((ext_vector_type(4)));
typedef float f32x4 __attribute__((ext_vector_type(4)));
typedef short bf16x8 __attribute__((ext_vector_type(8)));
typedef GAS unsigned gu32;
typedef GAS unsigned long long gu64;
#define RLX_AGENT __ATOMIC_RELAXED, __HIP_MEMORY_SCOPE_AGENT
#define LDS_WAIT() asm volatile("s_waitcnt lgkmcnt(0)" ::: "memory")
#define VM_WAIT() asm volatile("s_waitcnt vmcnt(0)" ::: "memory")
__device__ __forceinline__ unsigned long long rt() { return __builtin_amdgcn_s_memrealtime(); }
__device__ __forceinline__ unsigned f2bf(float f) { unsigned u = __builtin_bit_cast(unsigned, f); return (u + 0x7fffu + ((u >> 16) & 1u)) >> 16; }
__device__ __forceinline__ unsigned pk2(float lo, float hi) { return f2bf(lo) | (f2bf(hi) << 16); }

#define XB_TMO      128
#define XB_XCNT(j)  (256  + 64 * (j))
#define XB_XSUB(j)  (1280 + 64 * (j))
#define XB_XGEN(j)  (2304 + 64 * (j))
#define XB_TOP      3328
#define XB_TOPGEN   3392
#define XCD_BAR_WORDS 3456
#define XB_SPIN_CAP (1u << 18)

__device__ __forceinline__ unsigned xb_ld(unsigned* p)              { return __hip_atomic_load(p, __ATOMIC_RELAXED, __HIP_MEMORY_SCOPE_AGENT); }
__device__ __forceinline__ unsigned xb_add(unsigned* p, unsigned v) { return __hip_atomic_fetch_add(p, v, __ATOMIC_RELAXED, __HIP_MEMORY_SCOPE_AGENT); }
__device__ __forceinline__ unsigned xb_xcc_id() { return (unsigned)__builtin_amdgcn_s_getreg((3 << 11) | 20) & 0xFu; }
#define XB_SPIN(cond, bar) do { unsigned _sp = 0; while (cond) { __builtin_amdgcn_s_sleep(1); \
    if ((++_sp & 255u) == 0u) { if (xb_ld(&(bar)[XB_TMO])) break; if (_sp > XB_SPIN_CAP) { atomicAdd(&(bar)[XB_TMO], 1u); break; } } } } while (0)

struct XcdBarrier {
    unsigned* bar; unsigned x;
    volatile LAS unsigned* st;
};

__device__ __forceinline__ XcdBarrier xcd_barrier_post(unsigned* bar, volatile LAS unsigned* st) {
    XcdBarrier b; b.bar = bar; b.x = xb_xcc_id(); b.st = st;
    if (threadIdx.x == 0) (void)xb_add(&bar[XB_XCNT(b.x)], 1u);
    return b;
}
__device__ __forceinline__ void xcd_barrier_complete(unsigned* bar, unsigned x, unsigned& nloc, unsigned& nx) {
    const unsigned G = gridDim.x * gridDim.y * gridDim.z;
    unsigned sum, cnt, mine, sp = 0u;
    for (;;) {
        sum = 0u; cnt = 0u; mine = 0u;
#pragma unroll
        for (unsigned j = 0; j < 16; ++j) { const unsigned c = xb_ld(&bar[XB_XCNT(j)]); sum += c; cnt += (c > 0u) ? 1u : 0u; mine = (j == x) ? c : mine; }
        if (sum == G) break;
        __builtin_amdgcn_s_sleep(1);
        if ((++sp & 255u) == 0u) { if (xb_ld(&bar[XB_TMO])) break; if (sp > XB_SPIN_CAP) { atomicAdd(&bar[XB_TMO], 1u); break; } }
    }
    nloc = mine > 0u ? mine : 1u; nx = cnt > 0u ? cnt : 1u;
}

__device__ __forceinline__ void xcd_barrier(const XcdBarrier& b) {
    asm volatile("s_waitcnt vmcnt(0)" ::: "memory");
    __syncthreads();
    if (threadIdx.x == 0) {
        unsigned* bar = b.bar;
        __builtin_amdgcn_s_waitcnt(0);
        unsigned nloc = b.st[0], nx = b.st[1];
        if (nloc == 0u) { xcd_barrier_complete(bar, b.x, nloc, nx); b.st[0] = nloc; b.st[1] = nx; }
        const unsigned old = xb_add(&bar[XB_XSUB(b.x)], 1u);
        const unsigned gen = old / nloc;
        if (old + 1u == (gen + 1u) * nloc) {
            __builtin_amdgcn_fence(__ATOMIC_RELEASE, "agent");
            asm volatile("s_waitcnt vmcnt(0)" ::: "memory");
            const unsigned og = xb_add(&bar[XB_TOP], 1u);
            const unsigned tg = og / nx;
            if (og + 1u == (tg + 1u) * nx) xb_add(&bar[XB_TOPGEN], 1u);
            else XB_SPIN(xb_ld(&bar[XB_TOPGEN]) == tg, bar);
            __builtin_amdgcn_fence(__ATOMIC_ACQUIRE, "agent");
            xb_add(&bar[XB_XGEN(b.x)], 1u);
            asm volatile("s_waitcnt vmcnt(0)" ::: "memory");
        } else {
            XB_SPIN(xb_ld(&bar[XB_XGEN(b.x)]) == gen, bar);
            __builtin_amdgcn_fence(__ATOMIC_ACQUIRE, "agent");
            asm volatile("s_waitcnt vmcnt(0)" ::: "memory");
        }
    }
    __syncthreads();
}


#ifndef NO_HIDE_CONV
#define HIDE_CONV 1
#endif
constexpr int NWAVES = 8;
constexpr int BATCH = 4, T = 2048, D = 2048, M = BATCH * T, FF = 5632, NGU = 2 * FF;
constexpr int RWC = 3072, IN_COLS = 10656, IN_PAD = 10752, NLORA = 5120, KLORA = 512;
constexpr float NORM_EPS = 1e-6f, GN_EPS = 64e-5f, SUBLN_EPS = 1e-5f, LAM_INIT = 0.2f;
constexpr float QSCALE = 0.125f * 1.4426950408889634f;

constexpr size_t MiB = 1u << 20;
constexpr size_t WS_CTL = 0, CTL_ZERO_BYTES = 1 * MiB;
constexpr size_t WS_ROPE = 1 * MiB;
constexpr size_t WS_WGU = 2 * MiB;
constexpr size_t WS_WDN = 46 * MiB;
constexpr size_t WS_WIN = 68 * MiB;
constexpr size_t WS_WA = 110 * MiB, WS_WB = 114 * MiB;
constexpr size_t WS_WOUT = 118 * MiB;
constexpr size_t WS_WLORA = 126 * MiB;
constexpr size_t WS_XN = 131 * MiB;
constexpr size_t WS_F = 163 * MiB;
constexpr size_t WS_ACT = 227 * MiB;
constexpr size_t WS_RW = 227 * MiB;
constexpr size_t WS_Q = 275 * MiB, WS_K = 291 * MiB, WS_V = 307 * MiB;
constexpr size_t WS_Y = 275 * MiB;
constexpr size_t WS_GATES = 323 * MiB;
constexpr size_t WS_LR = 387 * MiB;
constexpr size_t WS_G = 387 * MiB;
constexpr size_t WS_LA = 403 * MiB;
constexpr size_t WS_OATT = 411 * MiB;
constexpr size_t WS_END = 443 * MiB;
constexpr int CW_BAR = 4096;

constexpr int RING_OFF = 0, RING_BYTES = 131072;
constexpr int LDSCTL_OFF = RING_BYTES, MISC_OFF = LDSCTL_OFF + 320;
constexpr int LDS_BYTES = 147456;

struct Args { const float* in[32]; float* out; unsigned char* ws; int ph_lo, ph_hi, li, pad; };

__device__ __forceinline__ float wave_sum(float v) {
#pragma unroll
    for (int o = 1; o < 64; o <<= 1) v += __shfl_xor(v, o);
    return v;
}
template <int CTRL> __device__ __forceinline__ float dppf(float x) { return __builtin_bit_cast(float, __builtin_amdgcn_mov_dpp(__builtin_bit_cast(int, x), CTRL, 0xf, 0xf, true)); }
__device__ __forceinline__ float red8(float x) { x += dppf<0xB1>(x); x += dppf<0x4E>(x); x += dppf<0x141>(x); return x; }
__device__ __forceinline__ float red16(float x) { x = red8(x); x += dppf<0x128>(x); return x; }
__device__ __forceinline__ float bf2f(unsigned short h) { return __uint_as_float((unsigned)h << 16); }
__device__ __forceinline__ float bfsel(unsigned w, int lane) { return __uint_as_float((lane & 1) ? (w & 0xffff0000u) : (w << 16)); }
__device__ __forceinline__ float sigm_(float x) { return __builtin_amdgcn_rcpf(1.0f + __builtin_amdgcn_exp2f(-1.4426950408889634f * x)); }
typedef unsigned u32x2 __attribute__((ext_vector_type(2)));
__device__ __forceinline__ f32x4 unpk4(const u32x2 w) { return (f32x4){__uint_as_float(w.x << 16), __uint_as_float(w.x & 0xffff0000u), __uint_as_float(w.y << 16), __uint_as_float(w.y & 0xffff0000u)}; }

__device__ __forceinline__ void transpose_item(const float* W, int K, int N, bf16* WT, int k0, int n0, int drow0, LAS float* scr, int lane) {
#pragma unroll 8
    for (int i = 0; i < 32; ++i) { const int kk = 2 * i + (lane >> 5); scr[kk * 33 + (lane & 31)] = __builtin_nontemporal_load(&W[(size_t)(k0 + kk) * N + n0 + (lane & 31)]); }
    LDS_WAIT(); asm volatile("" ::: "memory");
    const int c = lane & 7;
#pragma unroll
    for (int j = 0; j < 4; ++j) { const int n = (lane >> 3) + 8 * j; const LAS float* s = scr + (8 * c) * 33 + n;
        v4u o; o.x = pk2(s[0 * 33], s[1 * 33]); o.y = pk2(s[2 * 33], s[3 * 33]); o.z = pk2(s[4 * 33], s[5 * 33]); o.w = pk2(s[6 * 33], s[7 * 33]);
        *(GAS v4u*)(WT + (size_t)(drow0 + n) * K + k0 + 8 * c) = o; }
    LDS_WAIT(); asm volatile("" ::: "memory");
}
__device__ __forceinline__ int map_gu(int n0) { const int which = n0 / FF, cc = n0 % FF; return 256 * (cc / 128) + 128 * which + (cc % 128); }
__device__ __forceinline__ int map_in(int n0) {
    if (n0 < 3488) return n0;
    if (n0 < 5536) { const int seg = n0 - 3488, l = seg & 255, hd = l >> 6, half = (l >> 5) & 1; return 3584 + (seg & ~255) + 128 * half + 32 * hd; }
    if (n0 < 6560) return 5632 + (n0 - 5536);
    return 6656 + (n0 - 6560);
}
__device__ __forceinline__ void conv_ffn_weights(const float* wgu, const float* wdn, unsigned char* ws, LAS float* scr, int gw, int NGW, int lane, int which = 3) {
    constexpr int I_GU = (D / 64) * (NGU / 32), I_DN = (FF / 64) * (D / 32);
    for (int it = ((which & 1) ? 0 : I_GU) + gw; it < ((which & 2) ? I_GU + I_DN : I_GU); it += NGW) {
        if (it < I_GU) { const int nb = it % (NGU / 32), kb = it / (NGU / 32); transpose_item(wgu, D, NGU, (bf16*)(ws + WS_WGU), kb * 64, nb * 32, map_gu(nb * 32), scr, lane); }
        else { const int r = it - I_GU, nb = r % (D / 32), kb = r / (D / 32); transpose_item(wdn, FF, D, (bf16*)(ws + WS_WDN), kb * 64, nb * 32, nb * 32, scr, lane); }
    }
}
__device__ __forceinline__ void rms_row_to_bf16(const float* xrow, const float* g, bf16* orow, int lane) {
    const f32x4* xr = (const f32x4*)xrow + lane; const f32x4* gr = (const f32x4*)g + lane;
    f32x4 v[8]; float s = 0.f;
#pragma unroll
    for (int j = 0; j < 8; ++j) { v[j] = __builtin_nontemporal_load(&xr[64 * j]); s += (v[j].x * v[j].x + v[j].y * v[j].y) + (v[j].z * v[j].z + v[j].w * v[j].w); }
    const float rs = 1.0f / sqrtf(wave_sum(s) * (1.f / D) + NORM_EPS);
    u32x2* o8 = (u32x2*)orow + lane;
#pragma unroll
    for (int j = 0; j < 8; ++j) { const f32x4 gg = gr[64 * j]; const f32x4 y = v[j] * rs * gg; u32x2 w; w.x = pk2(y.x, y.y); w.y = pk2(y.z, y.w); o8[64 * j] = w; }
}
__device__ __forceinline__ void norm_phase(const float* Fb_, const float* Hin, float* Hout, const float* gpost, float coef, const float* gpre, bf16* XN, int gw, int NGW, int lane) {
    for (int m = gw; m < M; m += NGW) {
        const u32x2* fr = (const u32x2*)((const bf16*)Fb_ + (size_t)m * D) + lane; const f32x4* hr = (const f32x4*)(Hin + (size_t)m * D) + lane; f32x4* ho = (f32x4*)(Hout + (size_t)m * D) + lane;
        f32x4 f[8], h[8]; float s = 0.f;
#pragma unroll
        for (int j = 0; j < 8; ++j) { f[j] = unpk4(__builtin_nontemporal_load(&fr[64 * j])); h[j] = __builtin_nontemporal_load(&hr[64 * j]); }
#pragma unroll
        for (int j = 0; j < 8; ++j) s += (f[j].x * f[j].x + f[j].y * f[j].y) + (f[j].z * f[j].z + f[j].w * f[j].w);
        const float rs = coef / sqrtf(wave_sum(s) * (1.f / D) + NORM_EPS);
        float s2 = 0.f;
#pragma unroll
        for (int j = 0; j < 8; ++j) { const f32x4 gg = ((const f32x4*)gpost)[lane + 64 * j]; h[j] = h[j] + f[j] * rs * gg; __builtin_nontemporal_store(h[j], &ho[64 * j]);
            s2 += (h[j].x * h[j].x + h[j].y * h[j].y) + (h[j].z * h[j].z + h[j].w * h[j].w); }
        if (XN) {
            const float rs2 = 1.0f / sqrtf(wave_sum(s2) * (1.f / D) + NORM_EPS);
            u32x2* o8 = (u32x2*)(XN + (size_t)m * D) + lane;
#pragma unroll
            for (int j = 0; j < 8; ++j) { const f32x4 gg = ((const f32x4*)gpre)[lane + 64 * j]; const f32x4 y = h[j] * rs2 * gg; u32x2 w; w.x = pk2(y.x, y.y); w.y = pk2(y.z, y.w); o8[64 * j] = w; }
        }
    }
}

typedef float f32x2s __attribute__((ext_vector_type(2)));
#define SLO(x) __builtin_shufflevector(x, x, 0, 1)
#define SHI(x) __builtin_shufflevector(x, x, 2, 3)
constexpr int SC_TC = 32, SC_STEP_F = 352, SC_BUF_F = SC_TC * SC_STEP_F, SC_NCH = T / SC_TC;
template <int DIR>
__device__ __forceinline__ void scan_load_chunk(bf16* dbg, LAS float* wb, const bf16* RWb, const bf16* Eb, const bf16* Ab, int t0, int rh, int lane,
                                                float mpr, float mnr, float mpk, float mnk, float mpv, float mnv, float kkc, float kac) {
    constexpr int ts = DIR ? -1 : 1;
    float rr[10], kr[10], vr[10], ee[8], aa[8];
#pragma unroll
    for (int p = 0; p < 10; ++p) { const int t = t0 + (p - 1) * ts; const bool ok = (t >= 0) && (t < T); const unsigned* rp = (const unsigned*)(RWb + (size_t)(ok ? t : 0) * RWC);
        const float a0 = bfsel(rp[0], lane), a1 = bfsel(rp[512], lane), a2 = bfsel(rp[1024], lane); rr[p] = ok ? a0 : 0.f; kr[p] = ok ? a1 : 0.f; vr[p] = ok ? a2 : 0.f; }
#pragma unroll
    for (int q = 0; q < 8; ++q) { const size_t m = (size_t)(t0 + q * ts); ee[q] = bfsel(*(const unsigned*)(Eb + m * 1024), lane); aa[q] = bfsel(*(const unsigned*)(Ab + m * 1024), lane); }
#pragma unroll
    for (int q = 0; q < 8; ++q) {
        constexpr int dummy = 0; (void)dummy;
        const int pc = q + 1, pp = DIR ? q + 2 : q, pn = DIR ? q : q + 2;
        const float r = rr[pc] + mpr * (rr[pp] - rr[pc]) + mnr * (rr[pn] - rr[pc]);
        const float k = kr[pc] + mpk * (kr[pp] - kr[pc]) + mnk * (kr[pn] - kr[pc]);
        const float v = vr[pc] + mpv * (vr[pp] - vr[pc]) + mnv * (vr[pn] - vr[pc]);
        const float a = aa[q], w = __builtin_amdgcn_exp2f(-1.4426950408889634f * ee[q]);
        const float kq = k * kkc; const float n2 = wave_sum(kq * kq); const float kk = kq * (1.0f / sqrtf(fmaxf(n2, 1e-24f)));
        const float kd = k * (1.0f + (a - 1.0f) * kac);
        LAS float* o = wb + q * SC_STEP_F;
        o[lane] = kk; o[64 + lane] = w; o[128 + lane] = kk * a; o[192 + lane] = kd; o[256 + lane] = r;
        if ((lane >> 5) == rh) o[320 + (lane & 31)] = v;
#ifdef SCAN_DBG_LOADER
        if (dbg && (q & 1) == 0) dbg[(size_t)(q >> 1) * 64 + lane] = (bf16)f2bf(kk + w + kk * a + kd + r + v);
#endif
    }
}
__device__ __forceinline__ float wsum64(float x) {
    x += dppf<0xB1>(x); x += dppf<0x4E>(x); x += dppf<0x141>(x); x += dppf<0x128>(x);
    x += __shfl_xor(x, 16); x += __shfl_xor(x, 32); return x;
}
struct ScanRaw { unsigned rr[10], kr[10], vr[10], ee[8], aa[8]; };
template <int DIR>
__device__ __forceinline__ void scan_fetch(ScanRaw& R, const bf16* RWb, const bf16* Eb, const bf16* Ab, int t0) {
    constexpr int ts = DIR ? -1 : 1;
#pragma unroll
    for (int p = 0; p < 10; ++p) { const int t = t0 + (p - 1) * ts; const bool ok = (t >= 0) && (t < T); const bf16* rp = RWb + (size_t)(ok ? t : 0) * RWC;
        R.rr[p] = rp[0]; R.kr[p] = rp[1024]; R.vr[p] = rp[2048]; }
#pragma unroll
    for (int q = 0; q < 8; ++q) { const size_t m = (size_t)(t0 + q * ts); R.ee[q] = Eb[m * 1024]; R.aa[q] = Ab[m * 1024]; }
}
template <int DIR>
__device__ __forceinline__ void scan_prep_store(const ScanRaw& R, LAS float* wb, int t0, int rh, int lane,
                                                float mpr, float mnr, float mpk, float mnk, float mpv, float mnv, float kkc, float kac) {
    constexpr int ts = DIR ? -1 : 1;
    float rr[10], kr[10], vr[10];
#pragma unroll
    for (int p = 0; p < 10; ++p) { const int t = t0 + (p - 1) * ts; const bool ok = (t >= 0) && (t < T);
        rr[p] = ok ? __uint_as_float(R.rr[p] << 16) : 0.f; kr[p] = ok ? __uint_as_float(R.kr[p] << 16) : 0.f; vr[p] = ok ? __uint_as_float(R.vr[p] << 16) : 0.f; }
#pragma unroll
    for (int q = 0; q < 8; ++q) {
        const int pc = q + 1, pp = DIR ? q + 2 : q, pn = DIR ? q : q + 2;
        const float r = rr[pc] + mpr * (rr[pp] - rr[pc]) + mnr * (rr[pn] - rr[pc]);
        const float k = kr[pc] + mpk * (kr[pp] - kr[pc]) + mnk * (kr[pn] - kr[pc]);
        const float v = vr[pc] + mpv * (vr[pp] - vr[pc]) + mnv * (vr[pn] - vr[pc]);
        const float a = __uint_as_float(R.aa[q] << 16), w = __builtin_amdgcn_exp2f(-1.4426950408889634f * __uint_as_float(R.ee[q] << 16));
        const float kq = k * kkc; const float n2 = wsum64(kq * kq); const float kk = kq * __builtin_amdgcn_rsqf(fmaxf(n2, 1e-24f));
        const float kd = k * (1.0f + (a - 1.0f) * kac);
        LAS float* o = wb + q * SC_STEP_F;
        o[lane] = kk; o[64 + lane] = w; o[128 + lane] = kk * a; o[192 + lane] = kd; o[256 + lane] = r;
        if ((lane >> 5) == rh) o[320 + (lane & 31)] = v;
    }
}
#define SCAN_FLUSH(fc) do { const int fs_ = (fc) * SC_TC + lw * 8 + (lane >> 3); const int ft_ = d ? (T - 1 - fs_) : fs_; \
        const f32x4 ov_ = *(const LAS f32x4*)(obuf + ((fc) & 1) * (SC_TC * 32) + (lw * 8 + (lane >> 3)) * 32 + (lane & 7) * 4); \
        u32x2 ow_; ow_.x = pk2(ov_.x, ov_.y); ow_.y = pk2(ov_.z, ov_.w); *(u32x2*)(Od + (size_t)ft_ * 32 + (lane & 7) * 4) = ow_; } while (0)
__device__ __forceinline__ void scan_phase(LAS unsigned char* lds, const bf16* RW, const bf16* EA, bf16* OS, const float* mu_prev, const float* mu_next, const float* k_k, const float* k_a,
                                           int vcu, int G, int wave, int lane) {
    LAS float* buf = (LAS float*)(lds + 16384);
    LAS float* obuf = buf + 2 * SC_BUF_F;
    const bool is_loader = wave < 4;
    for (int wg = vcu; wg < 256; wg += G) {
        const int ch = wg >> 1, rh = wg & 1, d = ch >> 6, b = (ch >> 4) & 3, h = ch & 15;
        const size_t mb = (size_t)b * T;
        const int lw = wave & 3, c_ = h * 64 + lane;
        const float mpr = mu_prev[c_], mnr = mu_next[c_], mpk = mu_prev[1024 + c_], mnk = mu_next[1024 + c_], mpv = mu_prev[2048 + c_], mnv = mu_next[2048 + c_];
        const float kkc = k_k[c_], kac = k_a[c_];
        const int ce = c_ & ~1;
        const bf16* RWb = RW + mb * RWC + c_; const bf16* Eb = EA + ((size_t)d * M + mb) * 1024 + c_; const bf16* Ab = EA + ((size_t)(2 + d) * M + mb) * 1024 + c_; (void)ce;
        const int rowl = lane >> 3, jg = lane & 7, row_local = (wave & 3) * 8 + rowl;
        f32x2s S2[4];
#pragma unroll
        for (int e = 0; e < 4; ++e) S2[e] = (f32x2s){0.f, 0.f};
        bf16* Od = OS + ((size_t)((((d * 4 + b) * 16 + h) * 2 + rh)) * T) * 32;
        ScanRaw R;
        if (is_loader) { const int s0 = lw * 8; if (d == 0) scan_fetch<0>(R, RWb, Eb, Ab, s0); else scan_fetch<1>(R, RWb, Eb, Ab, T - 1 - s0); }
        for (int c = 0; c <= SC_NCH; ++c) {
            if (is_loader) {
                if (c >= 2) SCAN_FLUSH(c - 2);
                if (c < SC_NCH) {
                    const int s0 = c * SC_TC + lw * 8; LAS float* wb = buf + (c & 1) * SC_BUF_F + (lw * 8) * SC_STEP_F;
                    if (d == 0) scan_prep_store<0>(R, wb, s0, rh, lane, mpr, mnr, mpk, mnk, mpv, mnv, kkc, kac);
                    else scan_prep_store<1>(R, wb, T - 1 - s0, rh, lane, mpr, mnr, mpk, mnk, mpv, mnv, kkc, kac);
                    if (c + 1 < SC_NCH) { const int s1 = s0 + SC_TC; if (d == 0) scan_fetch<0>(R, RWb, Eb, Ab, s1); else scan_fetch<1>(R, RWb, Eb, Ab, T - 1 - s1); }
                }
            }
#ifdef SCAN_SYNC
            __syncthreads();
#endif
            if (!is_loader && c > 0) {
                __builtin_amdgcn_s_setprio(3);
                const int cc = c - 1;
                LAS float* obc = obuf + (cc & 1) * (SC_TC * 32);
                const LAS float* bc = buf + (cc & 1) * SC_BUF_F;
                const LAS float* p = bc + jg * 8;
                f32x4 kk0 = *(const LAS f32x4*)(p), kk1 = *(const LAS f32x4*)(p + 4), w0 = *(const LAS f32x4*)(p + 64), w1 = *(const LAS f32x4*)(p + 68), b0 = *(const LAS f32x4*)(p + 128), b1 = *(const LAS f32x4*)(p + 132),
                      k0 = *(const LAS f32x4*)(p + 192), k1 = *(const LAS f32x4*)(p + 196), r0 = *(const LAS f32x4*)(p + 256), r1 = *(const LAS f32x4*)(p + 260);
                float v = bc[320 + row_local];
#pragma unroll 8
                for (int s = 0; s < SC_TC; ++s) {
                    const int sn = (s + 1 < SC_TC) ? s + 1 : s;
                    const LAS float* pn = bc + sn * SC_STEP_F + jg * 8;
                    const f32x4 nkk0 = *(const LAS f32x4*)(pn), nkk1 = *(const LAS f32x4*)(pn + 4), nw0 = *(const LAS f32x4*)(pn + 64), nw1 = *(const LAS f32x4*)(pn + 68), nb0 = *(const LAS f32x4*)(pn + 128), nb1 = *(const LAS f32x4*)(pn + 132),
                                nk0 = *(const LAS f32x4*)(pn + 192), nk1 = *(const LAS f32x4*)(pn + 196), nr0 = *(const LAS f32x4*)(pn + 256), nr1 = *(const LAS f32x4*)(pn + 260);
                    const float nv = bc[sn * SC_STEP_F + 320 + row_local];
                    const f32x2s pa_ = S2[1] * SHI(kk0) + S2[0] * SLO(kk0), pb_ = S2[3] * SHI(kk1) + S2[2] * SLO(kk1); const f32x2s p_ = pa_ + pb_;
                    const f32x2s t0_ = S2[0] * SLO(w0), t1_ = S2[1] * SHI(w0), t2_ = S2[2] * SLO(w1), t3_ = S2[3] * SHI(w1);
                    const float nsa = -red8(p_.x + p_.y);
                    const f32x2s ns2 = (f32x2s){nsa, nsa}, v2 = (f32x2s){v, v};
                    S2[0] = ns2 * SLO(b0) + (v2 * SLO(k0) + t0_); S2[1] = ns2 * SHI(b0) + (v2 * SHI(k0) + t1_);
                    S2[2] = ns2 * SLO(b1) + (v2 * SLO(k1) + t2_); S2[3] = ns2 * SHI(b1) + (v2 * SHI(k1) + t3_);
                    const f32x2s qa_ = S2[1] * SHI(r0) + S2[0] * SLO(r0), qb_ = S2[3] * SHI(r1) + S2[2] * SLO(r1); const f32x2s q_ = qa_ + qb_;
#ifdef SCAN_TRIVIAL
                    const float o = v;
#else
                    const float o = red8(q_.x + q_.y);
#endif
                    if (jg == 0) obc[s * 32 + row_local] = o;
                    kk0 = nkk0; kk1 = nkk1; w0 = nw0; w1 = nw1; b0 = nb0; b1 = nb1; k0 = nk0; k1 = nk1; r0 = nr0; r1 = nr1; v = nv;
                }
                __builtin_amdgcn_s_setprio(0);
            }
            __syncthreads();
        }
        if (is_loader) SCAN_FLUSH(SC_NCH - 1);
        __syncthreads();
    }
}

__device__ __forceinline__ void post_phase(const bf16* __restrict__ RW, const bf16* __restrict__ EAG, const bf16* __restrict__ GG, const bf16* __restrict__ OS, const bf16* __restrict__ OATT, bf16* __restrict__ Y, const float* __restrict__ mu_prev, const float* __restrict__ mu_next, const float* __restrict__ k_a, const float* __restrict__ r_k,
                                           const float* gn_w, const float* gn_b, const float* lq1, const float* lk1, const float* lq2, const float* lk2, const float* subln_g, int gw, int NGW, int lane) {
#pragma unroll 2
    for (int it = gw; it < M * 4; it += NGW) {
        const int m = it >> 2, hq = it & 3, c0 = hq * 256 + 4 * lane, t = m & (T - 1);
        const bool hasp = t > 0, hasn = t < T - 1;
        const int hh = hq * 4 + (lane >> 4), i0 = (lane & 15) * 4, bb = m >> 11;
        const size_t oso = ((size_t)((((bb * 16 + hh) * 2 + (i0 >> 5))) * T) + t) * 32 + (i0 & 31);
        const f32x4 o = unpk4(*(const u32x2*)(OS + oso)) + unpk4(*(const u32x2*)(OS + (size_t)4 * 16 * 2 * T * 32 + oso));
        const bf16* rp = RW + (size_t)m * RWC + c0;
        f32x4 x[3], xp[3], xn[3];
#pragma unroll
        for (int q = 0; q < 3; ++q) { x[q] = unpk4(*(const u32x2*)(rp + q * 1024));
            xp[q] = unpk4(*(const u32x2*)(rp + q * 1024 - (hasp ? RWC : 0))); xn[q] = unpk4(*(const u32x2*)(rp + q * 1024 + (hasn ? RWC : 0)));
            if (!hasp) xp[q] = (f32x4){0.f, 0.f, 0.f, 0.f}; if (!hasn) xn[q] = (f32x4){0.f, 0.f, 0.f, 0.f};
            const f32x4 mp = *(const f32x4*)(mu_prev + q * 1024 + c0), mn = *(const f32x4*)(mu_next + q * 1024 + c0);
            x[q] = x[q] + mp * (xp[q] - x[q]) + mn * (xn[q] - x[q]); }
        const f32x4 a0 = unpk4(*(const u32x2*)(EAG + (size_t)(2 * M + m) * 1024 + c0)), a1 = unpk4(*(const u32x2*)(EAG + (size_t)(3 * M + m) * 1024 + c0));
        const f32x4 g = unpk4(*(const u32x2*)(GG + (size_t)m * 1024 + c0));
        const f32x4 ka = *(const f32x4*)(k_a + c0), rk = *(const f32x4*)(r_k + c0), gw4 = *(const f32x4*)(gn_w + c0), gb4 = *(const f32x4*)(gn_b + c0);
        const float mean = red16((o.x + o.y) + (o.z + o.w)) * (1.f / 64.f);
        const f32x4 dv = o - mean;
        const float var = red16((dv.x * dv.x + dv.y * dv.y) + (dv.z * dv.z + dv.w * dv.w)) * (1.f / 64.f);
        const float rstd = 1.0f / sqrtf(var + GN_EPS);
        const f32x4 ksum = x[1] * (2.0f + (a0 + a1 - 2.0f) * ka);
        const f32x4 bt = x[0] * ksum * rk;
        const float bs = red16((bt.x + bt.y) + (bt.z + bt.w));
        const f32x4 y = (dv * rstd * gw4 + gb4 + x[2] * bs) * g;
        u32x2 w; w.x = pk2(y.x, y.y); w.y = pk2(y.z, y.w);
        *(u32x2*)(Y + (size_t)m * 1024 + c0) = w;
    }
    const float lam = __expf(wave_sum(lq1[lane] * lk1[lane])) - __expf(wave_sum(lq2[lane] * lk2[lane])) + LAM_INIT;
#pragma unroll 2
    for (int m = gw; m < M; m += NGW) {
        const int hv = lane >> 3, d0 = 16 * (lane & 7);
        const bf16* p1 = OATT + (size_t)m * 2048 + (2 * hv) * 128 + d0; const bf16* p2 = p1 + 128;
        const v4u a0 = *(const v4u*)p1, a1 = *(const v4u*)(p1 + 8), b0 = *(const v4u*)p2, b1 = *(const v4u*)(p2 + 8);
        f32x4 df[4];
        df[0] = pg8::unpk_lo(a0) - lam * pg8::unpk_lo(b0); df[1] = pg8::unpk_hi(a0) - lam * pg8::unpk_hi(b0); df[2] = pg8::unpk_lo(a1) - lam * pg8::unpk_lo(b1); df[3] = pg8::unpk_hi(a1) - lam * pg8::unpk_hi(b1);
        float ss = 0.f;
#pragma unroll
        for (int q = 0; q < 4; ++q) ss += (df[q].x * df[q].x + df[q].y * df[q].y) + (df[q].z * df[q].z + df[q].w * df[q].w);
        const float rs = (1.0f - LAM_INIT) / sqrtf(red8(ss) * (1.f / 128.f) + SUBLN_EPS);
#pragma unroll
        for (int q = 0; q < 4; ++q) df[q] = df[q] * rs * *(const f32x4*)(subln_g + d0 + 4 * q);
        bf16* yo = Y + (size_t)(M + m) * 1024 + hv * 128 + d0;
        *(v4u*)yo = pg8::pack8(df[0], df[1]); *(v4u*)(yo + 8) = pg8::pack8(df[2], df[3]);
    }
}


struct Ctx { int vcu, wave, lane; };
typedef const __attribute__((address_space(4))) Args* ArgsP;
template <int ph> __device__ __forceinline__ void run_phase(const Ctx& c, LAS unsigned char* lds, unsigned char* lds_raw) {
    ArgsP ap = (ArgsP)__builtin_amdgcn_kernarg_segment_ptr(); asm volatile("" : "+s"(ap));
    unsigned char* ws = ap->ws; const float* x = ap->in[0]; float* out = ap->out;
    int tid = threadIdx.x; asm volatile("" : "+v"(tid));
    const int G = gridDim.x, bx = blockIdx.x, vcu = (G % 8 == 0) ? (bx % 8) * (G / 8) + bx / 8 : bx, wave = __builtin_amdgcn_readfirstlane(tid >> 6), lane = tid & 63; (void)c;
    const int gw = vcu * NWAVES + wave, NGW = G * NWAVES, gt = vcu * (NWAVES * 64) + tid, NGT = G * NWAVES * 64;
    bf16* XN = (bf16*)(ws + WS_XN); float* Fb = (float*)(ws + WS_F); bf16* ACT = (bf16*)(ws + WS_ACT);
    bf16* RW = (bf16*)(ws + WS_RW); bf16* Qb = (bf16*)(ws + WS_Q); bf16* Kb = (bf16*)(ws + WS_K); bf16* Vb = (bf16*)(ws + WS_V); bf16* Yb = (bf16*)(ws + WS_Y);
    bf16* GATES = (bf16*)(ws + WS_GATES); float* LR = (float*)(ws + WS_LR); bf16* LA = (bf16*)(ws + WS_LA); bf16* OATT = (bf16*)(ws + WS_OATT);
    bf16* EA = (bf16*)(ws + WS_F);
    bf16* Gg = (bf16*)(ws + WS_G);
#ifdef OS_IN_GATES
    bf16* OS = (bf16*)(ws + WS_GATES);
#else
    bf16* OS = (bf16*)(ws + WS_XN);
#endif
    bf16* MERGED = (bf16*)(ws + WS_XN); float* Pb = (float*)(ws + WS_F);
    float* ROPE = (float*)(ws + WS_ROPE);
    (void)XN; (void)Fb; (void)ACT; (void)RW; (void)Qb; (void)Kb; (void)Vb; (void)Yb; (void)GATES; (void)LR; (void)LA; (void)OATT; (void)EA; (void)Gg; (void)OS; (void)MERGED; (void)Pb; (void)ROPE; (void)gw; (void)NGW; (void)gt; (void)NGT; (void)bx;
    (void)tid; (void)x; (void)out; (void)ws;
#ifdef ONLY_PH
    if (ph != ONLY_PH) return;
#endif
#ifdef STOP_AFTER
    if (ph > STOP_AFTER) return;
#endif
#ifdef SKIP_MASK
    if ((SKIP_MASK >> ph) & 1) return;
#endif
        switch (ph) {
        case 0: {
            LAS float* scr = (LAS float*)(lds + RING_OFF + wave * 16384);
#ifdef HIDE_CONV
            conv_ffn_weights(ap->in[2], ap->in[3], ws, scr, gw, NGW, lane, 1);
#else
            conv_ffn_weights(ap->in[2], ap->in[3], ws, scr, gw, NGW, lane);
#endif
#ifndef HIDE_CONV
            constexpr int I_IN = (D / 64) * (IN_COLS / 32), I_BR = (1024 / 64) * (D / 32), I_OUT = (D / 64) * (D / 32);
            for (int it = gw; it < I_IN + 2 * I_BR + I_OUT; it += NGW) {
                int r = it;
                if (r < I_IN) { const int nb = r % (IN_COLS / 32), kb = r / (IN_COLS / 32); transpose_item(ap->in[6], D, IN_COLS, (bf16*)(ws + WS_WIN), kb * 64, nb * 32, map_in(nb * 32), scr, lane); continue; } r -= I_IN;
                if (r < I_BR) { const int nb = r % (D / 32), kb = r / (D / 32); transpose_item(ap->in[24], 1024, D, (bf16*)(ws + WS_WA), kb * 64, nb * 32, nb * 32, scr, lane); continue; } r -= I_BR;
                if (r < I_BR) { const int nb = r % (D / 32), kb = r / (D / 32); transpose_item(ap->in[25], 1024, D, (bf16*)(ws + WS_WB), kb * 64, nb * 32, nb * 32, scr, lane); continue; } r -= I_BR;
                { const int nb = r % (D / 32), kb = r / (D / 32); transpose_item(ap->in[26], D, D, (bf16*)(ws + WS_WOUT), kb * 64, nb * 32, nb * 32, scr, lane); }
            }
#endif
#ifndef HIDE_CONV
            { const float* w_up = ap->in[10]; const float* a_up = ap->in[12]; const float* g_up = ap->in[13]; bf16* WL = (bf16*)(ws + WS_WLORA);
              for (int i = gt; i < NLORA * (KLORA / 8); i += NGT) { const int n = i >> 6, k0 = (i & 63) * 8, ob = n >> 10, c = n & 1023; float v[8];
#pragma unroll
                  for (int e = 0; e < 8; ++e) { const int kk = k0 + e; float val = 0.f;
                      if (ob < 2) { if ((kk >> 6) == ob) val = w_up[(size_t)kk * 1024 + c]; }
                      else if (ob < 4) { if ((kk >> 6) == ob) val = a_up[(size_t)(kk - 128) * 1024 + c]; }
                      else { if (kk >= 256 && kk < 416) val = g_up[(size_t)(kk - 256) * 1024 + c]; }
                      v[e] = val; }
                  v4u o; o.x = pk2(v[0], v[1]); o.y = pk2(v[2], v[3]); o.z = pk2(v[4], v[5]); o.w = pk2(v[6], v[7]);
                  *(v4u*)(WL + (size_t)n * KLORA + k0) = o; } }
#endif
            for (int i = gt; i < T * 32; i += NGT) { const int t = i >> 5, k = i & 31;
                const float inv = __builtin_amdgcn_exp2f(-(float)k * (13.287712379549449f / 32.0f)); const float ang = (float)t * inv;
                const double rev = (double)ang * 0.15915494309189535; const float fr = (float)(rev - floor(rev));
                ROPE[t * 64 + k] = __builtin_amdgcn_cosf(fr); ROPE[t * 64 + 32 + k] = __builtin_amdgcn_sinf(fr); }
            for (int m = gw; m < M; m += NGW) rms_row_to_bf16(x + (size_t)m * D, ap->in[1], XN + (size_t)m * D, lane);
        } break;
        case 1: case 12: {
            pg8::Gemm g{XN, (const bf16*)(ws + WS_WGU), M, NGU, D, nullptr, nullptr}; pg8::StaticOrder S; S.init(M, NGU, G, bx);
            pg8::EpiSwiglu E{ACT, FF};
            pg8::gemm_phase<pg8::EpiSwiglu, pg8::StaticOrder, true, true>(lds + RING_OFF, g, S, E);
#ifdef HIDE_CONV
            if (ph == 1 && G == 256 ? bx >= 128 : ph == 1) { LAS float* scr = (LAS float*)(lds + RING_OFF + wave * 16384);
                const int gw2 = (G == 256) ? (bx - 128) * NWAVES + wave : gw, NGW2 = (G == 256) ? 128 * NWAVES : NGW;
                constexpr int I_IN = (D / 64) * (IN_COLS / 32);
                for (int r = gw2; r < I_IN; r += NGW2) { const int nb = r % (IN_COLS / 32), kb = r / (IN_COLS / 32); transpose_item(ap->in[6], D, IN_COLS, (bf16*)(ws + WS_WIN), kb * 64, nb * 32, map_in(nb * 32), scr, lane); }
                conv_ffn_weights(ap->in[2], ap->in[3], ws, scr, gw2, NGW2, lane, 2);
            }
#endif
        } break;
        case 2: case 10: case 13: {
            const bool isout = (ph == 10);
            pg8::Gemm g{isout ? MERGED : ACT, (const bf16*)(ws + (isout ? WS_WOUT : WS_WDN)), M, D, isout ? D : FF, nullptr, nullptr}; pg8::StaticOrder S; S.init(M, D, G, bx);
            pg8::EpiB16 E{(bf16*)Fb, D};
            pg8::gemm_phase<pg8::EpiB16, pg8::StaticOrder, true, true>(lds + RING_OFF, g, S, E);
        } break;
        case 3: case 11: case 14: {
            const float* gpost = ap->in[ph == 3 ? 4 : (ph == 11 ? 27 : 31)]; const float* gpre = ap->in[ph == 3 ? 5 : 28];
            norm_phase(Fb, ph == 3 ? x : out, out, gpost, ph == 11 ? 1.0f : 0.5f, gpre, ph == 14 ? (bf16*)nullptr : XN, gw, NGW, lane);
        } break;
        case 4: {
            pg8::Gemm g{XN, (const bf16*)(ws + WS_WIN), M, IN_PAD, D, nullptr, nullptr}; pg8::StaticOrder S; S.init(M, IN_PAD, G, bx);
            pg8::EpiIn E{RW, Qb, Kb, Vb, GATES, LR, ROPE, QSCALE};
            pg8::gemm_phase<pg8::EpiIn, pg8::StaticOrder, true, true>(lds + RING_OFF, g, S, E);
#ifdef HIDE_CONV
            if (G == 256 ? bx >= 64 : true) { LAS float* scr = (LAS float*)(lds + RING_OFF + wave * 16384);
                const int gw2 = (G == 256) ? (bx - 64) * NWAVES + wave : gw, NGW2 = (G == 256) ? 192 * NWAVES : NGW;
                conv_ffn_weights(ap->in[29], ap->in[30], ws, scr, gw2, NGW2, lane);
                constexpr int I_BR = (1024 / 64) * (D / 32), I_OUT = (D / 64) * (D / 32);
                for (int it = gw2; it < 2 * I_BR + I_OUT; it += NGW2) { int r = it;
                    if (r < I_BR) { const int nb = r % (D / 32), kb = r / (D / 32); transpose_item(ap->in[24], 1024, D, (bf16*)(ws + WS_WA), kb * 64, nb * 32, nb * 32, scr, lane); continue; } r -= I_BR;
                    if (r < I_BR) { const int nb = r % (D / 32), kb = r / (D / 32); transpose_item(ap->in[25], 1024, D, (bf16*)(ws + WS_WB), kb * 64, nb * 32, nb * 32, scr, lane); continue; } r -= I_BR;
                    { const int nb = r % (D / 32), kb = r / (D / 32); transpose_item(ap->in[26], D, D, (bf16*)(ws + WS_WOUT), kb * 64, nb * 32, nb * 32, scr, lane); } }
                const int gt2 = (G == 256) ? (bx - 64) * (NWAVES * 64) + tid : gt, NGT2 = (G == 256) ? 192 * NWAVES * 64 : NGT;
            { const float* w_up = ap->in[10]; const float* a_up = ap->in[12]; const float* g_up = ap->in[13]; bf16* WL = (bf16*)(ws + WS_WLORA);
              for (int i = gt2; i < NLORA * (KLORA / 8); i += NGT2) { const int n = i >> 6, k0 = (i & 63) * 8, ob = n >> 10, c = n & 1023; float v[8];
#pragma unroll
                  for (int e = 0; e < 8; ++e) { const int kk = k0 + e; float val = 0.f;
                      if (ob < 2) { if ((kk >> 6) == ob) val = w_up[(size_t)kk * 1024 + c]; }
                      else if (ob < 4) { if ((kk >> 6) == ob) val = a_up[(size_t)(kk - 128) * 1024 + c]; }
                      else { if (kk >= 256 && kk < 416) val = g_up[(size_t)(kk - 256) * 1024 + c]; }
                      v[e] = val; }
                  v4u o; o.x = pk2(v[0], v[1]); o.y = pk2(v[2], v[3]); o.z = pk2(v[4], v[5]); o.w = pk2(v[6], v[7]);
                  *(v4u*)(WL + (size_t)n * KLORA + k0) = o; } }
            }
#endif
        } break;
        case 5: {
            const float* mu_prev = ap->in[7]; const float* mu_next = ap->in[8];
            for (int i = gt; i < M * 64; i += NGT) { const int m = i >> 6, grp = i & 63, c0 = grp * 8, t = m & (T - 1);
                f32x4 y0 = (f32x4){0.f, 0.f, 0.f, 0.f}, y1 = y0;
                if (grp < 52) {
                    const float* cp = LR + (size_t)m * 512 + c0; const f32x4 z = (f32x4){0.f, 0.f, 0.f, 0.f};
                    const f32x4 c_0 = *(const f32x4*)cp, c_1 = *(const f32x4*)(cp + 4);
                    const f32x4 p_0 = t > 0 ? *(const f32x4*)(cp - 512) : z, p_1 = t > 0 ? *(const f32x4*)(cp - 508) : z;
                    const f32x4 n_0 = t < T - 1 ? *(const f32x4*)(cp + 512) : z, n_1 = t < T - 1 ? *(const f32x4*)(cp + 516) : z;
                    const f32x4 mp0 = *(const f32x4*)(mu_prev + 3072 + c0), mp1 = *(const f32x4*)(mu_prev + 3076 + c0), mn0 = *(const f32x4*)(mu_next + 3072 + c0), mn1 = *(const f32x4*)(mu_next + 3076 + c0);
                    y0 = c_0 + mp0 * (p_0 - c_0) + mn0 * (n_0 - c_0); y1 = c_1 + mp1 * (p_1 - c_1) + mn1 * (n_1 - c_1);
                    if (c0 < 128) {
#pragma unroll
                        for (int e = 0; e < 4; ++e) { y0[e] = 2.0f * sigm_(2.0f * y0[e]) - 1.0f; y1[e] = 2.0f * sigm_(2.0f * y1[e]) - 1.0f; } }
                    else if (c0 >= 256) {
#pragma unroll
                        for (int e = 0; e < 4; ++e) { y0[e] = sigm_(y0[e]); y1[e] = sigm_(y1[e]); } }
                }
                *(v4u*)(LA + (size_t)m * 512 + c0) = pg8::pack8(y0, y1); }
#ifndef HIDE_CONV
            LAS float* scr = (LAS float*)(lds + RING_OFF + wave * 16384);
            conv_ffn_weights(ap->in[29], ap->in[30], ws, scr, gw, NGW, lane);
#endif
        } break;
        case 6: {
            pg8::Gemm g{LA, (const bf16*)(ws + WS_WLORA), M, NLORA, KLORA, nullptr, nullptr}; pg8::LoraOrder S; S.so.init(M, NLORA, G, bx);
            pg8::EpiLora E{EA, Gg, ap->in[9], ap->in[11]};
            pg8::gemm_phase<pg8::EpiLora, pg8::LoraOrder, true, true>(lds + RING_OFF, g, S, E);
        } break;
        case 7: {
            scan_phase(lds + RING_OFF, RW, EA, OS, ap->in[7], ap->in[8], ap->in[14], ap->in[15], vcu, G, wave, lane);
            __syncthreads();
#ifdef SKIP_ATTN
            if (true) break;
#endif
            const int upc = (1024 + G - 1) / G;
            for (int i = 0; i < upc; ++i) { const int unit = vcu * upc + i; if (unit >= 1024) break;
                const int qb = unit & 7, vh = (unit >> 3) & 1, j = (unit >> 4) & 15, b = unit >> 8;
                attn_body::attn_unit<8>(b, j, (j >> 1) * 128 + vh * 64, j * 128 + vh * 64, qb, (const attn_body::bf16*)Qb, (const attn_body::bf16*)Kb, (const attn_body::bf16*)Vb, (attn_body::bf16*)OATT, (char*)lds_raw + RING_OFF); }
        } break;
        case 8: {
            post_phase(RW, EA, Gg, OS, OATT, Yb, ap->in[7], ap->in[8], ap->in[15], ap->in[16], ap->in[17], ap->in[18], ap->in[19], ap->in[20], ap->in[21], ap->in[22], ap->in[23], gw, NGW, lane);
        } break;
        case 9: {
            pg8::Gemm g{Yb, (const bf16*)(ws + WS_WA), M, D, 1024, Yb + (size_t)M * 1024, (const bf16*)(ws + WS_WB)}; pg8::BranchOrder S; S.so.init(M, D, G, bx);
            pg8::EpiBranch E{Pb, MERGED, GATES};
            pg8::gemm_phase<pg8::EpiBranch, pg8::BranchOrder, true, true>(lds + RING_OFF, g, S, E);
        } break;
        }
}
__device__ __forceinline__ void ap_out_nan(float* out, int i) { out[i] = __builtin_nanf(""); }
#ifndef USE_XCD_BARRIER
#define USE_XCD_BARRIER 1
#endif
#if USE_XCD_BARRIER
#define GRID_SYNC() xcd_barrier(bar)
#else
#define GRID_SYNC() cooperative_groups::this_grid().sync()
#endif
#ifndef CUT_LIST
#define CUT_LIST {0, 15}
#endif
__global__ void __launch_bounds__(NWAVES * 64, 2) mk_fwd(Args args) {
    extern __shared__ __attribute__((aligned(16))) unsigned char lds_raw[];
    LAS unsigned char* lds = (LAS unsigned char*)lds_raw;
    volatile LAS unsigned* MISC = (volatile LAS unsigned*)(lds + MISC_OFF);
    const int tid = threadIdx.x, lane = tid & 63, wave = __builtin_amdgcn_readfirstlane(tid >> 6);
    const int G = gridDim.x; const int bx = blockIdx.x; const int vcu = (G % 8 == 0) ? (bx % 8) * (G / 8) + bx / 8 : bx;
    unsigned char* ws = args.ws;
    gu32* ctl = (gu32*)(ws + WS_CTL);
    for (int u = tid; u < (LDS_BYTES - LDSCTL_OFF) / 4; u += NWAVES * 64) ((LAS unsigned*)(lds + LDSCTL_OFF))[u] = 0u;
    __syncthreads();
    XcdBarrier bar = xcd_barrier_post((unsigned*)(ctl + CW_BAR) + args.li * XCD_BAR_WORDS, MISC + 8);
    const int ph_lo = args.ph_lo, ph_hi = args.ph_hi;
#ifdef DUMP_SCAN_INPUTS
    if (ph_lo == 7) {
        for (size_t i_ = (size_t)blockIdx.x * 512 + threadIdx.x; i_ < (size_t)M * D; i_ += (size_t)gridDim.x * 512) {
            float s_ = 0.f;
            { const unsigned* W_ = (const unsigned*)(ws + WS_RW); if (i_ < (size_t)48 * MiB / 4) s_ += (float)(W_[i_] & 0xfffffu) + (float)(W_[i_] >> 20); }
            { const unsigned* W_ = (const unsigned*)(ws + WS_F); s_ += (float)(W_[i_] & 0xfffffu) + (float)(W_[i_] >> 20); }
            if (i_ < 3488) s_ += args.in[7][i_] + args.in[8][i_];
            if (i_ < 1024) s_ += args.in[14][i_] + args.in[15][i_];
            args.out[i_] = s_; }
        return; }
    if (ph_lo > 7) return;
#endif
#ifdef DUMP_OS_AT8
    if (ph_lo == 8) {
        for (size_t i_ = (size_t)blockIdx.x * 512 + threadIdx.x; i_ < (size_t)M * D; i_ += (size_t)gridDim.x * 512) {
            float s_ = 0.f;
            if (DUMP_OS_AT8 & 1) { const unsigned* W_ = (const unsigned*)(ws + WS_XN); if (i_ < (size_t)32 * MiB / 4) s_ += (float)(W_[i_] & 0xfffffu) + (float)(W_[i_] >> 20); }
            if (DUMP_OS_AT8 & 4) { const unsigned* W_ = (const unsigned*)(ws + WS_GATES); s_ += (float)(W_[i_] & 0xfffffu) + (float)(W_[i_] >> 20); }
            if (DUMP_OS_AT8 & 8) { const unsigned* W_ = (const unsigned*)(ws + WS_GATES); if (i_ < 256 * 8 * 4 * 64) s_ += (float)(W_[i_] & 0xfffffu) + (float)(W_[i_] >> 20); }
            if (DUMP_OS_AT8 & 2) { const unsigned* W_ = (const unsigned*)(ws + WS_OATT); if (i_ < (size_t)32 * MiB / 4) s_ += (float)(W_[i_] & 0xfffffu) + (float)(W_[i_] >> 20); }
            args.out[i_] = s_; }
        return; }
#endif
    Ctx c{vcu, wave, lane};
#ifdef DUMP_AFTER
#define DUMP_AFTER_7X(n) ((n) == 7 && DUMP_AFTER > 70)
#define DUMPR(off, nbytes) do { const unsigned* W_ = (const unsigned*)(ws + (off)); const size_t n_ = (size_t)(nbytes) / 4; \
        for (size_t i_ = (size_t)blockIdx.x * 512 + threadIdx.x; i_ < (size_t)M * D; i_ += (size_t)gridDim.x * 512) { float s_ = 0.f; for (size_t j_ = i_; j_ < n_; j_ += (size_t)M * D) s_ += (float)(W_[j_] & 0xfffffu); args.out[i_] += s_; } } while (0)
#define DUMPCHK(k) if (DUMP_AFTER == (k)) { for (size_t i_ = (size_t)blockIdx.x * 512 + threadIdx.x; i_ < (size_t)M * D; i_ += (size_t)gridDim.x * 512) args.out[i_] = 0.f; \
        if ((k) == 4) { DUMPR(WS_RW, 48 * MiB); DUMPR(WS_Q, 48 * MiB); DUMPR(WS_GATES, 64 * MiB); } \
        if ((k) == 5) { DUMPR(WS_LA, 8 * MiB); DUMPR(WS_WGU, 66 * MiB); } \
        if ((k) == 6) { DUMPR(WS_F, 64 * MiB); DUMPR(WS_G, 16 * MiB); } \
        if ((k) == 7) { DUMPR(WS_XN, 32 * MiB); DUMPR(WS_OATT, 32 * MiB); } \
        if ((k) == 71) { DUMPR(WS_XN, 32 * MiB); } \
        if ((k) == 72) { DUMPR(WS_OATT, 32 * MiB); } \
        if ((k) == 8) { DUMPR(WS_Y, 32 * MiB); } \
        if ((k) == 9) { DUMPR(WS_XN, 32 * MiB); } \
        if ((k) == 10) { DUMPR(WS_F, 64 * MiB); } \
        return; }
#else
#define DUMPCHK(k)
#define DUMP_AFTER_7X(n) false
#endif
#ifdef HASH_AFTER
#define HASHCHK(n) if ((n) == HASH_AFTER) { unsigned hs_ = 0u; const unsigned* W_ = (const unsigned*)(ws + (size_t)(HASH_LO) * MiB); const size_t n_ = (size_t)((HASH_HI) - (HASH_LO)) * MiB / 4; \
        for (size_t i_ = (size_t)blockIdx.x * 512 + threadIdx.x; i_ < n_; i_ += (size_t)gridDim.x * 512) { const unsigned w_ = W_[i_]; hs_ += w_ * 2654435761u + (w_ >> 15) + (unsigned)i_ * (w_ | 1u); } \
        atomicAdd((unsigned*)(ctl + 100000), hs_); GRID_SYNC(); const unsigned hv_ = xb_ld((unsigned*)(ctl + 100000)); \
        for (size_t i_ = (size_t)blockIdx.x * 512 + threadIdx.x; i_ < (size_t)M * D; i_ += (size_t)gridDim.x * 512) args.out[i_] = (float)((hv_ ^ (unsigned)(i_ * 40503u)) & 0xffffu); \
        return; }
#else
#define HASHCHK(n)
#endif
#ifdef DUP_PHASE
#define DUPRUN(n) if ((n) == DUP_PHASE) { run_phase<n>(c, lds, lds_raw); GRID_SYNC(); }
#else
#define DUPRUN(n)
#endif
#define PH(n) if (ph_lo <= (n) && (n) < ph_hi) { DUPRUN(n) run_phase<n>(c, lds, lds_raw); if ((n) + 1 < ph_hi) { GRID_SYNC(); } HASHCHK(n) }
    PH(0) PH(1) PH(2) PH(3) PH(4) PH(5) PH(6) PH(7) PH(8) PH(9) PH(10) PH(11) PH(12) PH(13)
    PH(14)
    if (ph_hi == 15 && (xb_ld((unsigned*)(ctl + CW_BAR) + XB_TMO) | xb_ld((unsigned*)(ctl + CW_BAR) + XCD_BAR_WORDS + XB_TMO) | xb_ld((unsigned*)(ctl + CW_BAR) + 2 * XCD_BAR_WORDS + XB_TMO)) != 0u) { asm volatile("s_waitcnt vmcnt(0)" ::: "memory"); if (threadIdx.x < 64) ap_out_nan(args.out, blockIdx.x * 64 + threadIdx.x); }
#undef PH
}

extern "C" void kernel_launch(void* const* d_in, const int* in_sizes, int n_in, void* d_out, int out_size, void* d_ws, size_t ws_size, hipStream_t stream) {
    static int grid = 0;
    if (grid == 0) {
        if (n_in != 32 || in_sizes[0] != M * D || out_size != M * D || ws_size < WS_END) { fprintf(stderr, "kernel_launch: unexpected shapes (n_in %d, ws %zu)\n", n_in, ws_size); grid = -1; return; }
        int dev = 0, cus = 0, per_cu = 0;
        if (hipGetDevice(&dev) != hipSuccess || hipDeviceGetAttribute(&cus, hipDeviceAttributeMultiprocessorCount, dev) != hipSuccess) { grid = -1; return; }
        if (hipFuncSetAttribute((const void*)mk_fwd, hipFuncAttributeMaxDynamicSharedMemorySize, LDS_BYTES) != hipSuccess) { fprintf(stderr, "kernel_launch: hipFuncSetAttribute failed\n"); grid = -1; return; }
        if (hipOccupancyMaxActiveBlocksPerMultiprocessor(&per_cu, (const void*)mk_fwd, NWAVES * 64, LDS_BYTES) != hipSuccess || per_cu < 1) { fprintf(stderr, "kernel_launch: occupancy query says %d\n", per_cu); per_cu = 1; }
        (void)hipGetLastError();
        grid = cus;
    }
    if (grid < 0) return;
    if (hipMemsetAsync((char*)d_ws + WS_CTL, 0, CTL_ZERO_BYTES, stream) != hipSuccess) return;
    Args a{};
    for (int i = 0; i < 32; ++i) a.in[i] = (const float*)d_in[i];
    a.out = (float*)d_out; a.ws = (unsigned char*)d_ws;
#if USE_XCD_BARRIER
#ifndef N_CUTS
#define N_CUTS 1
#endif
    static const int cuts[N_CUTS + 1] = CUT_LIST;
    for (int li = 0; li < N_CUTS; ++li) { a.ph_lo = cuts[li]; a.ph_hi = cuts[li + 1]; a.li = li;
        hipLaunchKernelGGL(mk_fwd, dim3(grid), dim3(NWAVES * 64), LDS_BYTES, stream, a); }
#else
    void* kargs[] = {&a};
    hipError_t e = hipLaunchCooperativeKernel((const void*)mk_fwd, dim3(grid), dim3(NWAVES * 64), kargs, LDS_BYTES, stream);
    if (e != hipSuccess) fprintf(stderr, "cooperative launch failed: %s (grid %d)\n", hipGetErrorString(e), grid);
#endif
}
```
